# Optimizing an MI355X kernel written in HIP

```python
import jax, jax.numpy as jnp
from jax import lax
import numpy as np

D_MODEL = 2048
BATCH = 2
SEQ = 16384
DEPTH = 1

MEM_LEN = 256
HEAD_DIM = 128
MOBA_HEADS = 8
MOBA_W = MOBA_HEADS * HEAD_DIM
MOBA_BLOCK = 256
MOBA_TOPK = 3
MOBA_Q_CHUNK = 64
GMLP_GROUPS = 4
GMLP_W = GMLP_GROUPS * HEAD_DIM
GMLP_CHUNK = 128
MEM_HEADS = 4
MEM_W = MEM_HEADS * HEAD_DIM
D_MIX = MOBA_W + GMLP_W + MEM_W
IN_SPLITS = (MOBA_W, MOBA_W, MOBA_W, MOBA_W, GMLP_W, GMLP_W, GMLP_W, MEM_W, MEM_W)
D_IN = sum(IN_SPLITS)
IN_SPLIT_POINTS = tuple(int(c) for c in np.cumsum(IN_SPLITS)[:-1])
ROPE_THETA = 10000.0
LN_EPS = 1e-5
DEEPNORM_ALPHA = (2.0 * DEPTH) ** 0.25
DEEPNORM_BETA = (8.0 * DEPTH) ** -0.25
NEG_INF = -1e30

kernel_name = "hymba_moba_gmlp_memxattn_deepnorm"


def layer_norm(x, g, b):
    xf = x.astype(jnp.float32)
    mu = xf.mean(-1, keepdims=True)
    var = jnp.square(xf - mu).mean(-1, keepdims=True)
    return ((xf - mu) * lax.rsqrt(var + LN_EPS) * g.astype(jnp.float32) + b.astype(jnp.float32)).astype(x.dtype)


def rope(x, positions):
    half = HEAD_DIM // 2
    inv_freq = ROPE_THETA ** (-jnp.arange(half, dtype=jnp.float32) / half)
    ang = positions.astype(jnp.float32)[..., None] * inv_freq
    cos = jnp.cos(ang)[:, :, None, :]
    sin = jnp.sin(ang)[:, :, None, :]
    xf = x.astype(jnp.float32)
    x1, x2 = xf[..., :half], xf[..., half:]
    return jnp.concatenate([x1 * cos - x2 * sin, x2 * cos + x1 * sin], axis=-1).astype(x.dtype)


def moba_attention(q, k, v):
    b, s, h, d = q.shape
    s_pad = -(-s // MOBA_BLOCK) * MOBA_BLOCK
    pad = ((0, 0), (0, s_pad - s), (0, 0), (0, 0))
    q, k, v = (jnp.pad(t, pad).transpose(0, 2, 1, 3) for t in (q, k, v))
    nb = s_pad // MOBA_BLOCK
    n_sel = min(MOBA_TOPK, nb)
    kb = k.reshape(b, h, nb, MOBA_BLOCK, d)
    vb = v.reshape(b, h, nb, MOBA_BLOCK, d)
    k_mean = kb.astype(jnp.float32).mean(axis=3)
    q_block = jnp.arange(s_pad) // MOBA_BLOCK
    gate = jnp.einsum('bhsd,bhnd->bhsn', q.astype(jnp.float32), k_mean)
    past = jnp.arange(nb)[None, :] < q_block[:, None]
    gate = jnp.where(past, gate, NEG_INF)
    _, sel_idx = lax.top_k(gate, n_sel)
    sel_valid = sel_idx < q_block[:, None]
    scale = d ** -0.5
    bi = jnp.arange(b)[:, None, None, None]
    hi = jnp.arange(h)[None, :, None, None]
    key_off = jnp.arange(MOBA_BLOCK)
    q_off = jnp.arange(MOBA_Q_CHUNK)
    n_keys_sel = n_sel * MOBA_BLOCK

    def chunk(c):
        start = c * MOBA_Q_CHUNK
        q_c = lax.dynamic_slice_in_dim(q, start, MOBA_Q_CHUNK, axis=2)
        idx_c = lax.dynamic_slice_in_dim(sel_idx, start, MOBA_Q_CHUNK, axis=2)
        val_c = lax.dynamic_slice_in_dim(sel_valid, start, MOBA_Q_CHUNK, axis=2)
        blk = start // MOBA_BLOCK
        k_own = lax.dynamic_index_in_dim(kb, blk, axis=2, keepdims=False)
        v_own = lax.dynamic_index_in_dim(vb, blk, axis=2, keepdims=False)
        k_sel = kb[bi, hi, idx_c]
        v_sel = vb[bi, hi, idx_c]
        l_sel = jnp.einsum('bhqd,bhqnkd->bhqnk', q_c, k_sel).astype(jnp.float32) * scale
        l_sel = jnp.where(val_c[..., None], l_sel, NEG_INF).reshape(b, h, MOBA_Q_CHUNK, n_keys_sel)
        l_own = jnp.einsum('bhqd,bhkd->bhqk', q_c, k_own).astype(jnp.float32) * scale
        causal = (blk * MOBA_BLOCK + key_off)[None, :] <= (start + q_off)[:, None]
        l_own = jnp.where(causal, l_own, NEG_INF)
        p = jax.nn.softmax(jnp.concatenate([l_sel, l_own], axis=-1), axis=-1).astype(v.dtype)
        p_sel = p[..., :n_keys_sel].reshape(b, h, MOBA_Q_CHUNK, n_sel, MOBA_BLOCK)
        p_own = p[..., n_keys_sel:]
        return (jnp.einsum('bhqnk,bhqnkd->bhqd', p_sel, v_sel)
                + jnp.einsum('bhqk,bhkd->bhqd', p_own, v_own))

    out = lax.map(chunk, jnp.arange(s_pad // MOBA_Q_CHUNK))
    out = out.transpose(1, 0, 3, 2, 4).reshape(b, s_pad, h, d)
    return out[:, :s]


def gmlp_spatial_gate(u, v, ln_g, ln_b, w_s, b_s):
    u = jax.nn.gelu(u)
    v = layer_norm(jax.nn.gelu(v), ln_g, ln_b)
    b, s, _ = v.shape
    v = v.reshape(b, s // GMLP_CHUNK, GMLP_CHUNK, GMLP_GROUPS, HEAD_DIM)
    tril = jnp.tril(jnp.ones((GMLP_CHUNK, GMLP_CHUNK), dtype=bool))
    w = jnp.where(tril, w_s, 0)
    mixed = jnp.einsum('gts,bnsgc->bntgc', w, v) + b_s.T[None, None, :, :, None]
    return u * mixed.reshape(b, s, GMLP_W)


def memory_attention(q, mem_k, mem_v):
    logits = jnp.einsum('bshd,bmhd->bhsm', q, mem_k).astype(jnp.float32) * (HEAD_DIM ** -0.5)
    p = jax.nn.softmax(logits, axis=-1).astype(mem_v.dtype)
    return jnp.einsum('bhsm,bmhd->bshd', p, mem_v)


def setup_inputs(seed: int = 0) -> dict:
    key = jax.random.key(seed)
    ks = jax.random.split(key, 12)
    f32 = jnp.float32
    x = jax.random.normal(ks[0], (BATCH, SEQ, D_MODEL), f32)
    mem = jax.random.normal(ks[1], (BATCH, MEM_LEN, D_MODEL), f32)
    positions = jnp.broadcast_to(jnp.arange(SEQ, dtype=jnp.int32), (BATCH, SEQ))
    w_in = jax.random.normal(ks[2], (DEPTH, D_MODEL, D_IN), f32) * D_MODEL ** -0.5
    w_mem_kv = jax.random.normal(ks[3], (DEPTH, D_MODEL, 2 * MEM_W), f32) * D_MODEL ** -0.5
    gmlp_ln_g = 1.0 + 0.02 * jax.random.normal(ks[4], (DEPTH, GMLP_W), f32)
    gmlp_ln_b = 0.02 * jax.random.normal(ks[5], (DEPTH, GMLP_W), f32)
    gmlp_w_s = jax.random.normal(ks[6], (DEPTH, GMLP_GROUPS, GMLP_CHUNK, GMLP_CHUNK), f32) * GMLP_CHUNK ** -0.5
    gmlp_b_s = 1.0 + 0.1 * jax.random.normal(ks[7], (DEPTH, GMLP_GROUPS, GMLP_CHUNK), f32)
    w_out = jax.random.normal(ks[8], (DEPTH, D_MIX, D_MODEL), f32) * (D_MIX ** -0.5) * DEEPNORM_BETA
    ln_g = 1.0 + 0.02 * jax.random.normal(ks[9], (DEPTH, D_MODEL), f32)
    ln_b = 0.02 * jax.random.normal(ks[10], (DEPTH, D_MODEL), f32)
    return {"x": x, "mem": mem, "positions": positions, "w_in": w_in, "w_mem_kv": w_mem_kv,
            "gmlp_ln_g": gmlp_ln_g, "gmlp_ln_b": gmlp_ln_b, "gmlp_w_s": gmlp_w_s,
            "gmlp_b_s": gmlp_b_s, "w_out": w_out, "ln_g": ln_g, "ln_b": ln_b}


def reference(x, mem, positions, w_in, w_mem_kv, gmlp_ln_g, gmlp_ln_b, gmlp_w_s, gmlp_b_s,
              w_out, ln_g, ln_b):
    b, s, _ = x.shape
    for l in range(DEPTH):
        proj = jnp.einsum('bsd,de->bse', x, w_in[l])
        q_mo, k_mo, v_mo, g_mo, u_gm, v_gm, g_gm, q_me, g_me = jnp.split(proj, IN_SPLIT_POINTS, axis=-1)
        q_mo = rope(q_mo.reshape(b, s, MOBA_HEADS, HEAD_DIM), positions)
        k_mo = rope(k_mo.reshape(b, s, MOBA_HEADS, HEAD_DIM), positions)
        v_mo = v_mo.reshape(b, s, MOBA_HEADS, HEAD_DIM)
        y_mo = moba_attention(q_mo, k_mo, v_mo).reshape(b, s, MOBA_W) * jax.nn.silu(g_mo)
        y_gm = gmlp_spatial_gate(u_gm, v_gm, gmlp_ln_g[l], gmlp_ln_b[l], gmlp_w_s[l], gmlp_b_s[l]) * jax.nn.silu(g_gm)
        mem_k, mem_v = jnp.split(jnp.einsum('bmd,de->bme', mem, w_mem_kv[l]), 2, axis=-1)
        y_me = memory_attention(q_me.reshape(b, s, MEM_HEADS, HEAD_DIM),
                                mem_k.reshape(b, MEM_LEN, MEM_HEADS, HEAD_DIM),
                                mem_v.reshape(b, MEM_LEN, MEM_HEADS, HEAD_DIM)).reshape(b, s, MEM_W) * jax.nn.silu(g_me)
        y = jnp.concatenate([y_mo, y_gm, y_me], axis=-1)
        sub = jnp.einsum('bse,ed->bsd', y, w_out[l])
        x = layer_norm(DEEPNORM_ALPHA * x + sub, ln_g[l], ln_b[l])
    return x
```

```cpp
#include <hip/hip_runtime.h>
#include <hip/hip_cooperative_groups.h>
#include <cstdio>
#include <cstdint>
namespace cg = cooperative_groups;

#ifndef MK_MULTI
#define MK_MULTI 0
#endif

#define LAS __attribute__((address_space(3)))
typedef unsigned short bf16_t;
typedef short bf16x8 __attribute__((ext_vector_type(8)));
typedef float f32x4 __attribute__((ext_vector_type(4)));
typedef float f32x2 __attribute__((ext_vector_type(2)));
typedef unsigned u32x4 __attribute__((ext_vector_type(4)));
typedef unsigned u32x2 __attribute__((ext_vector_type(2)));

constexpr int BATCH = 2, SEQ = 16384, DM = 2048, DIN = 6656, MROWS = BATCH * SEQ, NBLK = 64, MEMLEN = 256;
constexpr int C_K = 1024, C_V = 2048, C_GMO = 3072, C_U = 4096, C_VG = 4608, C_GG = 5120, C_QME = 5632, C_GME = 6144;
constexpr float QSCALE = 0.08838834764831845f * 1.4426950408889634f;
constexpr float ALPHA = 1.189207115002721f;
constexpr float LN_EPS = 1e-5f;
constexpr int LIST_PER_BH = 256 * 2080;
constexpr int QCH = 1024;
constexpr int MQCH = 512;

constexpr size_t MiB = 1u << 20;
constexpr size_t WS_CNT = 0;
constexpr size_t WS_BAR = 8192;
constexpr size_t WS_KSUM = 64 * 1024;
constexpr size_t WS_WIN = 1 * MiB;
constexpr size_t WS_WOUT = 28 * MiB;
constexpr size_t WS_WMKV = 36 * MiB;
constexpr size_t WS_WSB = 40 * MiB;
constexpr size_t WS_MEMB = 41 * MiB;
constexpr size_t WS_MKV = 43 * MiB;
constexpr size_t WS_COS = 44 * MiB;
constexpr size_t WS_SIN = 52 * MiB;
constexpr size_t WS_LIST = 60 * MiB;
constexpr size_t WS_PML = 96 * MiB;
constexpr size_t WS_Y = 104 * MiB;
constexpr size_t WS_PROJ = 232 * MiB;
constexpr size_t WS_PO = 648 * MiB;
constexpr size_t WS_SUB = 648 * MiB;
constexpr size_t WS_XB = 648 * MiB;
constexpr size_t WS_END = 904 * MiB;
constexpr int LDS_BYTES = 152 * 1024;
constexpr int BAR_WORDS_N = 3456;

namespace pg8 {
constexpr int BM = 256, BK = 64, HALF = 128, HTB = HALF * BK * 2, STAGE_BYTES = 8 * HTB, NXCD = 8, WGM = 8;
__host__ __device__ __forceinline__ int lds_byte(int r, int c) { const int st = (r >> 4) * 2 + (c >> 5), rr = r & 15, cc = c & 31, ob = rr * 64 + cc * 2; return st * 1024 + (ob ^ (((ob >> 9) & 1) << 5)); }
__host__ __device__ __forceinline__ void stage_rc(int b, int& R, int& C) { const int st = b / 1024, sb = b % 1024, swz = sb ^ (((sb >> 9) & 1) << 5); R = (st >> 1) * 16 + swz / 64; C = (st & 1) * 32 + (swz % 64) / 2; }
__host__ __device__ __forceinline__ int perm32(int rho) { const int n = rho >> 4, i = rho & 15; return 8 * (i >> 2) + 4 * n + (i & 3); }
struct Unit { int pm, pn; };
struct Gemm { const bf16_t* A; const bf16_t* Bt; int M, N, K; };
struct StaticOrder {
    int nM, nN, nwg, G, c;
    __host__ __device__ void init(int M, int N, int G_, int c_) { nM = M / BM; nN = N / BM; nwg = nM * nN; G = G_; c = c_; }
    __host__ __device__ bool next(int i, Unit& u) const {
        const long L = (long)i * G + c; if (L >= nwg) return false;
        int wgid = (int)L; { const int q = nwg / NXCD, r = nwg % NXCD, xcd = wgid % NXCD, off = wgid / NXCD; wgid = (xcd < r ? xcd * (q + 1) : r * (q + 1) + (xcd - r) * q) + off; }
        const int nig = WGM * nN, gid = wgid / nig, fm = gid * WGM, gsz = (nM - fm) < WGM ? (nM - fm) : WGM;
        u.pm = fm + ((wgid % nig) % gsz); u.pn = (wgid % nig) / gsz; return true;
    }
    __device__ __forceinline__ void a_ready(const Unit&) const {}
    __device__ __forceinline__ void done(const Unit&) const {}
};
__device__ __forceinline__ unsigned cvt_pk_bf16(float lo, float hi) { unsigned r; asm volatile("v_cvt_pk_bf16_f32 %0, %1, %2" : "=v"(r) : "v"(lo), "v"(hi)); return r; }

template <class Epi, class Sched, bool ALIGN_EPI = false, bool SP2 = false>
__device__ __forceinline__ void gemm_phase(LAS unsigned char* lds, const Gemm g, const Sched& S, const Epi& E) {
    const int tid = threadIdx.x, wid = __builtin_amdgcn_readfirstlane(tid >> 6), lane = tid & 63, wr = wid >> 2, wc = wid & 3, fr = lane & 15, fq = lane >> 4;
    const int K = g.K, nt = K / BK;
    unsigned voffA[2], voffB[2];
#pragma unroll
    for (int i = 0; i < 2; ++i) { int R, C; stage_rc(tid * 16 + i * 8192, R, C); const int Rb = Epi::PERM ? ((R & ~31) + perm32(R & 31)) : R;
        voffA[i] = (unsigned)(R * K + C) * 2u; voffB[i] = (unsigned)(Rb * K + C) * 2u; }
    const size_t kstep = (size_t)(BK * 2);
    const size_t hstep = (size_t)HALF * K * 2;
    const size_t tstep = 2 * hstep;
    const unsigned ldsw = (unsigned)wid * 1024u;
    const int aoff = lds_byte(wr * 64 + fr, fq * 8), boff = lds_byte(wc * 32 + fr, fq * 8);
#define PG8_SA(b, h) (((b) * 2 + (h)) * HTB)
#define PG8_SB(b, h) ((4 + (b) * 2 + (h)) * HTB)
#define PG8_STAGE(bufoff, gbase, voff) do { _Pragma("unroll") for (int _i = 0; _i < 2; ++_i) \
        __builtin_amdgcn_global_load_lds((const unsigned*)((const char*)(gbase) + (voff)[_i]), (LAS unsigned*)(lds + (bufoff) + ldsw + _i * 8192), 16, 0, 0); } while (0)
#define PG8_LDA(dst, b, h) do { _Pragma("unroll") for (int m = 0; m < 4; ++m) _Pragma("unroll") for (int k = 0; k < 2; ++k) dst[m][k] = *(const LAS bf16x8*)(lds + PG8_SA(b, h) + aoff + m * 2048 + k * 1024); } while (0)
#define PG8_LDB(dst, b, h) do { _Pragma("unroll") for (int n = 0; n < 2; ++n) _Pragma("unroll") for (int k = 0; k < 2; ++k) dst[n][k] = *(const LAS bf16x8*)(lds + PG8_SB(b, h) + boff + n * 2048 + k * 1024); } while (0)
#define PG8_MMA(ai, bj, At, Bt) do { __builtin_amdgcn_s_setprio(1); _Pragma("unroll") for (int m = 0; m < 4; ++m) _Pragma("unroll") for (int n = 0; n < 2; ++n) _Pragma("unroll") for (int k = 0; k < 2; ++k) \
        acc[ai][bj][m][n] = __builtin_amdgcn_mfma_f32_16x16x32_bf16(Bt[n][k], At[m][k], acc[ai][bj][m][n], 0, 0, 0); __builtin_amdgcn_s_setprio(0); } while (0)
#define PG8_WAIT_V(n) asm volatile("s_waitcnt vmcnt(" #n ")" ::: "memory")
#define PG8_WAIT_L(n) asm volatile("s_waitcnt lgkmcnt(" #n ")" ::: "memory")
#define PG8_BAR __builtin_amdgcn_s_barrier()
#define PG8_SCHED __builtin_amdgcn_sched_barrier(0)
    Unit cur, nxt; int ui = 0;
    if (!S.next(0, cur)) return;
    f32x4 acc[2][2][4][2];
#pragma unroll
    for (int a = 0; a < 2; ++a)
#pragma unroll
        for (int b = 0; b < 2; ++b)
#pragma unroll
            for (int m = 0; m < 4; ++m)
#pragma unroll
                for (int n = 0; n < 2; ++n) acc[a][b][m][n] = (f32x4){0.f, 0.f, 0.f, 0.f};
    bf16x8 At[4][2], B0[2][2], B1[2][2];
    const char* cA = (const char*)g.A + (size_t)cur.pm * tstep; const char* cB = (const char*)g.Bt + (size_t)cur.pn * tstep;
    S.a_ready(cur);
    if constexpr (SP2) {
        PG8_STAGE(PG8_SB(0, 0), cB, voffB); PG8_STAGE(PG8_SB(0, 1), cB + hstep, voffB); PG8_STAGE(PG8_SA(0, 0), cA, voffA); PG8_STAGE(PG8_SA(0, 1), cA + hstep, voffA);
        if (wr == 1) PG8_BAR;
        PG8_WAIT_V(2); PG8_BAR;
        PG8_STAGE(PG8_SB(1, 0), cB + kstep, voffB); PG8_STAGE(PG8_SA(1, 0), cA + kstep, voffA); PG8_STAGE(PG8_SB(1, 1), cB + hstep + kstep, voffB);
        PG8_WAIT_V(6); PG8_BAR;
    } else {
        PG8_STAGE(PG8_SB(0, 0), cB, voffB); PG8_STAGE(PG8_SA(0, 0), cA, voffA); PG8_STAGE(PG8_SB(0, 1), cB + hstep, voffB); PG8_STAGE(PG8_SA(0, 1), cA + hstep, voffA);
        if (wr == 1) PG8_BAR;
        PG8_WAIT_V(4); PG8_BAR;
        PG8_STAGE(PG8_SB(1, 0), cB + kstep, voffB); PG8_STAGE(PG8_SA(1, 0), cA + kstep, voffA); PG8_STAGE(PG8_SB(1, 1), cB + hstep + kstep, voffB);
        PG8_WAIT_V(6); PG8_BAR;
    }
    for (;;) {
        const bool has_next = S.next(ui + 1, nxt);
        const char* nA = has_next ? (const char*)g.A + (size_t)nxt.pm * tstep : cA; const char* nB = has_next ? (const char*)g.Bt + (size_t)nxt.pn * tstep : cB;
        for (int t = 0; t < nt; t += 2) {
            const bool last = (t == nt - 2);
            const char* a1 = cA + (size_t)(t + 1) * kstep;
            const char* a2 = last ? nA : cA + (size_t)(t + 2) * kstep; const char* b2 = last ? nB : cB + (size_t)(t + 2) * kstep;
            const char* a3 = a2 + kstep; const char* b3 = b2 + kstep;
            if (last && has_next) S.a_ready(nxt);
            if constexpr (SP2) {
            PG8_LDB(B0, 0, 0); PG8_LDB(B1, 0, 1); PG8_SCHED; PG8_LDA(At, 0, 0); PG8_STAGE(PG8_SA(1, 1), a1 + hstep, voffA);
            PG8_WAIT_V(8); PG8_WAIT_L(0); PG8_BAR; PG8_MMA(0, 0, At, B0); PG8_MMA(0, 1, At, B1); PG8_BAR; PG8_SCHED;
            PG8_LDA(At, 0, 1); PG8_STAGE(PG8_SB(0, 0), b2, voffB); PG8_STAGE(PG8_SB(0, 1), b2 + hstep, voffB); PG8_STAGE(PG8_SA(0, 0), a2, voffA);
            PG8_WAIT_V(8); PG8_WAIT_L(0); PG8_BAR; PG8_MMA(1, 0, At, B0); PG8_MMA(1, 1, At, B1); PG8_BAR; PG8_SCHED;
            PG8_LDB(B0, 1, 0); PG8_LDB(B1, 1, 1); PG8_SCHED; PG8_LDA(At, 1, 0); PG8_STAGE(PG8_SA(0, 1), a2 + hstep, voffA);
            PG8_WAIT_V(8); PG8_WAIT_L(0); PG8_BAR; PG8_MMA(0, 0, At, B0); PG8_MMA(0, 1, At, B1); PG8_BAR; PG8_SCHED;
            PG8_LDA(At, 1, 1); PG8_STAGE(PG8_SB(1, 0), b3, voffB); PG8_STAGE(PG8_SB(1, 1), b3 + hstep, voffB); PG8_STAGE(PG8_SA(1, 0), a3, voffA);
            PG8_WAIT_V(8); PG8_WAIT_L(0); PG8_BAR; PG8_MMA(1, 0, At, B0); PG8_MMA(1, 1, At, B1); PG8_BAR; PG8_SCHED;
            } else {
            PG8_LDB(B0, 0, 0); PG8_SCHED; PG8_LDA(At, 0, 0); PG8_STAGE(PG8_SA(1, 1), a1 + hstep, voffA);
            PG8_WAIT_L(8); PG8_BAR; PG8_WAIT_L(0); PG8_MMA(0, 0, At, B0); PG8_BAR; PG8_SCHED;
            PG8_LDB(B1, 0, 1); PG8_STAGE(PG8_SB(0, 0), b2, voffB);
            PG8_BAR; PG8_WAIT_L(0); PG8_MMA(0, 1, At, B1); PG8_BAR;
            PG8_LDA(At, 0, 1); PG8_STAGE(PG8_SA(0, 0), a2, voffA);
            PG8_BAR; PG8_WAIT_L(0); PG8_MMA(1, 0, At, B0); PG8_BAR; PG8_SCHED;
            PG8_STAGE(PG8_SB(0, 1), b2 + hstep, voffB);
            PG8_WAIT_V(6); PG8_BAR; PG8_MMA(1, 1, At, B1); PG8_BAR;
            PG8_LDB(B0, 1, 0); PG8_SCHED; PG8_LDA(At, 1, 0); PG8_STAGE(PG8_SA(0, 1), a2 + hstep, voffA);
            PG8_WAIT_L(8); PG8_BAR; PG8_WAIT_L(0); PG8_MMA(0, 0, At, B0); PG8_BAR; PG8_SCHED;
            PG8_LDB(B1, 1, 1); PG8_STAGE(PG8_SB(1, 0), b3, voffB);
            PG8_BAR; PG8_WAIT_L(0); PG8_MMA(0, 1, At, B1); PG8_BAR;
            PG8_LDA(At, 1, 1); PG8_STAGE(PG8_SA(1, 0), a3, voffA);
            PG8_BAR; PG8_WAIT_L(0); PG8_MMA(1, 0, At, B0); PG8_BAR; PG8_SCHED;
            PG8_STAGE(PG8_SB(1, 1), b3 + hstep, voffB);
            PG8_WAIT_V(6); PG8_BAR; PG8_MMA(1, 1, At, B1); PG8_BAR;
            }
        }
        if constexpr (ALIGN_EPI) { if (wr == 0) PG8_BAR; }
        E(acc, cur, wr, wc, fr, fq); S.done(cur);
        if (!has_next) break;
#pragma unroll
        for (int a = 0; a < 2; ++a)
#pragma unroll
            for (int b = 0; b < 2; ++b)
#pragma unroll
                for (int m = 0; m < 4; ++m)
#pragma unroll
                    for (int n = 0; n < 2; ++n) acc[a][b][m][n] = (f32x4){0.f, 0.f, 0.f, 0.f};
        cur = nxt; cA = nA; cB = nB; ++ui;
        if constexpr (ALIGN_EPI) { if (wr == 1) PG8_BAR; }
    }
    PG8_WAIT_V(0);
    if constexpr (!ALIGN_EPI) { if (wr == 0) PG8_BAR; }
    PG8_BAR;
#undef PG8_SA
#undef PG8_SB
#undef PG8_STAGE
#undef PG8_LDA
#undef PG8_LDB
#undef PG8_MMA
#undef PG8_WAIT_V
#undef PG8_WAIT_L
#undef PG8_BAR
#undef PG8_SCHED
}
}

using pg8::cvt_pk_bf16;
__device__ __forceinline__ float bf2f(unsigned short b) { return __builtin_bit_cast(float, (unsigned)b << 16); }
__device__ __forceinline__ float bflo(unsigned w) { return __builtin_bit_cast(float, w << 16); }
__device__ __forceinline__ float bfhi(unsigned w) { return __builtin_bit_cast(float, w & 0xffff0000u); }
__device__ __forceinline__ float fast_exp2(float x) { return __builtin_amdgcn_exp2f(x); }
__device__ __forceinline__ float fast_rcp(float x) { return __builtin_amdgcn_rcpf(x); }
__device__ __forceinline__ float silu_f(float x) { return x * fast_rcp(1.f + fast_exp2(-1.4426950408889634f * x)); }
__device__ __forceinline__ float gelu_tanh_f(float x) {
    const float t = x * (1.f + 0.044715f * x * x) * (-1.5957691216057308f * 1.4426950408889634f);
    return x * fast_rcp(1.f + fast_exp2(t));
}
#define LDS_WAIT() asm volatile("s_waitcnt lgkmcnt(0)" ::: "memory")

struct EpiProj {
    static constexpr bool PERM = true;
    bf16_t* O; const float* cosT; const float* sinT; float* ksum;
    __device__ __forceinline__ void operator()(const f32x4 (&acc)[2][2][4][2], const pg8::Unit& u, int wr, int wc, int fr, int fq) const {
        const int pn = u.pn;
        const int type = pn < 4 ? 0 : pn < 8 ? 1 : pn < 12 ? 2 : pn < 16 ? 3 : pn < 20 ? 4 : pn < 22 ? 3 : pn < 24 ? 5 : 3;
        const int row0 = u.pm * 256 + wr * 64 + fr;
        const int col0 = pn * 256 + wc * 32 + 8 * fq;
        float cs[2][8];
#pragma unroll
        for (int bj = 0; bj < 2; ++bj)
#pragma unroll
            for (int e = 0; e < 8; ++e) cs[bj][e] = 0.f;
#pragma unroll
        for (int ai = 0; ai < 2; ++ai) {
            f32x4 c4v[4], s4v[4];
#pragma unroll
            for (int m = 0; m < 4; ++m) { c4v[m] = (f32x4){1.f, 1.f, 1.f, 1.f}; s4v[m] = (f32x4){0.f, 0.f, 0.f, 0.f}; }
            if (type <= 1) {
#pragma unroll
                for (int m = 0; m < 4; ++m) { const size_t ro = (size_t)(row0 + ai * 128 + m * 16) * 64 + 16 * wc + 4 * fq; c4v[m] = *(const f32x4*)(cosT + ro); s4v[m] = *(const f32x4*)(sinT + ro); }
            }
            __builtin_amdgcn_sched_barrier(0);
#pragma unroll
            for (int m = 0; m < 4; ++m) {
                const int row = row0 + ai * 128 + m * 16;
                const f32x4 c4 = c4v[m], s4 = s4v[m];
                bf16_t* rowp = O + (size_t)row * DIN + col0;
#pragma unroll
                for (int bj = 0; bj < 2; ++bj) {
                    f32x4 v0 = acc[ai][bj][m][0], v1 = acc[ai][bj][m][1];
                    float o[8];
                    if (type <= 1) {
                        o[0] = v0[0] * c4[0] - v0[1] * s4[0]; o[1] = v0[1] * c4[0] + v0[0] * s4[0];
                        o[2] = v0[2] * c4[1] - v0[3] * s4[1]; o[3] = v0[3] * c4[1] + v0[2] * s4[1];
                        o[4] = v1[0] * c4[2] - v1[1] * s4[2]; o[5] = v1[1] * c4[2] + v1[0] * s4[2];
                        o[6] = v1[2] * c4[3] - v1[3] * s4[3]; o[7] = v1[3] * c4[3] + v1[2] * s4[3];
                        if (type == 0) {
#pragma unroll
                            for (int e = 0; e < 8; ++e) o[e] *= QSCALE;
                        } else {
#pragma unroll
                            for (int e = 0; e < 8; ++e) cs[bj][e] += o[e];
                        }
                    } else {
#pragma unroll
                        for (int e = 0; e < 4; ++e) { o[e] = v0[e]; o[4 + e] = v1[e]; }
                        if (type == 3) {
#pragma unroll
                            for (int e = 0; e < 8; ++e) o[e] = silu_f(o[e]);
                        } else if (type == 4) {
#pragma unroll
                            for (int e = 0; e < 8; ++e) o[e] = gelu_tanh_f(o[e]);
                        } else if (type == 5) {
#pragma unroll
                            for (int e = 0; e < 8; ++e) o[e] *= QSCALE;
                        }
                    }
                    u32x4 w; w.x = cvt_pk_bf16(o[0], o[1]); w.y = cvt_pk_bf16(o[2], o[3]); w.z = cvt_pk_bf16(o[4], o[5]); w.w = cvt_pk_bf16(o[6], o[7]);
                    *(u32x4*)(rowp + bj * 128) = w;
                }
            }
            __builtin_amdgcn_sched_barrier(0);
        }
        if (type == 1) {
#pragma unroll
            for (int bj = 0; bj < 2; ++bj)
#pragma unroll
                for (int e = 0; e < 8; ++e) {
                    float v = cs[bj][e];
                    v += __shfl_xor(v, 1); v += __shfl_xor(v, 2); v += __shfl_xor(v, 4); v += __shfl_xor(v, 8);
                    cs[bj][e] = v;
                }
            if (fr == 0) {
                float* kp = ksum + (size_t)u.pm * 1024 + (pn - 4) * 256 + wc * 32 + 8 * fq;
#pragma unroll
                for (int bj = 0; bj < 2; ++bj)
#pragma unroll
                    for (int e = 0; e < 8; ++e) atomicAdd(kp + bj * 128 + e, cs[bj][e]);
            }
        }
    }
};
struct EpiPlain {
    static constexpr bool PERM = true;
    bf16_t* O; int ldc;
    __device__ __forceinline__ void operator()(const f32x4 (&acc)[2][2][4][2], const pg8::Unit& u, int wr, int wc, int fr, int fq) const {
        const int row0 = u.pm * 256 + wr * 64 + fr, col0 = u.pn * 256 + wc * 32 + 8 * fq;
#pragma unroll
        for (int ai = 0; ai < 2; ++ai)
#pragma unroll
            for (int m = 0; m < 4; ++m) { bf16_t* rowp = O + (size_t)(row0 + ai * 128 + m * 16) * ldc + col0;
#pragma unroll
                for (int bj = 0; bj < 2; ++bj) { const f32x4 v0 = acc[ai][bj][m][0], v1 = acc[ai][bj][m][1];
                    u32x4 w; w.x = cvt_pk_bf16(v0[0], v0[1]); w.y = cvt_pk_bf16(v0[2], v0[3]); w.z = cvt_pk_bf16(v1[0], v1[1]); w.w = cvt_pk_bf16(v1[2], v1[3]);
                    *(u32x4*)(rowp + bj * 128) = w; } }
    }
};
struct EpiResid {
    static constexpr bool PERM = true;
    const float* __restrict__ x; float* __restrict__ out;
    __device__ __forceinline__ void operator()(const f32x4 (&acc)[2][2][4][2], const pg8::Unit& u, int wr, int wc, int fr, int fq) const {
        const int row0 = u.pm * 256 + wr * 64 + fr, col0 = u.pn * 256 + wc * 32 + 8 * fq;
#pragma unroll
        for (int ai = 0; ai < 2; ++ai) {
            f32x4 xv[4][2][2];
#pragma unroll
            for (int m = 0; m < 4; ++m) { const size_t off = (size_t)(row0 + ai * 128 + m * 16) * DM + col0;
#pragma unroll
                for (int bj = 0; bj < 2; ++bj)
#pragma unroll
                    for (int n = 0; n < 2; ++n) xv[m][bj][n] = *(const f32x4*)(x + off + bj * 128 + 4 * n); }
            __builtin_amdgcn_sched_barrier(0);
#pragma unroll
            for (int m = 0; m < 4; ++m) { const size_t off = (size_t)(row0 + ai * 128 + m * 16) * DM + col0;
#pragma unroll
                for (int bj = 0; bj < 2; ++bj)
#pragma unroll
                    for (int n = 0; n < 2; ++n) *(f32x4*)(out + off + bj * 128 + 4 * n) = xv[m][bj][n] * ALPHA + acc[ai][bj][m][n]; }
            __builtin_amdgcn_sched_barrier(0);
        }
    }
};

struct Args { const float* x; const float* mem; const int* pos; const float* w_in; const float* w_mkv; const float* gln_g; const float* gln_b;
              const float* w_s; const float* b_s; const float* w_out; const float* ln_g; const float* ln_b; float* out; unsigned char* ws; int ph_lo, ph_hi; };

__device__ __forceinline__ void p0_transpose_item(const float* W, int K, int N, bf16_t* WT, bool permute_qk, LAS float* scr, int item, int lane) {
    const int nblk = N / 32, kb = item / nblk, nb = item % nblk, k0 = 64 * kb, n0 = 32 * nb;
    const int ncol = n0 + (lane & 31);
    int src = ncol;
    if (permute_qk && ncol < 2048) { const int p = ncol & 127; src = (ncol & ~127) + ((p & 1) << 6) + (p >> 1); }
#pragma unroll 8
    for (int i = 0; i < 32; ++i) { const int kk = 2 * i + (lane >> 5); scr[kk * 33 + (lane & 31)] = W[(size_t)(k0 + kk) * N + src]; }
    LDS_WAIT();
    const int c = lane & 7;
#pragma unroll
    for (int j = 0; j < 4; ++j) { const int n = (lane >> 3) + 8 * j; const LAS float* s = scr + (8 * c) * 33 + n;
        u32x4 o; o.x = cvt_pk_bf16(s[0 * 33], s[1 * 33]); o.y = cvt_pk_bf16(s[2 * 33], s[3 * 33]); o.z = cvt_pk_bf16(s[4 * 33], s[5 * 33]); o.w = cvt_pk_bf16(s[6 * 33], s[7 * 33]);
        *(u32x4*)(WT + (size_t)(n0 + n) * K + k0 + 8 * c) = o; }
    LDS_WAIT();
}

__device__ __forceinline__ void phase0(const Args& a, LAS unsigned char* lds) {
    unsigned char* ws = a.ws;
    const int tid = threadIdx.x, lane = tid & 63, wave = tid >> 6;
    const int G = gridDim.x;
    const size_t gtid = (size_t)blockIdx.x * 512 + tid, NT = (size_t)G * 512;
    { int* cnt = (int*)(ws + WS_CNT); for (size_t i = gtid; i < 1088; i += NT) cnt[i] = 0;
      float* ks = (float*)(ws + WS_KSUM); for (size_t i = gtid; i < 128 * 1024; i += NT) ks[i] = 0.f; }
    { LAS float* scr = (LAS float*)(lds + wave * 16384);
      const int gw = blockIdx.x * 8 + wave, NGW = G * 8;
      constexpr int I_IN = (DM / 64) * (DIN / 32), I_OUT = (DM / 64) * (DM / 32), I_MKV = (DM / 64) * (1024 / 32);
      for (int it = gw; it < I_IN + I_OUT + I_MKV; it += NGW) {
          int r = it;
          if (r < I_IN) { p0_transpose_item(a.w_in, DM, DIN, (bf16_t*)(ws + WS_WIN), true, scr, r, lane); continue; } r -= I_IN;
          if (r < I_OUT) { p0_transpose_item(a.w_out, DM, DM, (bf16_t*)(ws + WS_WOUT), false, scr, r, lane); continue; } r -= I_OUT;
          p0_transpose_item(a.w_mkv, DM, 1024, (bf16_t*)(ws + WS_WMKV), false, scr, r, lane);
      } }
    { const size_t n8 = (size_t)MROWS * DM / 8; u32x4* xb = (u32x4*)(ws + WS_XB);
      for (size_t i0 = gtid; i0 < n8; i0 += 4 * NT) {
          f32x4 v[4][2];
#pragma unroll
          for (int j = 0; j < 4; ++j) { const size_t i = i0 + j * NT; if (i < n8) { v[j][0] = ((const f32x4*)a.x)[2 * i]; v[j][1] = ((const f32x4*)a.x)[2 * i + 1]; } }
          __builtin_amdgcn_sched_barrier(0);
#pragma unroll
          for (int j = 0; j < 4; ++j) { const size_t i = i0 + j * NT; if (i < n8) { const f32x4 v0 = v[j][0], v1 = v[j][1];
              u32x4 o; o.x = cvt_pk_bf16(v0[0], v0[1]); o.y = cvt_pk_bf16(v0[2], v0[3]); o.z = cvt_pk_bf16(v1[0], v1[1]); o.w = cvt_pk_bf16(v1[2], v1[3]); xb[i] = o; } }
          __builtin_amdgcn_sched_barrier(0);
      }
      const size_t m8 = (size_t)BATCH * MEMLEN * DM / 8; u32x4* mb = (u32x4*)(ws + WS_MEMB);
      for (size_t i = gtid; i < m8; i += NT) { const f32x4 v0 = ((const f32x4*)a.mem)[2 * i], v1 = ((const f32x4*)a.mem)[2 * i + 1];
          u32x4 o; o.x = cvt_pk_bf16(v0[0], v0[1]); o.y = cvt_pk_bf16(v0[2], v0[3]); o.z = cvt_pk_bf16(v1[0], v1[1]); o.w = cvt_pk_bf16(v1[2], v1[3]); mb[i] = o; } }
    { bf16_t* wsb = (bf16_t*)(ws + WS_WSB);
      for (size_t i = gtid; i < 4 * 128 * 128; i += NT) { const int t = (int)(i >> 7) & 127, s = (int)i & 127; const float v = s <= t ? a.w_s[i] : 0.f; wsb[i] = (bf16_t)(cvt_pk_bf16(v, 0.f) & 0xffffu); } }
    { float* cT = (float*)(ws + WS_COS); float* sT = (float*)(ws + WS_SIN);
      LAS float* invf = (LAS float*)(lds + 8 * 16384);
      if (tid < 64) invf[tid] = (float)exp2(-(double)tid * (13.287712379549449 / 64.0));
      __syncthreads();
      for (size_t e = gtid; e < (size_t)MROWS * 64; e += NT) { const int row = (int)(e >> 6), i = (int)e & 63;
          const float inv = invf[i];
          const float ang = (float)a.pos[row] * inv;
          const double rev = (double)ang * 0.15915494309189535; const float fr = (float)(rev - rint(rev));
          cT[e] = __builtin_amdgcn_cosf(fr); sT[e] = __builtin_amdgcn_sinf(fr); } }
}

__device__ __forceinline__ int list_base(int n) { return 256 * (64 * n - (n * (n - 1)) / 2); }
__device__ __forceinline__ unsigned long long shfl_xor_u64(unsigned long long v, int m) {
    unsigned lo = (unsigned)v, hi = (unsigned)(v >> 32); lo = __shfl_xor(lo, m); hi = __shfl_xor(hi, m); return ((unsigned long long)hi << 32) | lo; }

__device__ __forceinline__ void phase2(const Args& a, LAS unsigned char* lds) {
    unsigned char* ws = a.ws;
    const int tid = threadIdx.x, lane = tid & 63, wave = __builtin_amdgcn_readfirstlane(tid >> 6), fr = lane & 15, fq = lane >> 4;
    const bf16_t* proj = (const bf16_t*)(ws + WS_PROJ);
    const float* ksum = (const float*)(ws + WS_KSUM);
    int* cnt = (int*)(ws + WS_CNT);
    unsigned* list = (unsigned*)(ws + WS_LIST);
    LAS unsigned char* Kl = lds;
    LAS int* lcnt = (LAS int*)(lds + 16384);
    LAS int* gbase = (LAS int*)(lds + 16384 + 256);
    { const bf16_t* memb = (const bf16_t*)(ws + WS_MEMB); const bf16_t* wt = (const bf16_t*)(ws + WS_WMKV); bf16_t* mkv = (bf16_t*)(ws + WS_MKV);
      for (int t = blockIdx.x; t < 256; t += gridDim.x) {
          const int m0 = (t & 15) * 32 + 16 * (wave & 1), n0 = (t >> 4) * 64 + 16 * (wave >> 1);
          const bf16_t* ap = wt + (size_t)(n0 + fr) * DM + 8 * fq; const bf16_t* bp = memb + (size_t)(m0 + fr) * DM + 8 * fq;
          f32x4 acc = (f32x4){0.f, 0.f, 0.f, 0.f};
          bf16x8 av[8], bv[8], an[8], bn[8];
#pragma unroll
          for (int i = 0; i < 8; ++i) { av[i] = *(const bf16x8*)(ap + 32 * i); bv[i] = *(const bf16x8*)(bp + 32 * i); }
#pragma unroll 1
          for (int kb = 0; kb < 8; ++kb) {
              const int kn = kb < 7 ? kb + 1 : kb;
#pragma unroll
              for (int i = 0; i < 8; ++i) { an[i] = *(const bf16x8*)(ap + 32 * (8 * kn + i)); bn[i] = *(const bf16x8*)(bp + 32 * (8 * kn + i)); }
              __builtin_amdgcn_sched_barrier(0);
#pragma unroll
              for (int i = 0; i < 8; ++i) acc = __builtin_amdgcn_mfma_f32_16x16x32_bf16(av[i], bv[i], acc, 0, 0, 0);
              __builtin_amdgcn_sched_barrier(0);
#pragma unroll
              for (int i = 0; i < 8; ++i) { av[i] = an[i]; bv[i] = bn[i]; }
          }
          u32x2 w; w.x = cvt_pk_bf16(acc[0], acc[1]); w.y = cvt_pk_bf16(acc[2], acc[3]);
          *(u32x2*)(mkv + (size_t)(m0 + fr) * 1024 + n0 + 4 * fq) = w; } }
    LAS int* pend_n = (LAS int*)(lds + 18432);
    LAS int* pend_lp = (LAS int*)(lds + 18432 + 16384);
    LAS int* lcnt4 = (LAS int*)(lds + 16384);
    LAS int* gbase4 = (LAS int*)(lds + 16384 + 1024);
    for (int grp = blockIdx.x; grp < 256; grp += gridDim.x) {
        const int bh = grp >> 4, qb0 = (grp & 15) * 4, b = bh >> 3, h = bh & 7;
        { const int n = tid >> 3, c2 = tid & 7; const float* kp = ksum + (size_t)(b * 64 + n) * 1024 + h * 128 + c2 * 16;
          const f32x4 v0 = *(const f32x4*)kp, v1 = *(const f32x4*)(kp + 4), v2 = *(const f32x4*)(kp + 8), v3 = *(const f32x4*)(kp + 12);
          u32x4 w0, w1; w0.x = cvt_pk_bf16(v0[0], v0[1]); w0.y = cvt_pk_bf16(v0[2], v0[3]); w0.z = cvt_pk_bf16(v1[0], v1[1]); w0.w = cvt_pk_bf16(v1[2], v1[3]);
          w1.x = cvt_pk_bf16(v2[0], v2[1]); w1.y = cvt_pk_bf16(v2[2], v2[3]); w1.z = cvt_pk_bf16(v3[0], v3[1]); w1.w = cvt_pk_bf16(v3[2], v3[3]);
          *(LAS u32x4*)(Kl + n * 256 + (((2 * c2) ^ (n & 15)) << 4)) = w0; *(LAS u32x4*)(Kl + n * 256 + (((2 * c2 + 1) ^ (n & 15)) << 4)) = w1;
          if (tid < 256) lcnt4[tid] = 0; }
        const bf16_t* qbase = proj + (size_t)(b * SEQ + wave * 32 + fr) * DIN + h * 128 + 8 * fq;
        bf16x8 qcur[2][4];
#pragma unroll
        for (int tt = 0; tt < 2; ++tt)
#pragma unroll
            for (int k = 0; k < 4; ++k) qcur[tt][k] = *(const bf16x8*)(qbase + (size_t)(qb0 * 256 + tt * 16) * DIN + 32 * k);
        __syncthreads();
#pragma unroll 1
        for (int kk = 0; kk < 4; ++kk) {
            const int qb = qb0 + kk;
            bf16x8 qnxt[2][4];
            { const int qbn = kk < 3 ? qb + 1 : qb;
#pragma unroll
              for (int tt = 0; tt < 2; ++tt)
#pragma unroll
                  for (int k = 0; k < 4; ++k) qnxt[tt][k] = *(const bf16x8*)(qbase + (size_t)(qbn * 256 + tt * 16) * DIN + 32 * k); }
#pragma unroll
            for (int tt = 0; tt < 2; ++tt) {
                unsigned long long best0 = 0ull, best1 = 0ull, best2 = 0ull;
#pragma unroll
                for (int nt = 0; nt < 4; ++nt) {
                    if (16 * nt < qb) {
                        f32x4 g = (f32x4){0.f, 0.f, 0.f, 0.f};
#pragma unroll
                        for (int k = 0; k < 4; ++k) { const bf16x8 av = *(const LAS bf16x8*)(Kl + (16 * nt + fr) * 256 + (((4 * k + fq) ^ fr) << 4)); g = __builtin_amdgcn_mfma_f32_16x16x32_bf16(av, qcur[tt][k], g, 0, 0, 0); }
#pragma unroll
                        for (int j = 0; j < 4; ++j) { const int n = 16 * nt + 4 * fq + j;
                            const float gj = j == 0 ? g.x : j == 1 ? g.y : j == 2 ? g.z : g.w; const unsigned bits = __float_as_uint(gj); const unsigned ord = (bits & 0x80000000u) ? ~bits : (bits | 0x80000000u);
                            unsigned long long key = n < qb ? (((unsigned long long)ord << 32) | (unsigned)(63 - n)) : 0ull;
                            if (key > best0) { const unsigned long long t = best0; best0 = key; key = t; }
                            if (key > best1) { const unsigned long long t = best1; best1 = key; key = t; }
                            if (key > best2) { best2 = key; } }
                    }
                }
                int ptr = 0; int myn = -1;
#pragma unroll
                for (int r = 0; r < 3; ++r) {
                    const unsigned long long cand = ptr == 0 ? best0 : ptr == 1 ? best1 : ptr == 2 ? best2 : 0ull;
                    unsigned long long g = cand; { const unsigned long long o = shfl_xor_u64(g, 16); g = o > g ? o : g; } { const unsigned long long o = shfl_xor_u64(g, 32); g = o > g ? o : g; }
                    if (g != 0ull && cand == g) ++ptr;
                    if (fq == r && g != 0ull) myn = 63 - (int)(unsigned)(g & 0xffffffffull);
                }
                if (fq == 3) myn = qb;
                int lp = 0;
                if (myn >= 0) lp = __hip_atomic_fetch_add(lcnt4 + kk * 64 + myn, 1, __ATOMIC_RELAXED, __HIP_MEMORY_SCOPE_WORKGROUP);
                pend_n[(kk * 2 + tt) * 512 + tid] = myn; pend_lp[(kk * 2 + tt) * 512 + tid] = lp;
            }
#pragma unroll
            for (int tt = 0; tt < 2; ++tt)
#pragma unroll
                for (int k = 0; k < 4; ++k) qcur[tt][k] = qnxt[tt][k];
        }
        __syncthreads();
        if (tid < 256) { const int c = lcnt4[tid]; gbase4[tid] = c ? atomicAdd(cnt + bh * 64 + (tid & 63), c) : 0; }
        __syncthreads();
#pragma unroll 1
        for (int e = 0; e < 8; ++e) { const int kk = e >> 1, tt = e & 1; const int myn = pend_n[e * 512 + tid];
            if (myn >= 0) { const int s = (qb0 + kk) * 256 + (wave * 2 + tt) * 16 + fr;
                list[(size_t)bh * LIST_PER_BH + list_base(myn) + gbase4[kk * 64 + myn] + pend_lp[e * 512 + tid]] = (unsigned)s | ((unsigned)fq << 14); } }
        __syncthreads();
    }
}

__device__ __forceinline__ float sq8(u32x4 v) {
    const float a = bflo(v.x), b = bfhi(v.x), c = bflo(v.y), d = bfhi(v.y), e = bflo(v.z), f = bfhi(v.z), g = bflo(v.w), h = bfhi(v.w);
    return ((a * a + b * b) + (c * c + d * d)) + ((e * e + f * f) + (g * g + h * h)); }
__device__ __forceinline__ void stage_kv(LAS unsigned char* Kl, LAS unsigned char* Vl, const bf16_t* Kg, const bf16_t* Vg, int stride, int tid, LAS float* kmx) {
    float nmax = 0.f;
#pragma unroll
    for (int it = 0; it < 8; ++it) { const int q = tid + 512 * it, c = q & 15, r = q >> 4;
        const u32x4 v = *(const u32x4*)(Kg + (size_t)r * stride + 8 * c);
        *(LAS u32x4*)(Kl + r * 256 + ((c ^ (r & 15)) << 4)) = v;
        float n2 = sq8(v); n2 += __shfl_xor(n2, 1); n2 += __shfl_xor(n2, 2); n2 += __shfl_xor(n2, 4); n2 += __shfl_xor(n2, 8);
        nmax = fmaxf(nmax, n2); }
    nmax = fmaxf(nmax, __shfl_xor(nmax, 16)); nmax = fmaxf(nmax, __shfl_xor(nmax, 32));
    if ((tid & 63) == 0) kmx[tid >> 6] = nmax;
#pragma unroll
    for (int it = 0; it < 4; ++it) { const int q = tid + 512 * it, c = q & 15, kp = q >> 4, kq = 2 * kp;
        const int key = (kq & 0xE0) | (((kq >> 2) & 1) << 4) | (((kq >> 3) & 3) << 2) | (kq & 3);
        const u32x4 v0 = *(const u32x4*)(Vg + (size_t)key * stride + 8 * c), v1 = *(const u32x4*)(Vg + (size_t)(key + 1) * stride + 8 * c);
        const unsigned a0[4] = {v0.x, v0.y, v0.z, v0.w}, a1[4] = {v1.x, v1.y, v1.z, v1.w};
#pragma unroll
        for (int i = 0; i < 8; ++i) { const int d = 8 * c + i;
            const unsigned lo = (i & 1) ? (a0[i >> 1] >> 16) : (a0[i >> 1] & 0xffffu), hi = (i & 1) ? (a1[i >> 1] & 0xffff0000u) : (a1[i >> 1] << 16);
            *(LAS unsigned*)(Vl + d * 512 + ((((kq >> 3)) ^ (d & 15)) << 4) + (kq & 7) * 2) = lo | hi; } }
}
__device__ __forceinline__ float kmax_of(const LAS float* kmx) {
    float m = kmx[0];
#pragma unroll
    for (int i = 1; i < 8; ++i) m = fmaxf(m, kmx[i]);
    return sqrtf(m) * 1.002f; }

__device__ __forceinline__ float qnorm(const bf16x8 (&qf)[4]) {
    float qq = 0.f;
#pragma unroll
    for (int k = 0; k < 4; ++k) qq += sq8(__builtin_bit_cast(u32x4, qf[k]));
    qq += __shfl_xor(qq, 16); qq += __shfl_xor(qq, 32);
    return sqrtf(qq); }
#define AT_SCHED() __builtin_amdgcn_sched_barrier(0)
#define AT_LOADK(S) do { _Pragma("unroll") for (int k = 0; k < 4; ++k) { kf[2 * k] = *(const LAS bf16x8*)(Kl + kb[k] + (S) * 8192); kf[2 * k + 1] = *(const LAS bf16x8*)(Kl + kb[k] + (S) * 8192 + 4096); } } while (0)
#define AT_LOADV(S) do { const unsigned vb = (unsigned)fr * 512u + ((unsigned)((4 * (S) + fq) ^ fr) << 4); _Pragma("unroll") for (int dt = 0; dt < 8; ++dt) vf[dt] = *(const LAS bf16x8*)(Vl + vb + dt * 8192); } while (0)
__device__ __forceinline__ void attn_core(const LAS unsigned char* Kl, const LAS unsigned char* Vl, const bf16x8 (&qf)[4], int fr, int fq, bool do_mask, int qrel, int smax, float kmax,
                                          f32x4 (&oacc)[8], float& m_out, float& l_out) {
    asm volatile("" : "+v"(fr), "+v"(fq));
    unsigned kb[4];
#pragma unroll
    for (int k = 0; k < 4; ++k) kb[k] = (unsigned)fr * 256u + ((unsigned)((4 * k + fq) ^ fr) << 4);
    bf16x8 kf[8], vf[8];
    AT_LOADK(0); AT_LOADV(0);
    const float m = kmax;
    float l = 0.f;
#pragma unroll
    for (int dt = 0; dt < 8; ++dt) oacc[dt] = (f32x4){0.f, 0.f, 0.f, 0.f};
    f32x4 c0 = (f32x4){-m, -m, -m, -m}, c1 = c0;
    AT_SCHED();
#pragma unroll
    for (int k = 0; k < 4; ++k) { c0 = __builtin_amdgcn_mfma_f32_16x16x32_bf16(kf[2 * k], qf[k], c0, 0, 0, 0); c1 = __builtin_amdgcn_mfma_f32_16x16x32_bf16(kf[2 * k + 1], qf[k], c1, 0, 0, 0); }
    AT_SCHED();
    if (1 < smax) AT_LOADK(1);
#pragma unroll
    for (int s = 0; s < 8; ++s) {
        if (s < smax) {
            AT_SCHED();
            f32x4 n0 = (f32x4){-m, -m, -m, -m}, n1 = n0;
            if (s + 1 < smax) {
#pragma unroll
                for (int k = 0; k < 4; ++k) { n0 = __builtin_amdgcn_mfma_f32_16x16x32_bf16(kf[2 * k], qf[k], n0, 0, 0, 0); n1 = __builtin_amdgcn_mfma_f32_16x16x32_bf16(kf[2 * k + 1], qf[k], n1, 0, 0, 0); }
            }
            AT_SCHED();
            if (s + 2 < smax) AT_LOADK(s + 2);
            AT_SCHED();
            float p[8] = {c0.x, c0.y, c0.z, c0.w, c1.x, c1.y, c1.z, c1.w};
            if (do_mask) {
#pragma unroll
                for (int j = 0; j < 4; ++j) { if (32 * s + 4 * fq + j > qrel) p[j] = -INFINITY; if (32 * s + 16 + 4 * fq + j > qrel) p[4 + j] = -INFINITY; }
            }
#pragma unroll
            for (int j = 0; j < 8; ++j) p[j] = fast_exp2(p[j]);
            l += ((p[0] + p[1]) + (p[2] + p[3])) + ((p[4] + p[5]) + (p[6] + p[7]));
            u32x4 w; w.x = cvt_pk_bf16(p[0], p[1]); w.y = cvt_pk_bf16(p[2], p[3]); w.z = cvt_pk_bf16(p[4], p[5]); w.w = cvt_pk_bf16(p[6], p[7]);
            const bf16x8 pb = __builtin_bit_cast(bf16x8, w);
            AT_SCHED();
#pragma unroll
            for (int dt = 0; dt < 8; ++dt) oacc[dt] = __builtin_amdgcn_mfma_f32_16x16x32_bf16(vf[dt], pb, oacc[dt], 0, 0, 0);
            AT_SCHED();
            if (s + 1 < smax) AT_LOADV(s + 1);
            c0 = n0; c1 = n1;
        }
    }
    AT_SCHED();
    l += __shfl_xor(l, 16); l += __shfl_xor(l, 32);
    m_out = m; l_out = l;
}

__device__ __forceinline__ void phase3(const Args& a, LAS unsigned char* lds) {
    unsigned char* ws = a.ws;
    const int tid = threadIdx.x, lane = tid & 63, wave = __builtin_amdgcn_readfirstlane(tid >> 6), fr = lane & 15, fq = lane >> 4;
    const int fr_ = fr, fq_ = fq, lane_ = lane, tid_ = tid;
    const bf16_t* proj = (const bf16_t*)(ws + WS_PROJ);
    const int* cnt = (const int*)(ws + WS_CNT);
    const unsigned* list = (const unsigned*)(ws + WS_LIST);
    bf16_t* PO = (bf16_t*)(ws + WS_PO); f32x2* PML = (f32x2*)(ws + WS_PML);
    bf16_t* Y = (bf16_t*)(ws + WS_Y);
    LAS unsigned char* Kl = lds; LAS unsigned char* Vl = lds + 65536;
    LAS int* pre = (LAS int*)(lds + 131072);
    LAS float* kmx = (LAS float*)(lds + 131072 + 12288);
    LAS int* prp = (LAS int*)(lds + 131072 + 4352);
    LAS int* nxt = (LAS int*)(lds + 131072 + 12288 + 64);
    if (wave == 0) {
        int locf[16], locp[16]; int sumf = 0, sump = 0;
#pragma unroll
        for (int i = 0; i < 16; ++i) { const int c = cnt[lane * 16 + i]; locf[i] = c / QCH; locp[i] = (c % QCH) ? 1 : 0; sumf += locf[i]; sump += locp[i]; }
        int incf = sumf, incp = sump;
#pragma unroll
        for (int o = 1; o < 64; o <<= 1) { const int vf_ = __shfl_up(incf, o), vp_ = __shfl_up(incp, o); if (lane >= o) { incf += vf_; incp += vp_; } }
        int runf = incf - sumf, runp = incp - sump;
#pragma unroll
        for (int i = 0; i < 16; ++i) { pre[lane * 16 + i] = runf; prp[lane * 16 + i] = runp; runf += locf[i]; runp += locp[i]; }
        if (lane == 63) { pre[1024] = runf; prp[1024] = runp; }
    }
    __syncthreads();
    const int nfull = pre[1024], npart = prp[1024];
    int* ticket = (int*)(ws + WS_CNT) + 1024;
    int it_static = blockIdx.x; bool dyn = false;
    for (;;) {
        int idx = 0;
        if (!dyn) { if (it_static < nfull) { idx = it_static; it_static += gridDim.x; } else dyn = true; }
        if (dyn) {
            __syncthreads();
            if (tid == 0) nxt[0] = atomicAdd(ticket, 1);
            __syncthreads();
            idx = nxt[0];
            if (idx >= npart) break;
            idx += nfull;
        }
        int u, c;
        if (idx < nfull) { int lo = 0, hi = 1024; while (hi - lo > 1) { const int mid = (lo + hi) >> 1; if (pre[mid] <= idx) lo = mid; else hi = mid; } u = lo; c = idx - pre[u]; }
        else { const int j = idx - nfull; int lo = 0, hi = 1024; while (hi - lo > 1) { const int mid = (lo + hi) >> 1; if (prp[mid] <= j) lo = mid; else hi = mid; } u = lo; c = cnt[u] / QCH; }
        const int bh = u >> 6, n = u & 63, b = bh >> 3, h = bh & 7;
        int tid = tid_, fr = fr_, fq = fq_; asm volatile("" : "+v"(tid), "+v"(fr), "+v"(fq));
        const int count = cnt[u], qbase = c * QCH;
        const int ntile = min(QCH / 16, (count - qbase + 15) >> 4);
        const unsigned* lp = list + (size_t)bh * LIST_PER_BH + list_base(n);
        const bf16_t* qb0 = proj + (size_t)(b * SEQ) * DIN + h * 128 + 8 * fq;
        int tile = wave;
        unsigned ent_c = 0u, ent_n = 0u;
        if (tile < ntile) ent_c = lp[min(qbase + tile * 16 + fr, count - 1)];
        if (tile + 8 < ntile) ent_n = lp[min(qbase + (tile + 8) * 16 + fr, count - 1)];
        __syncthreads();
        const bf16_t* Kg = proj + (size_t)(b * SEQ + n * 256) * DIN + C_K + h * 128;
        stage_kv(Kl, Vl, Kg, Kg + (C_V - C_K), DIN, tid, kmx);
        bf16x8 qc[4];
        { const bf16_t* qp = qb0 + (size_t)(ent_c & 0x3fffu) * DIN;
#pragma unroll
          for (int k = 0; k < 4; ++k) qc[k] = *(const bf16x8*)(qp + 32 * k); }
        float qn_c = qnorm(qc);
        __syncthreads();
        const float kmax = kmax_of(kmx);
        for (; tile < ntile; tile += 8) {
            bf16x8 qn[4]; unsigned ent_nn = 0u;
#pragma unroll
            for (int k = 0; k < 4; ++k) qn[k] = qc[k];
            if (tile + 8 < ntile) {
                const bf16_t* qp = qb0 + (size_t)(ent_n & 0x3fffu) * DIN;
#pragma unroll
                for (int k = 0; k < 4; ++k) qn[k] = *(const bf16x8*)(qp + 32 * k);
                if (tile + 16 < ntile) ent_nn = lp[min(qbase + (tile + 16) * 16 + fr, count - 1)];
            }
            const bool valid = qbase + tile * 16 + fr < count;
            const int sq = (int)(ent_c & 0x3fffu), slot = (int)(ent_c >> 14);
            const bool do_mask = __any(slot == 3);
            const int qrel = sq - n * 256;
            int smax = 8;
            if (do_mask) { int qm = qrel;
#pragma unroll
                for (int o = 1; o < 64; o <<= 1) qm = max(qm, __shfl_xor(qm, o));
                smax = min(8, (qm >> 5) + 1); }
            smax = __builtin_amdgcn_readfirstlane(smax);
            f32x4 oacc[8]; float mx, l;
            attn_core(Kl, Vl, qc, fr, fq, do_mask, qrel, smax, qn_c * kmax, oacc, mx, l);
            qn_c = qnorm(qn);
            __builtin_amdgcn_sched_barrier(0);
            if (valid) {
                const size_t pidx = ((size_t)bh * SEQ + sq) * 4 + slot;
                bf16_t* op = PO + pidx * 128 + 4 * fq;
#pragma unroll
                for (int dt = 0; dt < 8; ++dt) { u32x2 w; w.x = cvt_pk_bf16(oacc[dt][0], oacc[dt][1]); w.y = cvt_pk_bf16(oacc[dt][2], oacc[dt][3]); *(u32x2*)(op + 16 * dt) = w; }
                if (fq == 0) PML[pidx] = (f32x2){mx, l};
            }
            ent_c = ent_n; ent_n = ent_nn;
#pragma unroll
            for (int k = 0; k < 4; ++k) qc[k] = qn[k];
        }
    }
    const bf16_t* mkv = (const bf16_t*)(ws + WS_MKV);
    for (int item = blockIdx.x; item < BATCH * 4 * (SEQ / MQCH); item += gridDim.x) {
        const int c = item & 31, hm = (item >> 5) & 3, b = item >> 7;
        int tid = tid_, fr = fr_, fq = fq_; asm volatile("" : "+v"(tid), "+v"(fr), "+v"(fq));
        __syncthreads();
        const bf16_t* Kg = mkv + (size_t)(b * MEMLEN) * 1024 + hm * 128;
        stage_kv(Kl, Vl, Kg, Kg + 512, 1024, tid, kmx);
        const bf16_t* qb0 = proj + (size_t)(b * SEQ + c * MQCH + fr) * DIN + C_QME + hm * 128 + 8 * fq;
        bf16x8 qc[4];
#pragma unroll
        for (int k = 0; k < 4; ++k) qc[k] = *(const bf16x8*)(qb0 + (size_t)(wave * 16) * DIN + 32 * k);
        float qn_c = qnorm(qc);
        __syncthreads();
        const float kmax = kmax_of(kmx);
        for (int tile = wave; tile < MQCH / 16; tile += 8) {
            bf16x8 qn[4];
#pragma unroll
            for (int k = 0; k < 4; ++k) qn[k] = qc[k];
            if (tile + 8 < MQCH / 16) {
#pragma unroll
                for (int k = 0; k < 4; ++k) qn[k] = *(const bf16x8*)(qb0 + (size_t)((tile + 8) * 16) * DIN + 32 * k); }
            const int sq = c * MQCH + tile * 16 + fr; const size_t row = (size_t)(b * SEQ + sq);
            f32x4 oacc[8]; float mx, l;
            attn_core(Kl, Vl, qc, fr, fq, false, 0, 8, qn_c * kmax, oacc, mx, l);
            qn_c = qnorm(qn);
            __builtin_amdgcn_sched_barrier(0);
            const float rl = 1.f / l;
            const bf16_t* gp = proj + row * DIN + C_GME + hm * 128 + 4 * fq;
            bf16_t* yp = Y + row * DM + 1536 + hm * 128 + 4 * fq;
            u32x2 gv[8];
#pragma unroll
            for (int dt = 0; dt < 8; ++dt) gv[dt] = *(const u32x2*)(gp + 16 * dt);
            __builtin_amdgcn_sched_barrier(0);
#pragma unroll
            for (int dt = 0; dt < 8; ++dt) { const u32x2 g = gv[dt];
                u32x2 w; w.x = cvt_pk_bf16(oacc[dt][0] * rl * bflo(g.x), oacc[dt][1] * rl * bfhi(g.x)); w.y = cvt_pk_bf16(oacc[dt][2] * rl * bflo(g.y), oacc[dt][3] * rl * bfhi(g.y));
                *(u32x2*)(yp + 16 * dt) = w; }
#pragma unroll
            for (int k = 0; k < 4; ++k) qc[k] = qn[k];
        }
    }
    const bf16_t* wsb = (const bf16_t*)(ws + WS_WSB);
    for (int item = blockIdx.x; item < BATCH * (SEQ / 128); item += gridDim.x) {
        const size_t row0 = (size_t)item * 128;
        int fr = fr_, fq = fq_, lane = lane_; asm volatile("" : "+v"(fr), "+v"(fq), "+v"(lane));
        __syncthreads();
        {
            const f32x4 g0 = *(const f32x4*)(a.gln_g + 8 * lane), g1 = *(const f32x4*)(a.gln_g + 8 * lane + 4), b0 = *(const f32x4*)(a.gln_b + 8 * lane), b1 = *(const f32x4*)(a.gln_b + 8 * lane + 4);
            u32x4 raw[16];
#pragma unroll
            for (int i = 0; i < 16; ++i) raw[i] = *(const u32x4*)(proj + (row0 + wave + 8 * i) * DIN + C_VG + 8 * lane);
#pragma unroll
            for (int i = 0; i < 16; ++i) {
                const int tk = wave + 8 * i;
                float v[8] = {bflo(raw[i].x), bfhi(raw[i].x), bflo(raw[i].y), bfhi(raw[i].y), bflo(raw[i].z), bfhi(raw[i].z), bflo(raw[i].w), bfhi(raw[i].w)};
                float sm = 0.f;
#pragma unroll
                for (int e = 0; e < 8; ++e) sm += v[e];
#pragma unroll
                for (int o = 1; o < 64; o <<= 1) sm += __shfl_xor(sm, o);
                const float mu = sm * (1.f / 512.f); float q = 0.f;
#pragma unroll
                for (int e = 0; e < 8; ++e) { v[e] -= mu; q += v[e] * v[e]; }
#pragma unroll
                for (int o = 1; o < 64; o <<= 1) q += __shfl_xor(q, o);
                const float rstd = 1.f / sqrtf(q * (1.f / 512.f) + LN_EPS);
#pragma unroll
                for (int e = 0; e < 8; ++e) { const float o = v[e] * rstd * (e < 4 ? g0[e] : g1[e - 4]) + (e < 4 ? b0[e] : b1[e - 4]);
                    *(LAS bf16_t*)(lds + (8 * lane + e) * 272 + tk * 2) = (bf16_t)(cvt_pk_bf16(o, 0.f) & 0xffffu); }
            }
        }
        __syncthreads();
        const int g = wave >> 1, th = wave & 1;
        f32x4 acc[8][4];
#pragma unroll
        for (int ct = 0; ct < 8; ++ct)
#pragma unroll
            for (int tt = 0; tt < 4; ++tt) acc[ct][tt] = (f32x4){0.f, 0.f, 0.f, 0.f};
#pragma unroll
        for (int k = 0; k < 4; ++k) {
            bf16x8 wf[4];
#pragma unroll
            for (int tt = 0; tt < 4; ++tt) wf[tt] = *(const bf16x8*)(wsb + (size_t)(g * 128 + 64 * th + 16 * tt + fr) * 128 + 32 * k + 8 * fq);
#pragma unroll
            for (int ct = 0; ct < 8; ++ct) { const bf16x8 av = *(const LAS bf16x8*)(lds + (128 * g + 16 * ct + fr) * 272 + (32 * k + 8 * fq) * 2);
#pragma unroll
                for (int tt = 0; tt < 4; ++tt) acc[ct][tt] = __builtin_amdgcn_mfma_f32_16x16x32_bf16(av, wf[tt], acc[ct][tt], 0, 0, 0); }
        }
#pragma unroll
        for (int tt = 0; tt < 4; ++tt) { const int t = 64 * th + 16 * tt + fr; const float bs = a.b_s[g * 128 + t]; const size_t row = row0 + t;
            u32x2 uuv[8], ggv[8];
#pragma unroll
            for (int ct = 0; ct < 8; ++ct) { const int ch = 128 * g + 16 * ct + 4 * fq; uuv[ct] = *(const u32x2*)(proj + row * DIN + C_U + ch); ggv[ct] = *(const u32x2*)(proj + row * DIN + C_GG + ch); }
            __builtin_amdgcn_sched_barrier(0);
#pragma unroll
            for (int ct = 0; ct < 8; ++ct) { const int ch = 128 * g + 16 * ct + 4 * fq;
                const u32x2 uu = uuv[ct], gg = ggv[ct];
                const f32x4 m = acc[ct][tt] + bs;
                u32x2 w; w.x = cvt_pk_bf16(bflo(uu.x) * m[0] * bflo(gg.x), bfhi(uu.x) * m[1] * bfhi(gg.x)); w.y = cvt_pk_bf16(bflo(uu.y) * m[2] * bflo(gg.y), bfhi(uu.y) * m[3] * bfhi(gg.y));
                *(u32x2*)(Y + row * DM + 1024 + ch) = w; } }
    }
}

__device__ __forceinline__ void phase4(const Args& a) {
    unsigned char* ws = a.ws;
    const int tid = threadIdx.x, lane = tid & 63, wave = tid >> 6;
    const bf16_t* proj = (const bf16_t*)(ws + WS_PROJ);
    const bf16_t* PO = (const bf16_t*)(ws + WS_PO); const f32x2* PML = (const f32x2*)(ws + WS_PML);
    bf16_t* Y = (bf16_t*)(ws + WS_Y);
    const int rl_ = lane >> 3, d0 = (lane & 7) * 16;
    const int nw = gridDim.x * 8;
    for (int t0 = blockIdx.x * 8 + wave; t0 < 16 * (SEQ / 8); t0 += 2 * nw) {
        f32x2 ml[2][4]; u32x4 pp[2][4][2]; u32x4 gg[2][2];
#pragma unroll
        for (int r = 0; r < 2; ++r) {
            const int t = (t0 + r * nw < 16 * (SEQ / 8)) ? t0 + r * nw : t0;
            const int bh = t / (SEQ / 8), s = (t % (SEQ / 8)) * 8 + rl_, b = bh >> 3, h = bh & 7, qb = s >> 8, nv = qb < 3 ? qb : 3;
            const size_t pbase = ((size_t)bh * SEQ + s) * 4; const size_t row = (size_t)b * SEQ + s;
#pragma unroll
            for (int j = 0; j < 4; ++j) { const bool ok = (j == 3) || (j < nv);
                ml[r][j] = ok ? PML[pbase + j] : (f32x2){-INFINITY, 0.f};
                if (ok) { pp[r][j][0] = *(const u32x4*)(PO + (pbase + j) * 128 + d0); pp[r][j][1] = *(const u32x4*)(PO + (pbase + j) * 128 + d0 + 8); }
                else { pp[r][j][0] = (u32x4){0u, 0u, 0u, 0u}; pp[r][j][1] = pp[r][j][0]; } }
            gg[r][0] = *(const u32x4*)(proj + row * DIN + C_GMO + h * 128 + d0); gg[r][1] = *(const u32x4*)(proj + row * DIN + C_GMO + h * 128 + d0 + 8);
        }
        __builtin_amdgcn_sched_barrier(0);
#pragma unroll
        for (int r = 0; r < 2; ++r) {
            const int t = t0 + r * nw;
            if (t < 16 * (SEQ / 8)) {
                const int bh = t / (SEQ / 8), s = (t % (SEQ / 8)) * 8 + rl_, b = bh >> 3, h = bh & 7; const size_t row = (size_t)b * SEQ + s;
                float M = -INFINITY;
#pragma unroll
                for (int j = 0; j < 4; ++j) M = fmaxf(M, ml[r][j].x);
                float o[16]; float L = 0.f;
#pragma unroll
                for (int e = 0; e < 16; ++e) o[e] = 0.f;
#pragma unroll
                for (int j = 0; j < 4; ++j) { const float w = fast_exp2(ml[r][j].x - M); L += w * ml[r][j].y;
                    const u32x4 p0 = pp[r][j][0], p1 = pp[r][j][1];
                    o[0] += w * bflo(p0.x); o[1] += w * bfhi(p0.x); o[2] += w * bflo(p0.y); o[3] += w * bfhi(p0.y); o[4] += w * bflo(p0.z); o[5] += w * bfhi(p0.z); o[6] += w * bflo(p0.w); o[7] += w * bfhi(p0.w);
                    o[8] += w * bflo(p1.x); o[9] += w * bfhi(p1.x); o[10] += w * bflo(p1.y); o[11] += w * bfhi(p1.y); o[12] += w * bflo(p1.z); o[13] += w * bfhi(p1.z); o[14] += w * bflo(p1.w); o[15] += w * bfhi(p1.w); }
                const float rl = 1.f / L;
                const u32x4 g0 = gg[r][0], g1 = gg[r][1];
                u32x4 w0, w1;
                w0.x = cvt_pk_bf16(o[0] * rl * bflo(g0.x), o[1] * rl * bfhi(g0.x)); w0.y = cvt_pk_bf16(o[2] * rl * bflo(g0.y), o[3] * rl * bfhi(g0.y));
                w0.z = cvt_pk_bf16(o[4] * rl * bflo(g0.z), o[5] * rl * bfhi(g0.z)); w0.w = cvt_pk_bf16(o[6] * rl * bflo(g0.w), o[7] * rl * bfhi(g0.w));
                w1.x = cvt_pk_bf16(o[8] * rl * bflo(g1.x), o[9] * rl * bfhi(g1.x)); w1.y = cvt_pk_bf16(o[10] * rl * bflo(g1.y), o[11] * rl * bfhi(g1.y));
                w1.z = cvt_pk_bf16(o[12] * rl * bflo(g1.z), o[13] * rl * bfhi(g1.z)); w1.w = cvt_pk_bf16(o[14] * rl * bflo(g1.w), o[15] * rl * bfhi(g1.w));
                *(u32x4*)(Y + row * DM + h * 128 + d0) = w0; *(u32x4*)(Y + row * DM + h * 128 + d0 + 8) = w1;
            }
        }
        __builtin_amdgcn_sched_barrier(0);
    }
}

__device__ __forceinline__ void phase6(const Args& a) {
    const int tid = threadIdx.x, lane = tid & 63, wave = tid >> 6;
    const bf16_t* sub = (const bf16_t*)(a.ws + WS_SUB);
    for (int row = blockIdx.x * 8 + wave; row < MROWS; row += gridDim.x * 8) {
        const f32x4* xp = (const f32x4*)(a.x + (size_t)row * DM) + lane;
        const u32x2* sp = (const u32x2*)(sub + (size_t)row * DM) + lane;
        f32x4* rp = (f32x4*)(a.out + (size_t)row * DM) + lane;
        f32x4 v[8]; u32x2 sv[8]; float s = 0.f;
#pragma unroll
        for (int j = 0; j < 8; ++j) { v[j] = xp[64 * j]; sv[j] = sp[64 * j]; }
#pragma unroll
        for (int j = 0; j < 8; ++j) { v[j] = v[j] * ALPHA + (f32x4){bflo(sv[j].x), bfhi(sv[j].x), bflo(sv[j].y), bfhi(sv[j].y)}; s += (v[j][0] + v[j][1]) + (v[j][2] + v[j][3]); }
#pragma unroll
        for (int o = 1; o < 64; o <<= 1) s += __shfl_xor(s, o);
        const float mu = s * (1.f / DM); float q = 0.f;
#pragma unroll
        for (int j = 0; j < 8; ++j) { v[j] = v[j] - mu; q += (v[j][0] * v[j][0] + v[j][1] * v[j][1]) + (v[j][2] * v[j][2] + v[j][3] * v[j][3]); }
#pragma unroll
        for (int o = 1; o < 64; o <<= 1) q += __shfl_xor(q, o);
        const float rstd = 1.f / sqrtf(q * (1.f / DM) + LN_EPS);
#pragma unroll
        for (int j = 0; j < 8; ++j) { const f32x4 g = ((const f32x4*)a.ln_g)[lane + 64 * j], bb = ((const f32x4*)a.ln_b)[lane + 64 * j]; rp[64 * j] = v[j] * rstd * g + bb; }
    }
}

#define XB_TMO      128
#define XB_XCNT(j)  (256  + 64 * (j))
#define XB_XSUB(j)  (1280 + 64 * (j))
#define XB_XGEN(j)  (2304 + 64 * (j))
#define XB_TOP      3328
#define XB_TOPGEN   3392
#define XCD_BAR_WORDS 3456
#define XB_SPIN_CAP (1u << 18)
__device__ __forceinline__ unsigned xb_ld(unsigned* p)              { return __hip_atomic_load(p, __ATOMIC_RELAXED, __HIP_MEMORY_SCOPE_AGENT); }
__device__ __forceinline__ unsigned xb_add(unsigned* p, unsigned v) { return __hip_atomic_fetch_add(p, v, __ATOMIC_RELAXED, __HIP_MEMORY_SCOPE_AGENT); }
__device__ __forceinline__ unsigned xb_xcc_id() { return (unsigned)__builtin_amdgcn_s_getreg((3 << 11) | 20) & 0xFu; }
#define XB_SPIN(cond, bar) do { unsigned _sp = 0; while (cond) { __builtin_amdgcn_s_sleep(1); \
    if ((++_sp & 255u) == 0u) { if (xb_ld(&(bar)[XB_TMO])) break; if (_sp > XB_SPIN_CAP) { atomicAdd(&(bar)[XB_TMO], 1u); break; } } } } while (0)
struct XcdBarrier { unsigned* bar; unsigned x; volatile LAS unsigned* st; };
__device__ __forceinline__ XcdBarrier xcd_barrier_post(unsigned* bar, volatile LAS unsigned* st) {
    XcdBarrier b; b.bar = bar; b.x = xb_xcc_id(); b.st = st;
    if (threadIdx.x == 0) (void)xb_add(&bar[XB_XCNT(b.x)], 1u);
    return b;
}
__device__ __forceinline__ void xcd_barrier_complete(unsigned* bar, unsigned x, unsigned& nloc, unsigned& nx) {
    const unsigned G = gridDim.x * gridDim.y * gridDim.z;
    unsigned sum, cnt, mine, sp = 0u;
    for (;;) {
        sum = 0u; cnt = 0u; mine = 0u;
#pragma unroll
        for (unsigned j = 0; j < 16; ++j) { const unsigned c = xb_ld(&bar[XB_XCNT(j)]); sum += c; cnt += (c > 0u) ? 1u : 0u; mine = (j == x) ? c : mine; }
        if (sum == G) break;
        __builtin_amdgcn_s_sleep(1);
        if ((++sp & 255u) == 0u) { if (xb_ld(&bar[XB_TMO])) break; if (sp > XB_SPIN_CAP) { atomicAdd(&bar[XB_TMO], 1u); break; } }
    }
    nloc = mine > 0u ? mine : 1u; nx = cnt > 0u ? cnt : 1u;
}
__device__ __forceinline__ void xcd_barrier(const XcdBarrier& b) {
    asm volatile("s_waitcnt vmcnt(0)" ::: "memory");
    __syncthreads();
    if (threadIdx.x == 0) {
        unsigned* bar = b.bar;
        __builtin_amdgcn_s_waitcnt(0);
        unsigned nloc = b.st[0], nx = b.st[1];
        if (nloc == 0u) { xcd_barrier_complete(bar, b.x, nloc, nx); b.st[0] = nloc; b.st[1] = nx; }
        const unsigned old = xb_add(&bar[XB_XSUB(b.x)], 1u);
        const unsigned gen = old / nloc;
        if (old + 1u == (gen + 1u) * nloc) {
            __builtin_amdgcn_fence(__ATOMIC_RELEASE, "agent");
            asm volatile("s_waitcnt vmcnt(0)" ::: "memory");
            const unsigned og = xb_add(&bar[XB_TOP], 1u);
            const unsigned tg = og / nx;
            if (og + 1u == (tg + 1u) * nx) xb_add(&bar[XB_TOPGEN], 1u);
            else XB_SPIN(xb_ld(&bar[XB_TOPGEN]) == tg, bar);
            __builtin_amdgcn_fence(__ATOMIC_ACQUIRE, "agent");
            xb_add(&bar[XB_XGEN(b.x)], 1u);
            asm volatile("s_waitcnt vmcnt(0)" ::: "memory");
        } else {
            XB_SPIN(xb_ld(&bar[XB_XGEN(b.x)]) == gen, bar);
            __builtin_amdgcn_fence(__ATOMIC_ACQUIRE, "agent");
            asm volatile("s_waitcnt vmcnt(0)" ::: "memory");
        }
    }
    __syncthreads();
}

__global__ void __launch_bounds__(512, 2) hymba_fwd(Args a) {
    extern __shared__ __attribute__((aligned(16))) unsigned char lds_raw[];
    LAS unsigned char* lds = (LAS unsigned char*)lds_raw;
    unsigned char* ws = a.ws;
    const int lo = a.ph_lo, hi = a.ph_hi, G = gridDim.x;
#define IN(k) (lo <= (k) && (k) < hi)
#define SEAM(k) do { if (IN(k) && IN((k) + 1)) xcd_barrier(xbar); } while (0)
    volatile LAS unsigned* xst = (volatile LAS unsigned*)(lds + LDS_BYTES - 64);
    if (threadIdx.x < 2) xst[threadIdx.x] = 0u;
    __syncthreads();
    XcdBarrier xbar; xbar.bar = (unsigned*)(ws + WS_BAR); xbar.x = 0; xbar.st = xst;
    if (IN(0) && IN(1)) xbar = xcd_barrier_post((unsigned*)(ws + WS_BAR), xst);
    if (IN(0)) phase0(a, lds);
    SEAM(0);
    if (IN(1)) {
        { pg8::Gemm g{(const bf16_t*)(ws + WS_XB), (const bf16_t*)(ws + WS_WIN), MROWS, DIN, DM}; pg8::StaticOrder S; S.init(g.M, g.N, G, (int)blockIdx.x);
          EpiProj E{(bf16_t*)(ws + WS_PROJ), (const float*)(ws + WS_COS), (const float*)(ws + WS_SIN), (float*)(ws + WS_KSUM)};
          pg8::gemm_phase<EpiProj, pg8::StaticOrder, true, true>(lds, g, S, E); }
    }
    SEAM(1);
    if (IN(2)) phase2(a, lds);
    SEAM(2);
    if (IN(3)) phase3(a, lds);
    SEAM(3);
    if (IN(4)) phase4(a);
    SEAM(4);
    if (IN(5)) {
        pg8::Gemm g{(const bf16_t*)(ws + WS_Y), (const bf16_t*)(ws + WS_WOUT), MROWS, DM, DM}; pg8::StaticOrder S; S.init(g.M, g.N, G, (int)blockIdx.x);
        EpiPlain E{(bf16_t*)(ws + WS_SUB), DM};
        pg8::gemm_phase<EpiPlain, pg8::StaticOrder, true, true>(lds, g, S, E);
    }
    SEAM(5);
    if (IN(6)) phase6(a);
#undef IN
#undef SEAM
}

extern "C" void kernel_launch(void* const* d_in, const int* in_sizes, int n_in, void* d_out, int out_size, void* d_ws, size_t ws_size, hipStream_t stream) {
    static int grid = 0;
    if (grid == 0) {
        if (n_in != 12 || ws_size < WS_END) { fprintf(stderr, "kernel_launch: unexpected inputs (n_in %d, ws %zu)\n", n_in, ws_size); grid = -1; return; }
        int dev = 0, cus = 0, per_cu = 0;
        hipGetDevice(&dev); hipDeviceGetAttribute(&cus, hipDeviceAttributeMultiprocessorCount, dev);
        hipFuncSetAttribute((const void*)hymba_fwd, hipFuncAttributeMaxDynamicSharedMemorySize, LDS_BYTES);
        hipOccupancyMaxActiveBlocksPerMultiprocessor(&per_cu, (const void*)hymba_fwd, 512, LDS_BYTES);
        if (per_cu < 1) { fprintf(stderr, "kernel_launch: occupancy query reports %d blocks per CU\n", per_cu); per_cu = 1; }
        grid = cus * per_cu;
        (void)hipGetLastError();
    }
    if (grid < 0) return;
    Args a{};
    a.x = (const float*)d_in[0]; a.mem = (const float*)d_in[1]; a.pos = (const int*)d_in[2]; a.w_in = (const float*)d_in[3]; a.w_mkv = (const float*)d_in[4];
    a.gln_g = (const float*)d_in[5]; a.gln_b = (const float*)d_in[6]; a.w_s = (const float*)d_in[7]; a.b_s = (const float*)d_in[8]; a.w_out = (const float*)d_in[9];
    a.ln_g = (const float*)d_in[10]; a.ln_b = (const float*)d_in[11]; a.out = (float*)d_out; a.ws = (unsigned char*)d_ws;
#if MK_MULTI
    for (int p = 0; p < 7; ++p) { a.ph_lo = p; a.ph_hi = p + 1; hipLaunchKernelGGL(hymba_fwd, dim3(grid), dim3(512), LDS_BYTES, stream, a); }
#else
    a.ph_lo = 0; a.ph_hi = 7;
    (void)hipMemsetAsync((char*)d_ws + WS_BAR, 0, BAR_WORDS_N * 4, stream);
    void* args[] = {&a};
    hipError_t e = hipLaunchCooperativeKernel((const void*)hymba_fwd, dim3(grid), dim3(512), args, LDS_BYTES, stream);
    if (e != hipSuccess) fprintf(stderr, "cooperative launch failed: %s (grid %d)\n", hipGetErrorString(e), grid);
#endif
}
```

```cpp
#include <hip/hip_runtime.h>
#include <hip/hip_cooperative_groups.h>
#include <cstdio>
#include <cstdint>
namespace cg = cooperative_groups;

#ifndef MK_MULTI
#define MK_MULTI 0
#endif

#define LAS __attribute__((address_space(3)))
typedef unsigned short bf16_t;
typedef short bf16x8 __attribute__((ext_vector_type(8)));
typedef float f32x4 __attribute__((ext_vector_type(4)));
typedef float f32x2 __attribute__((ext_vector_type(2)));
typedef unsigned u32x4 __attribute__((ext_vector_type(4)));
typedef unsigned u32x2 __attribute__((ext_vector_type(2)));

constexpr int BATCH = 2, SEQ = 16384, DM = 2048, DIN = 6656, MROWS = BATCH * SEQ, NBLK = 64, MEMLEN = 256;
constexpr int C_K = 1024, C_V = 2048, C_GMO = 3072, C_U = 4096, C_VG = 4608, C_GG = 5120, C_QME = 5632, C_GME = 6144;
constexpr float QSCALE = 0.08838834764831845f * 1.4426950408889634f;
constexpr float ALPHA = 1.189207115002721f;
constexpr float LN_EPS = 1e-5f;
constexpr int LIST_PER_BH = 256 * 2080;
constexpr int QCH = 1024;
constexpr int MQCH = 512;

constexpr size_t MiB = 1u << 20;
constexpr size_t WS_CNT = 0;
constexpr size_t WS_BAR = 8192;
constexpr size_t WS_KSUM = 64 * 1024;
constexpr size_t WS_WIN = 1 * MiB;
constexpr size_t WS_WOUT = 28 * MiB;
constexpr size_t WS_WMKV = 36 * MiB;
constexpr size_t WS_WSB = 40 * MiB;
constexpr size_t WS_MEMB = 41 * MiB;
constexpr size_t WS_MKV = 43 * MiB;
constexpr size_t WS_COS = 44 * MiB;
constexpr size_t WS_SIN = 52 * MiB;
constexpr size_t WS_LIST = 60 * MiB;
constexpr size_t WS_PML = 96 * MiB;
constexpr size_t WS_Y = 104 * MiB;
constexpr size_t WS_PROJ = 232 * MiB;
constexpr size_t WS_PO = 648 * MiB;
constexpr size_t WS_SUB = 648 * MiB;
constexpr size_t WS_XB = 648 * MiB;
constexpr size_t WS_END = 904 * MiB;
constexpr int LDS_BYTES = 152 * 1024;
constexpr int BAR_WORDS_N = 3456;

namespace pg8 {
constexpr int BM = 256, BK = 64, HALF = 128, HTB = HALF * BK * 2, STAGE_BYTES = 8 * HTB, NXCD = 8, WGM = 8;
__host__ __device__ __forceinline__ int lds_byte(int r, int c) { const int st = (r >> 4) * 2 + (c >> 5), rr = r & 15, cc = c & 31, ob = rr * 64 + cc * 2; return st * 1024 + (ob ^ (((ob >> 9) & 1) << 5)); }
__host__ __device__ __forceinline__ void stage_rc(int b, int& R, int& C) { const int st = b / 1024, sb = b % 1024, swz = sb ^ (((sb >> 9) & 1) << 5); R = (st >> 1) * 16 + swz / 64; C = (st & 1) * 32 + (swz % 64) / 2; }
__host__ __device__ __forceinline__ int perm32(int rho) { const int n = rho >> 4, i = rho & 15; return 8 * (i >> 2) + 4 * n + (i & 3); }
struct Unit { int pm, pn; };
struct Gemm { const bf16_t* A; const bf16_t* Bt; int M, N, K; };
struct StaticOrder {
    int nM, nN, nwg, G, c;
    __host__ __device__ void init(int M, int N, int G_, int c_) { nM = M / BM; nN = N / BM; nwg = nM * nN; G = G_; c = c_; }
    __host__ __device__ bool next(int i, Unit& u) const {
        const long L = (long)i * G + c; if (L >= nwg) return false;
        int wgid = (int)L; { const int q = nwg / NXCD, r = nwg % NXCD, xcd = wgid % NXCD, off = wgid / NXCD; wgid = (xcd < r ? xcd * (q + 1) : r * (q + 1) + (xcd - r) * q) + off; }
        const int nig = WGM * nN, gid = wgid / nig, fm = gid * WGM, gsz = (nM - fm) < WGM ? (nM - fm) : WGM;
        u.pm = fm + ((wgid % nig) % gsz); u.pn = (wgid % nig) / gsz; return true;
    }
    __device__ __forceinline__ void a_ready(const Unit&) const {}
    __device__ __forceinline__ void done(const Unit&) const {}
};
__device__ __forceinline__ unsigned cvt_pk_bf16(float lo, float hi) { unsigned r; asm volatile("v_cvt_pk_bf16_f32 %0, %1, %2" : "=v"(r) : "v"(lo), "v"(hi)); return r; }

template <class Epi, class Sched, bool ALIGN_EPI = false, bool SP2 = false>
__device__ __forceinline__ void gemm_phase(LAS unsigned char* lds, const Gemm g, const Sched& S, const Epi& E) {
    const int tid = threadIdx.x, wid = __builtin_amdgcn_readfirstlane(tid >> 6), lane = tid & 63, wr = wid >> 2, wc = wid & 3, fr = lane & 15, fq = lane >> 4;
    const int K = g.K, nt = K / BK;
    unsigned voffA[2], voffB[2];
#pragma unroll
    for (int i = 0; i < 2; ++i) { int R, C; stage_rc(tid * 16 + i * 8192, R, C); const int Rb = Epi::PERM ? ((R & ~31) + perm32(R & 31)) : R;
        voffA[i] = (unsigned)(R * K + C) * 2u; voffB[i] = (unsigned)(Rb * K + C) * 2u; }
    const size_t kstep = (size_t)(BK * 2);
    const size_t hstep = (size_t)HALF * K * 2;
    const size_t tstep = 2 * hstep;
    const unsigned ldsw = (unsigned)wid * 1024u;
    const int aoff = lds_byte(wr * 64 + fr, fq * 8), boff = lds_byte(wc * 32 + fr, fq * 8);
#define PG8_SA(b, h) (((b) * 2 + (h)) * HTB)
#define PG8_SB(b, h) ((4 + (b) * 2 + (h)) * HTB)
#define PG8_STAGE(bufoff, gbase, voff) do { _Pragma("unroll") for (int _i = 0; _i < 2; ++_i) \
        __builtin_amdgcn_global_load_lds((const unsigned*)((const char*)(gbase) + (voff)[_i]), (LAS unsigned*)(lds + (bufoff) + ldsw + _i * 8192), 16, 0, 0); } while (0)
#define PG8_LDA(dst, b, h) do { _Pragma("unroll") for (int m = 0; m < 4; ++m) _Pragma("unroll") for (int k = 0; k < 2; ++k) dst[m][k] = *(const LAS bf16x8*)(lds + PG8_SA(b, h) + aoff + m * 2048 + k * 1024); } while (0)
#define PG8_LDB(dst, b, h) do { _Pragma("unroll") for (int n = 0; n < 2; ++n) _Pragma("unroll") for (int k = 0; k < 2; ++k) dst[n][k] = *(const LAS bf16x8*)(lds + PG8_SB(b, h) + boff + n * 2048 + k * 1024); } while (0)
#define PG8_MMA(ai, bj, At, Bt) do { __builtin_amdgcn_s_setprio(1); _Pragma("unroll") for (int m = 0; m < 4; ++m) _Pragma("unroll") for (int n = 0; n < 2; ++n) _Pragma("unroll") for (int k = 0; k < 2; ++k) \
        acc[ai][bj][m][n] = __builtin_amdgcn_mfma_f32_16x16x32_bf16(Bt[n][k], At[m][k], acc[ai][bj][m][n], 0, 0, 0); __builtin_amdgcn_s_setprio(0); } while (0)
#define PG8_WAIT_V(n) asm volatile("s_waitcnt vmcnt(" #n ")" ::: "memory")
#define PG8_WAIT_L(n) asm volatile("s_waitcnt lgkmcnt(" #n ")" ::: "memory")
#define PG8_BAR __builtin_amdgcn_s_barrier()
#define PG8_SCHED __builtin_amdgcn_sched_barrier(0)
    Unit cur, nxt; int ui = 0;
    if (!S.next(0, cur)) return;
    f32x4 acc[2][2][4][2];
#pragma unroll
    for (int a = 0; a < 2; ++a)
#pragma unroll
        for (int b = 0; b < 2; ++b)
#pragma unroll
            for (int m = 0; m < 4; ++m)
#pragma unroll
                for (int n = 0; n < 2; ++n) acc[a][b][m][n] = (f32x4){0.f, 0.f, 0.f, 0.f};
    bf16x8 At[4][2], B0[2][2], B1[2][2];
    const char* cA = (const char*)g.A + (size_t)cur.pm * tstep; const char* cB = (const char*)g.Bt + (size_t)cur.pn * tstep;
    S.a_ready(cur);
    if constexpr (SP2) {
        PG8_STAGE(PG8_SB(0, 0), cB, voffB); PG8_STAGE(PG8_SB(0, 1), cB + hstep, voffB); PG8_STAGE(PG8_SA(0, 0), cA, voffA); PG8_STAGE(PG8_SA(0, 1), cA + hstep, voffA);
        if (wr == 1) PG8_BAR;
        PG8_WAIT_V(2); PG8_BAR;
        PG8_STAGE(PG8_SB(1, 0), cB + kstep, voffB); PG8_STAGE(PG8_SA(1, 0), cA + kstep, voffA); PG8_STAGE(PG8_SB(1, 1), cB + hstep + kstep, voffB);
        PG8_WAIT_V(6); PG8_BAR;
    } else {
        PG8_STAGE(PG8_SB(0, 0), cB, voffB); PG8_STAGE(PG8_SA(0, 0), cA, voffA); PG8_STAGE(PG8_SB(0, 1), cB + hstep, voffB); PG8_STAGE(PG8_SA(0, 1), cA + hstep, voffA);
        if (wr == 1) PG8_BAR;
        PG8_WAIT_V(4); PG8_BAR;
        PG8_STAGE(PG8_SB(1, 0), cB + kstep, voffB); PG8_STAGE(PG8_SA(1, 0), cA + kstep, voffA); PG8_STAGE(PG8_SB(1, 1), cB + hstep + kstep, voffB);
        PG8_WAIT_V(6); PG8_BAR;
    }
    for (;;) {
        const bool has_next = S.next(ui + 1, nxt);
        const char* nA = has_next ? (const char*)g.A + (size_t)nxt.pm * tstep : cA; const char* nB = has_next ? (const char*)g.Bt + (size_t)nxt.pn * tstep : cB;
        for (int t = 0; t < nt; t += 2) {
            const bool last = (t == nt - 2);
            const char* a1 = cA + (size_t)(t + 1) * kstep;
            const char* a2 = last ? nA : cA + (size_t)(t + 2) * kstep; const char* b2 = last ? nB : cB + (size_t)(t + 2) * kstep;
            const char* a3 = a2 + kstep; const char* b3 = b2 + kstep;
            if (last && has_next) S.a_ready(nxt);
            if constexpr (SP2) {
            PG8_LDB(B0, 0, 0); PG8_LDB(B1, 0, 1); PG8_SCHED; PG8_LDA(At, 0, 0); PG8_STAGE(PG8_SA(1, 1), a1 + hstep, voffA);
            PG8_WAIT_V(8); PG8_WAIT_L(0); PG8_BAR; PG8_MMA(0, 0, At, B0); PG8_MMA(0, 1, At, B1); PG8_BAR; PG8_SCHED;
            PG8_LDA(At, 0, 1); PG8_STAGE(PG8_SB(0, 0), b2, voffB); PG8_STAGE(PG8_SB(0, 1), b2 + hstep, voffB); PG8_STAGE(PG8_SA(0, 0), a2, voffA);
            PG8_WAIT_V(8); PG8_WAIT_L(0); PG8_BAR; PG8_MMA(1, 0, At, B0); PG8_MMA(1, 1, At, B1); PG8_BAR; PG8_SCHED;
            PG8_LDB(B0, 1, 0); PG8_LDB(B1, 1, 1); PG8_SCHED; PG8_LDA(At, 1, 0); PG8_STAGE(PG8_SA(0, 1), a2 + hstep, voffA);
            PG8_WAIT_V(8); PG8_WAIT_L(0); PG8_BAR; PG8_MMA(0, 0, At, B0); PG8_MMA(0, 1, At, B1); PG8_BAR; PG8_SCHED;
            PG8_LDA(At, 1, 1); PG8_STAGE(PG8_SB(1, 0), b3, voffB); PG8_STAGE(PG8_SB(1, 1), b3 + hstep, voffB); PG8_STAGE(PG8_SA(1, 0), a3, voffA);
            PG8_WAIT_V(8); PG8_WAIT_L(0); PG8_BAR; PG8_MMA(1, 0, At, B0); PG8_MMA(1, 1, At, B1); PG8_BAR; PG8_SCHED;
            } else {
            PG8_LDB(B0, 0, 0); PG8_SCHED; PG8_LDA(At, 0, 0); PG8_STAGE(PG8_SA(1, 1), a1 + hstep, voffA);
            PG8_WAIT_L(8); PG8_BAR; PG8_WAIT_L(0); PG8_MMA(0, 0, At, B0); PG8_BAR; PG8_SCHED;
            PG8_LDB(B1, 0, 1); PG8_STAGE(PG8_SB(0, 0), b2, voffB);
            PG8_BAR; PG8_WAIT_L(0); PG8_MMA(0, 1, At, B1); PG8_BAR;
            PG8_LDA(At, 0, 1); PG8_STAGE(PG8_SA(0, 0), a2, voffA);
            PG8_BAR; PG8_WAIT_L(0); PG8_MMA(1, 0, At, B0); PG8_BAR; PG8_SCHED;
            PG8_STAGE(PG8_SB(0, 1), b2 + hstep, voffB);
            PG8_WAIT_V(6); PG8_BAR; PG8_MMA(1, 1, At, B1); PG8_BAR;
            PG8_LDB(B0, 1, 0); PG8_SCHED; PG8_LDA(At, 1, 0); PG8_STAGE(PG8_SA(0, 1), a2 + hstep, voffA);
            PG8_WAIT_L(8); PG8_BAR; PG8_WAIT_L(0); PG8_MMA(0, 0, At, B0); PG8_BAR; PG8_SCHED;
            PG8_LDB(B1, 1, 1); PG8_STAGE(PG8_SB(1, 0), b3, voffB);
            PG8_BAR; PG8_WAIT_L(0); PG8_MMA(0, 1, At, B1); PG8_BAR;
            PG8_LDA(At, 1, 1); PG8_STAGE(PG8_SA(1, 0), a3, voffA);
            PG8_BAR; PG8_WAIT_L(0); PG8_MMA(1, 0, At, B0); PG8_BAR; PG8_SCHED;
            PG8_STAGE(PG8_SB(1, 1), b3 + hstep, voffB);
            PG8_WAIT_V(6); PG8_BAR; PG8_MMA(1, 1, At, B1); PG8_BAR;
            }
        }
        if constexpr (ALIGN_EPI) { if (wr == 0) PG8_BAR; }
        E(acc, cur, wr, wc, fr, fq); S.done(cur);
        if (!has_next) break;
#pragma unroll
        for (int a = 0; a < 2; ++a)
#pragma unroll
            for (int b = 0; b < 2; ++b)
#pragma unroll
                for (int m = 0; m < 4; ++m)
#pragma unroll
                    for (int n = 0; n < 2; ++n) acc[a][b][m][n] = (f32x4){0.f, 0.f, 0.f, 0.f};
        cur = nxt; cA = nA; cB = nB; ++ui;
        if constexpr (ALIGN_EPI) { if (wr == 1) PG8_BAR; }
    }
    PG8_WAIT_V(0);
    if constexpr (!ALIGN_EPI) { if (wr == 0) PG8_BAR; }
    PG8_BAR;
#undef PG8_SA
#undef PG8_SB
#undef PG8_STAGE
#undef PG8_LDA
#undef PG8_LDB
#undef PG8_MMA
#undef PG8_WAIT_V
#undef PG8_WAIT_L
#undef PG8_BAR
#undef PG8_SCHED
}
}

using pg8::cvt_pk_bf16;
__device__ __forceinline__ float bf2f(unsigned short b) { return __builtin_bit_cast(float, (unsigned)b << 16); }
__device__ __forceinline__ float bflo(unsigned w) { return __builtin_bit_cast(float, w << 16); }
__device__ __forceinline__ float bfhi(unsigned w) { return __builtin_bit_cast(float, w & 0xffff0000u); }
__device__ __forceinline__ float fast_exp2(float x) { return __builtin_amdgcn_exp2f(x); }
__device__ __forceinline__ float fast_rcp(float x) { return __builtin_amdgcn_rcpf(x); }
__device__ __forceinline__ float silu_f(float x) { return x * fast_rcp(1.f + fast_exp2(-1.4426950408889634f * x)); }
__device__ __forceinline__ float gelu_tanh_f(float x) {
    const float t = x * (1.f + 0.044715f * x * x) * (-1.5957691216057308f * 1.4426950408889634f);
    return x * fast_rcp(1.f + fast_exp2(t));
}
#define LDS_WAIT() asm volatile("s_waitcnt lgkmcnt(0)" ::: "memory")

struct EpiProj {
    static constexpr bool PERM = true;
    bf16_t* O; const float* cosT; const float* sinT; float* ksum;
    __device__ __forceinline__ void operator()(const f32x4 (&acc)[2][2][4][2], const pg8::Unit& u, int wr, int wc, int fr, int fq) const {
        const int pn = u.pn;
        const int type = pn < 4 ? 0 : pn < 8 ? 1 : pn < 12 ? 2 : pn < 16 ? 3 : pn < 20 ? 4 : pn < 22 ? 3 : pn < 24 ? 5 : 3;
        const int row0 = u.pm * 256 + wr * 64 + fr;
        const int col0 = pn * 256 + wc * 32 + 8 * fq;
        float cs[2][8];
#pragma unroll
        for (int bj = 0; bj < 2; ++bj)
#pragma unroll
            for (int e = 0; e < 8; ++e) cs[bj][e] = 0.f;
#pragma unroll
        for (int ai = 0; ai < 2; ++ai) {
            f32x4 c4v[4], s4v[4];
#pragma unroll
            for (int m = 0; m < 4; ++m) { c4v[m] = (f32x4){1.f, 1.f, 1.f, 1.f}; s4v[m] = (f32x4){0.f, 0.f, 0.f, 0.f}; }
            if (type <= 1) {
#pragma unroll
                for (int m = 0; m < 4; ++m) { const size_t ro = (size_t)(row0 + ai * 128 + m * 16) * 64 + 16 * wc + 4 * fq; c4v[m] = *(const f32x4*)(cosT + ro); s4v[m] = *(const f32x4*)(sinT + ro); }
            }
            __builtin_amdgcn_sched_barrier(0);
#pragma unroll
            for (int m = 0; m < 4; ++m) {
                const int row = row0 + ai * 128 + m * 16;
                const f32x4 c4 = c4v[m], s4 = s4v[m];
                bf16_t* rowp = O + (size_t)row * DIN + col0;
#pragma unroll
                for (int bj = 0; bj < 2; ++bj) {
                    f32x4 v0 = acc[ai][bj][m][0], v1 = acc[ai][bj][m][1];
                    float o[8];
                    if (type <= 1) {
                        o[0] = v0[0] * c4[0] - v0[1] * s4[0]; o[1] = v0[1] * c4[0] + v0[0] * s4[0];
                        o[2] = v0[2] * c4[1] - v0[3] * s4[1]; o[3] = v0[3] * c4[1] + v0[2] * s4[1];
                        o[4] = v1[0] * c4[2] - v1[1] * s4[2]; o[5] = v1[1] * c4[2] + v1[0] * s4[2];
                        o[6] = v1[2] * c4[3] - v1[3] * s4[3]; o[7] = v1[3] * c4[3] + v1[2] * s4[3];
                        if (type == 0) {
#pragma unroll
                            for (int e = 0; e < 8; ++e) o[e] *= QSCALE;
                        } else {
#pragma unroll
                            for (int e = 0; e < 8; ++e) cs[bj][e] += o[e];
                        }
                    } else {
#pragma unroll
                        for (int e = 0; e < 4; ++e) { o[e] = v0[e]; o[4 + e] = v1[e]; }
                        if (type == 3) {
#pragma unroll
                            for (int e = 0; e < 8; ++e) o[e] = silu_f(o[e]);
                        } else if (type == 4) {
#pragma unroll
                            for (int e = 0; e < 8; ++e) o[e] = gelu_tanh_f(o[e]);
                        } else if (type == 5) {
#pragma unroll
                            for (int e = 0; e < 8; ++e) o[e] *= QSCALE;
                        }
                    }
                    u32x4 w; w.x = cvt_pk_bf16(o[0], o[1]); w.y = cvt_pk_bf16(o[2], o[3]); w.z = cvt_pk_bf16(o[4], o[5]); w.w = cvt_pk_bf16(o[6], o[7]);
                    *(u32x4*)(rowp + bj * 128) = w;
                }
            }
            __builtin_amdgcn_sched_barrier(0);
        }
        if (type == 1) {
#pragma unroll
            for (int bj = 0; bj < 2; ++bj)
#pragma unroll
                for (int e = 0; e < 8; ++e) {
                    float v = cs[bj][e];
                    v += __shfl_xor(v, 1); v += __shfl_xor(v, 2); v += __shfl_xor(v, 4); v += __shfl_xor(v, 8);
                    cs[bj][e] = v;
                }
            if (fr == 0) {
                float* kp = ksum + (size_t)u.pm * 1024 + (pn - 4) * 256 + wc * 32 + 8 * fq;
#pragma unroll
                for (int bj = 0; bj < 2; ++bj)
#pragma unroll
                    for (int e = 0; e < 8; ++e) atomicAdd(kp + bj * 128 + e, cs[bj][e]);
            }
        }
    }
};
struct EpiPlain {
    static constexpr bool PERM = true;
    bf16_t* O; int ldc;
    __device__ __forceinline__ void operator()(const f32x4 (&acc)[2][2][4][2], const pg8::Unit& u, int wr, int wc, int fr, int fq) const {
        const int row0 = u.pm * 256 + wr * 64 + fr, col0 = u.pn * 256 + wc * 32 + 8 * fq;
#pragma unroll
        for (int ai = 0; ai < 2; ++ai)
#pragma unroll
            for (int m = 0; m < 4; ++m) { bf16_t* rowp = O + (size_t)(row0 + ai * 128 + m * 16) * ldc + col0;
#pragma unroll
                for (int bj = 0; bj < 2; ++bj) { const f32x4 v0 = acc[ai][bj][m][0], v1 = acc[ai][bj][m][1];
                    u32x4 w; w.x = cvt_pk_bf16(v0[0], v0[1]); w.y = cvt_pk_bf16(v0[2], v0[3]); w.z = cvt_pk_bf16(v1[0], v1[1]); w.w = cvt_pk_bf16(v1[2], v1[3]);
                    *(u32x4*)(rowp + bj * 128) = w; } }
    }
};
struct EpiResid {
    static constexpr bool PERM = true;
    const float* __restrict__ x; float* __restrict__ out;
    __device__ __forceinline__ void operator()(const f32x4 (&acc)[2][2][4][2], const pg8::Unit& u, int wr, int wc, int fr, int fq) const {
        const int row0 = u.pm * 256 + wr * 64 + fr, col0 = u.pn * 256 + wc * 32 + 8 * fq;
#pragma unroll
        for (int ai = 0; ai < 2; ++ai) {
            f32x4 xv[4][2][2];
#pragma unroll
            for (int m = 0; m < 4; ++m) { const size_t off = (size_t)(row0 + ai * 128 + m * 16) * DM + col0;
#pragma unroll
                for (int bj = 0; bj < 2; ++bj)
#pragma unroll
                    for (int n = 0; n < 2; ++n) xv[m][bj][n] = *(const f32x4*)(x + off + bj * 128 + 4 * n); }
            __builtin_amdgcn_sched_barrier(0);
#pragma unroll
            for (int m = 0; m < 4; ++m) { const size_t off = (size_t)(row0 + ai * 128 + m * 16) * DM + col0;
#pragma unroll
                for (int bj = 0; bj < 2; ++bj)
#pragma unroll
                    for (int n = 0; n < 2; ++n) *(f32x4*)(out + off + bj * 128 + 4 * n) = xv[m][bj][n] * ALPHA + acc[ai][bj][m][n]; }
            __builtin_amdgcn_sched_barrier(0);
        }
    }
};

struct Args { const float* x; const float* mem; const int* pos; const float* w_in; const float* w_mkv; const float* gln_g; const float* gln_b;
              const float* w_s; const float* b_s; const float* w_out; const float* ln_g; const float* ln_b; float* out; unsigned char* ws; int ph_lo, ph_hi; };

__device__ __forceinline__ void p0_transpose_item(const float* W, int K, int N, bf16_t* WT, bool permute_qk, LAS float* scr, int item, int lane) {
    const int nblk = N / 32, kb = item / nblk, nb = item % nblk, k0 = 64 * kb, n0 = 32 * nb;
    const int ncol = n0 + (lane & 31);
    int src = ncol;
    if (permute_qk && ncol < 2048) { const int p = ncol & 127; src = (ncol & ~127) + ((p & 1) << 6) + (p >> 1); }
#pragma unroll 8
    for (int i = 0; i < 32; ++i) { const int kk = 2 * i + (lane >> 5); scr[kk * 33 + (lane & 31)] = W[(size_t)(k0 + kk) * N + src]; }
    LDS_WAIT();
    const int c = lane & 7;
#pragma unroll
    for (int j = 0; j < 4; ++j) { const int n = (lane >> 3) + 8 * j; const LAS float* s = scr + (8 * c) * 33 + n;
        u32x4 o; o.x = cvt_pk_bf16(s[0 * 33], s[1 * 33]); o.y = cvt_pk_bf16(s[2 * 33], s[3 * 33]); o.z = cvt_pk_bf16(s[4 * 33], s[5 * 33]); o.w = cvt_pk_bf16(s[6 * 33], s[7 * 33]);
        *(u32x4*)(WT + (size_t)(n0 + n) * K + k0 + 8 * c) = o; }
    LDS_WAIT();
}

__device__ __forceinline__ void phase0(const Args& a, LAS unsigned char* lds) {
    unsigned char* ws = a.ws;
    const int tid = threadIdx.x, lane = tid & 63, wave = tid >> 6;
    const int G = gridDim.x;
    const size_t gtid = (size_t)blockIdx.x * 512 + tid, NT = (size_t)G * 512;
    { int* cnt = (int*)(ws + WS_CNT); for (size_t i = gtid; i < 1088; i += NT) cnt[i] = 0;
      float* ks = (float*)(ws + WS_KSUM); for (size_t i = gtid; i < 128 * 1024; i += NT) ks[i] = 0.f; }
    { LAS float* scr = (LAS float*)(lds + wave * 16384);
      const int gw = blockIdx.x * 8 + wave, NGW = G * 8;
      constexpr int I_IN = (DM / 64) * (DIN / 32), I_OUT = (DM / 64) * (DM / 32), I_MKV = (DM / 64) * (1024 / 32);
      for (int it = gw; it < I_IN + I_OUT + I_MKV; it += NGW) {
          int r = it;
          if (r < I_IN) { p0_transpose_item(a.w_in, DM, DIN, (bf16_t*)(ws + WS_WIN), true, scr, r, lane); continue; } r -= I_IN;
          if (r < I_OUT) { p0_transpose_item(a.w_out, DM, DM, (bf16_t*)(ws + WS_WOUT), false, scr, r, lane); continue; } r -= I_OUT;
          p0_transpose_item(a.w_mkv, DM, 1024, (bf16_t*)(ws + WS_WMKV), false, scr, r, lane);
      } }
    { const size_t n8 = (size_t)MROWS * DM / 8; u32x4* xb = (u32x4*)(ws + WS_XB);
      for (size_t i0 = gtid; i0 < n8; i0 += 4 * NT) {
          f32x4 v[4][2];
#pragma unroll
          for (int j = 0; j < 4; ++j) { const size_t i = i0 + j * NT; if (i < n8) { v[j][0] = __builtin_nontemporal_load((const f32x4*)a.x + 2 * i); v[j][1] = __builtin_nontemporal_load((const f32x4*)a.x + 2 * i + 1); } }
          __builtin_amdgcn_sched_barrier(0);
#pragma unroll
          for (int j = 0; j < 4; ++j) { const size_t i = i0 + j * NT; if (i < n8) { const f32x4 v0 = v[j][0], v1 = v[j][1];
              u32x4 o; o.x = cvt_pk_bf16(v0[0], v0[1]); o.y = cvt_pk_bf16(v0[2], v0[3]); o.z = cvt_pk_bf16(v1[0], v1[1]); o.w = cvt_pk_bf16(v1[2], v1[3]); xb[i] = o; } }
          __builtin_amdgcn_sched_barrier(0);
      }
      const size_t m8 = (size_t)BATCH * MEMLEN * DM / 8; u32x4* mb = (u32x4*)(ws + WS_MEMB);
      for (size_t i = gtid; i < m8; i += NT) { const f32x4 v0 = ((const f32x4*)a.mem)[2 * i], v1 = ((const f32x4*)a.mem)[2 * i + 1];
          u32x4 o; o.x = cvt_pk_bf16(v0[0], v0[1]); o.y = cvt_pk_bf16(v0[2], v0[3]); o.z = cvt_pk_bf16(v1[0], v1[1]); o.w = cvt_pk_bf16(v1[2], v1[3]); mb[i] = o; } }
    { bf16_t* wsb = (bf16_t*)(ws + WS_WSB);
      for (size_t i = gtid; i < 4 * 128 * 128; i += NT) { const int t = (int)(i >> 7) & 127, s = (int)i & 127; const float v = s <= t ? a.w_s[i] : 0.f; wsb[i] = (bf16_t)(cvt_pk_bf16(v, 0.f) & 0xffffu); } }
    { float* cT = (float*)(ws + WS_COS); float* sT = (float*)(ws + WS_SIN);
      LAS float* invf = (LAS float*)(lds + 8 * 16384);
      if (tid < 64) invf[tid] = (float)exp2(-(double)tid * (13.287712379549449 / 64.0));
      __syncthreads();
      for (size_t e = gtid; e < (size_t)MROWS * 64; e += NT) { const int row = (int)(e >> 6), i = (int)e & 63;
          const float inv = invf[i];
          const float ang = (float)a.pos[row] * inv;
          const double rev = (double)ang * 0.15915494309189535; const float fr = (float)(rev - rint(rev));
          cT[e] = __builtin_amdgcn_cosf(fr); sT[e] = __builtin_amdgcn_sinf(fr); } }
}

__device__ __forceinline__ int list_base(int n) { return 256 * (64 * n - (n * (n - 1)) / 2); }
__device__ __forceinline__ unsigned long long shfl_xor_u64(unsigned long long v, int m) {
    unsigned lo = (unsigned)v, hi = (unsigned)(v >> 32); lo = __shfl_xor(lo, m); hi = __shfl_xor(hi, m); return ((unsigned long long)hi << 32) | lo; }

__device__ __forceinline__ void phase2(const Args& a, LAS unsigned char* lds) {
    unsigned char* ws = a.ws;
    const int tid = threadIdx.x, lane = tid & 63, wave = __builtin_amdgcn_readfirstlane(tid >> 6), fr = lane & 15, fq = lane >> 4;
    const bf16_t* proj = (const bf16_t*)(ws + WS_PROJ);
    const float* ksum = (const float*)(ws + WS_KSUM);
    int* cnt = (int*)(ws + WS_CNT);
    unsigned* list = (unsigned*)(ws + WS_LIST);
    LAS unsigned char* Kl = lds;
    LAS int* lcnt = (LAS int*)(lds + 16384);
    LAS int* gbase = (LAS int*)(lds + 16384 + 256);
    { const bf16_t* memb = (const bf16_t*)(ws + WS_MEMB); const bf16_t* wt = (const bf16_t*)(ws + WS_WMKV); bf16_t* mkv = (bf16_t*)(ws + WS_MKV);
      for (int t = blockIdx.x; t < 256; t += gridDim.x) {
          const int m0 = (t & 15) * 32 + 16 * (wave & 1), n0 = (t >> 4) * 64 + 16 * (wave >> 1);
          const bf16_t* ap = wt + (size_t)(n0 + fr) * DM + 8 * fq; const bf16_t* bp = memb + (size_t)(m0 + fr) * DM + 8 * fq;
          f32x4 acc = (f32x4){0.f, 0.f, 0.f, 0.f};
          bf16x8 av[8], bv[8], an[8], bn[8];
#pragma unroll
          for (int i = 0; i < 8; ++i) { av[i] = *(const bf16x8*)(ap + 32 * i); bv[i] = *(const bf16x8*)(bp + 32 * i); }
#pragma unroll 1
          for (int kb = 0; kb < 8; ++kb) {
              const int kn = kb < 7 ? kb + 1 : kb;
#pragma unroll
              for (int i = 0; i < 8; ++i) { an[i] = *(const bf16x8*)(ap + 32 * (8 * kn + i)); bn[i] = *(const bf16x8*)(bp + 32 * (8 * kn + i)); }
              __builtin_amdgcn_sched_barrier(0);
#pragma unroll
              for (int i = 0; i < 8; ++i) acc = __builtin_amdgcn_mfma_f32_16x16x32_bf16(av[i], bv[i], acc, 0, 0, 0);
              __builtin_amdgcn_sched_barrier(0);
#pragma unroll
              for (int i = 0; i < 8; ++i) { av[i] = an[i]; bv[i] = bn[i]; }
          }
          u32x2 w; w.x = cvt_pk_bf16(acc[0], acc[1]); w.y = cvt_pk_bf16(acc[2], acc[3]);
          *(u32x2*)(mkv + (size_t)(m0 + fr) * 1024 + n0 + 4 * fq) = w; } }
    LAS int* pend_n = (LAS int*)(lds + 18432);
    LAS int* pend_lp = (LAS int*)(lds + 18432 + 16384);
    LAS int* lcnt4 = (LAS int*)(lds + 16384);
    LAS int* gbase4 = (LAS int*)(lds + 16384 + 1024);
    for (int grp = blockIdx.x; grp < 256; grp += gridDim.x) {
        const int bh = grp >> 4, qb0 = (grp & 15) * 4, b = bh >> 3, h = bh & 7;
        { const int n = tid >> 3, c2 = tid & 7; const float* kp = ksum + (size_t)(b * 64 + n) * 1024 + h * 128 + c2 * 16;
          const f32x4 v0 = *(const f32x4*)kp, v1 = *(const f32x4*)(kp + 4), v2 = *(const f32x4*)(kp + 8), v3 = *(const f32x4*)(kp + 12);
          u32x4 w0, w1; w0.x = cvt_pk_bf16(v0[0], v0[1]); w0.y = cvt_pk_bf16(v0[2], v0[3]); w0.z = cvt_pk_bf16(v1[0], v1[1]); w0.w = cvt_pk_bf16(v1[2], v1[3]);
          w1.x = cvt_pk_bf16(v2[0], v2[1]); w1.y = cvt_pk_bf16(v2[2], v2[3]); w1.z = cvt_pk_bf16(v3[0], v3[1]); w1.w = cvt_pk_bf16(v3[2], v3[3]);
          *(LAS u32x4*)(Kl + n * 256 + (((2 * c2) ^ (n & 15)) << 4)) = w0; *(LAS u32x4*)(Kl + n * 256 + (((2 * c2 + 1) ^ (n & 15)) << 4)) = w1;
          if (tid < 256) lcnt4[tid] = 0; }
        const bf16_t* qbase = proj + (size_t)(b * SEQ + wave * 32 + fr) * DIN + h * 128 + 8 * fq;
        bf16x8 qcur[2][4];
#pragma unroll
        for (int tt = 0; tt < 2; ++tt)
#pragma unroll
            for (int k = 0; k < 4; ++k) qcur[tt][k] = *(const bf16x8*)(qbase + (size_t)(qb0 * 256 + tt * 16) * DIN + 32 * k);
        __syncthreads();
#pragma unroll 1
        for (int kk = 0; kk < 4; ++kk) {
            const int qb = qb0 + kk;
            bf16x8 qnxt[2][4];
            { const int qbn = kk < 3 ? qb + 1 : qb;
#pragma unroll
              for (int tt = 0; tt < 2; ++tt)
#pragma unroll
                  for (int k = 0; k < 4; ++k) qnxt[tt][k] = *(const bf16x8*)(qbase + (size_t)(qbn * 256 + tt * 16) * DIN + 32 * k); }
#pragma unroll
            for (int tt = 0; tt < 2; ++tt) {
                unsigned long long best0 = 0ull, best1 = 0ull, best2 = 0ull;
#pragma unroll
                for (int nt = 0; nt < 4; ++nt) {
                    if (16 * nt < qb) {
                        f32x4 g = (f32x4){0.f, 0.f, 0.f, 0.f};
#pragma unroll
                        for (int k = 0; k < 4; ++k) { const bf16x8 av = *(const LAS bf16x8*)(Kl + (16 * nt + fr) * 256 + (((4 * k + fq) ^ fr) << 4)); g = __builtin_amdgcn_mfma_f32_16x16x32_bf16(av, qcur[tt][k], g, 0, 0, 0); }
#pragma unroll
                        for (int j = 0; j < 4; ++j) { const int n = 16 * nt + 4 * fq + j;
                            const float gj = j == 0 ? g.x : j == 1 ? g.y : j == 2 ? g.z : g.w; const unsigned bits = __float_as_uint(gj); const unsigned ord = (bits & 0x80000000u) ? ~bits : (bits | 0x80000000u);
                            unsigned long long key = n < qb ? (((unsigned long long)ord << 32) | (unsigned)(63 - n)) : 0ull;
                            if (key > best0) { const unsigned long long t = best0; best0 = key; key = t; }
                            if (key > best1) { const unsigned long long t = best1; best1 = key; key = t; }
                            if (key > best2) { best2 = key; } }
                    }
                }
                int ptr = 0; int myn = -1;
#pragma unroll
                for (int r = 0; r < 3; ++r) {
                    const unsigned long long cand = ptr == 0 ? best0 : ptr == 1 ? best1 : ptr == 2 ? best2 : 0ull;
                    unsigned long long g = cand; { const unsigned long long o = shfl_xor_u64(g, 16); g = o > g ? o : g; } { const unsigned long long o = shfl_xor_u64(g, 32); g = o > g ? o : g; }
                    if (g != 0ull && cand == g) ++ptr;
                    if (fq == r && g != 0ull) myn = 63 - (int)(unsigned)(g & 0xffffffffull);
                }
                if (fq == 3) myn = qb;
                int lp = 0;
                if (myn >= 0) lp = __hip_atomic_fetch_add(lcnt4 + kk * 64 + myn, 1, __ATOMIC_RELAXED, __HIP_MEMORY_SCOPE_WORKGROUP);
                pend_n[(kk * 2 + tt) * 512 + tid] = myn; pend_lp[(kk * 2 + tt) * 512 + tid] = lp;
            }
#pragma unroll
            for (int tt = 0; tt < 2; ++tt)
#pragma unroll
                for (int k = 0; k < 4; ++k) qcur[tt][k] = qnxt[tt][k];
        }
        __syncthreads();
        if (tid < 256) { const int c = lcnt4[tid]; gbase4[tid] = c ? atomicAdd(cnt + bh * 64 + (tid & 63), c) : 0; }
        __syncthreads();
#pragma unroll 1
        for (int e = 0; e < 8; ++e) { const int kk = e >> 1, tt = e & 1; const int myn = pend_n[e * 512 + tid];
            if (myn >= 0) { const int s = (qb0 + kk) * 256 + (wave * 2 + tt) * 16 + fr;
                list[(size_t)bh * LIST_PER_BH + list_base(myn) + gbase4[kk * 64 + myn] + pend_lp[e * 512 + tid]] = (unsigned)s | ((unsigned)fq << 14); } }
        __syncthreads();
    }
}

__device__ __forceinline__ float sq8(u32x4 v) {
    const float a = bflo(v.x), b = bfhi(v.x), c = bflo(v.y), d = bfhi(v.y), e = bflo(v.z), f = bfhi(v.z), g = bflo(v.w), h = bfhi(v.w);
    return ((a * a + b * b) + (c * c + d * d)) + ((e * e + f * f) + (g * g + h * h)); }
__device__ __forceinline__ void stage_kv(LAS unsigned char* Kl, LAS unsigned char* Vl, const bf16_t* Kg, const bf16_t* Vg, int stride, int tid, LAS float* kmx) {
    float nmax = 0.f;
#pragma unroll
    for (int it = 0; it < 8; ++it) { const int q = tid + 512 * it, c = q & 15, r = q >> 4;
        const u32x4 v = *(const u32x4*)(Kg + (size_t)r * stride + 8 * c);
        *(LAS u32x4*)(Kl + r * 256 + ((c ^ (r & 15)) << 4)) = v;
        float n2 = sq8(v); n2 += __shfl_xor(n2, 1); n2 += __shfl_xor(n2, 2); n2 += __shfl_xor(n2, 4); n2 += __shfl_xor(n2, 8);
        nmax = fmaxf(nmax, n2); }
    nmax = fmaxf(nmax, __shfl_xor(nmax, 16)); nmax = fmaxf(nmax, __shfl_xor(nmax, 32));
    if ((tid & 63) == 0) kmx[tid >> 6] = nmax;
#pragma unroll
    for (int it = 0; it < 4; ++it) { const int q = tid + 512 * it, c = q & 15, kp = q >> 4, kq = 2 * kp;
        const int key = (kq & 0xE0) | (((kq >> 2) & 1) << 4) | (((kq >> 3) & 3) << 2) | (kq & 3);
        const u32x4 v0 = *(const u32x4*)(Vg + (size_t)key * stride + 8 * c), v1 = *(const u32x4*)(Vg + (size_t)(key + 1) * stride + 8 * c);
        const unsigned a0[4] = {v0.x, v0.y, v0.z, v0.w}, a1[4] = {v1.x, v1.y, v1.z, v1.w};
#pragma unroll
        for (int i = 0; i < 8; ++i) { const int d = 8 * c + i;
            const unsigned lo = (i & 1) ? (a0[i >> 1] >> 16) : (a0[i >> 1] & 0xffffu), hi = (i & 1) ? (a1[i >> 1] & 0xffff0000u) : (a1[i >> 1] << 16);
            *(LAS unsigned*)(Vl + d * 512 + ((((kq >> 3)) ^ (d & 15)) << 4) + (kq & 7) * 2) = lo | hi; } }
}
__device__ __forceinline__ float kmax_of(const LAS float* kmx) {
    float m = kmx[0];
#pragma unroll
    for (int i = 1; i < 8; ++i) m = fmaxf(m, kmx[i]);
    return sqrtf(m) * 1.002f; }

__device__ __forceinline__ float qnorm(const bf16x8 (&qf)[4]) {
    float qq = 0.f;
#pragma unroll
    for (int k = 0; k < 4; ++k) qq += sq8(__builtin_bit_cast(u32x4, qf[k]));
    qq += __shfl_xor(qq, 16); qq += __shfl_xor(qq, 32);
    return sqrtf(qq); }
#define AT_SCHED() __builtin_amdgcn_sched_barrier(0)
#define AT_LOADK(S) do { _Pragma("unroll") for (int k = 0; k < 4; ++k) { kf[2 * k] = *(const LAS bf16x8*)(Kl + kb[k] + (S) * 8192); kf[2 * k + 1] = *(const LAS bf16x8*)(Kl + kb[k] + (S) * 8192 + 4096); } } while (0)
#define AT_LOADV(S) do { const unsigned vb = (unsigned)fr * 512u + ((unsigned)((4 * (S) + fq) ^ fr) << 4); _Pragma("unroll") for (int dt = 0; dt < 8; ++dt) vf[dt] = *(const LAS bf16x8*)(Vl + vb + dt * 8192); } while (0)
__device__ __forceinline__ void attn_core(const LAS unsigned char* Kl, const LAS unsigned char* Vl, const bf16x8 (&qf)[4], int fr, int fq, bool do_mask, int qrel, int smax, float kmax,
                                          f32x4 (&oacc)[8], float& m_out, float& l_out) {
    asm volatile("" : "+v"(fr), "+v"(fq));
    unsigned kb[4];
#pragma unroll
    for (int k = 0; k < 4; ++k) kb[k] = (unsigned)fr * 256u + ((unsigned)((4 * k + fq) ^ fr) << 4);
    bf16x8 kf[8], vf[8];
    AT_LOADK(0); AT_LOADV(0);
    const float m = kmax;
    float l = 0.f;
#pragma unroll
    for (int dt = 0; dt < 8; ++dt) oacc[dt] = (f32x4){0.f, 0.f, 0.f, 0.f};
    f32x4 c0 = (f32x4){-m, -m, -m, -m}, c1 = c0;
    AT_SCHED();
#pragma unroll
    for (int k = 0; k < 4; ++k) { c0 = __builtin_amdgcn_mfma_f32_16x16x32_bf16(kf[2 * k], qf[k], c0, 0, 0, 0); c1 = __builtin_amdgcn_mfma_f32_16x16x32_bf16(kf[2 * k + 1], qf[k], c1, 0, 0, 0); }
    AT_SCHED();
    if (1 < smax) AT_LOADK(1);
#pragma unroll
    for (int s = 0; s < 8; ++s) {
        if (s < smax) {
            AT_SCHED();
            f32x4 n0 = (f32x4){-m, -m, -m, -m}, n1 = n0;
            if (s + 1 < smax) {
#pragma unroll
                for (int k = 0; k < 4; ++k) { n0 = __builtin_amdgcn_mfma_f32_16x16x32_bf16(kf[2 * k], qf[k], n0, 0, 0, 0); n1 = __builtin_amdgcn_mfma_f32_16x16x32_bf16(kf[2 * k + 1], qf[k], n1, 0, 0, 0); }
            }
            AT_SCHED();
            if (s + 2 < smax) AT_LOADK(s + 2);
            AT_SCHED();
            float p[8] = {c0.x, c0.y, c0.z, c0.w, c1.x, c1.y, c1.z, c1.w};
            if (do_mask) {
#pragma unroll
                for (int j = 0; j < 4; ++j) { if (32 * s + 4 * fq + j > qrel) p[j] = -INFINITY; if (32 * s + 16 + 4 * fq + j > qrel) p[4 + j] = -INFINITY; }
            }
#pragma unroll
            for (int j = 0; j < 8; ++j) p[j] = fast_exp2(p[j]);
            l += ((p[0] + p[1]) + (p[2] + p[3])) + ((p[4] + p[5]) + (p[6] + p[7]));
            u32x4 w; w.x = cvt_pk_bf16(p[0], p[1]); w.y = cvt_pk_bf16(p[2], p[3]); w.z = cvt_pk_bf16(p[4], p[5]); w.w = cvt_pk_bf16(p[6], p[7]);
            const bf16x8 pb = __builtin_bit_cast(bf16x8, w);
            AT_SCHED();
#pragma unroll
            for (int dt = 0; dt < 8; ++dt) oacc[dt] = __builtin_amdgcn_mfma_f32_16x16x32_bf16(vf[dt], pb, oacc[dt], 0, 0, 0);
            AT_SCHED();
            if (s + 1 < smax) AT_LOADV(s + 1);
            c0 = n0; c1 = n1;
        }
    }
    AT_SCHED();
    l += __shfl_xor(l, 16); l += __shfl_xor(l, 32);
    m_out = m; l_out = l;
}

__device__ __forceinline__ void phase3(const Args& a, LAS unsigned char* lds) {
    unsigned char* ws = a.ws;
    const int tid = threadIdx.x, lane = tid & 63, wave = __builtin_amdgcn_readfirstlane(tid >> 6), fr = lane & 15, fq = lane >> 4;
    const int fr_ = fr, fq_ = fq, lane_ = lane, tid_ = tid;
    const bf16_t* proj = (const bf16_t*)(ws + WS_PROJ);
    const int* cnt = (const int*)(ws + WS_CNT);
    const unsigned* list = (const unsigned*)(ws + WS_LIST);
    bf16_t* PO = (bf16_t*)(ws + WS_PO); f32x2* PML = (f32x2*)(ws + WS_PML);
    bf16_t* Y = (bf16_t*)(ws + WS_Y);
    LAS unsigned char* Kl = lds; LAS unsigned char* Vl = lds + 65536;
    LAS int* pre = (LAS int*)(lds + 131072);
    LAS float* kmx = (LAS float*)(lds + 131072 + 12288);
    LAS int* prp = (LAS int*)(lds + 131072 + 4352);
    LAS int* nxt = (LAS int*)(lds + 131072 + 12288 + 64);
    if (wave == 0) {
        int locf[16], locp[16]; int sumf = 0, sump = 0;
#pragma unroll
        for (int i = 0; i < 16; ++i) { const int c = cnt[lane * 16 + i]; locf[i] = c / QCH; locp[i] = (c % QCH) ? 1 : 0; sumf += locf[i]; sump += locp[i]; }
        int incf = sumf, incp = sump;
#pragma unroll
        for (int o = 1; o < 64; o <<= 1) { const int vf_ = __shfl_up(incf, o), vp_ = __shfl_up(incp, o); if (lane >= o) { incf += vf_; incp += vp_; } }
        int runf = incf - sumf, runp = incp - sump;
#pragma unroll
        for (int i = 0; i < 16; ++i) { pre[lane * 16 + i] = runf; prp[lane * 16 + i] = runp; runf += locf[i]; runp += locp[i]; }
        if (lane == 63) { pre[1024] = runf; prp[1024] = runp; }
    }
    __syncthreads();
    const int nfull = pre[1024], npart = prp[1024];
    int* ticket = (int*)(ws + WS_CNT) + 1024;
    int it_static = blockIdx.x; bool dyn = false;
    for (;;) {
        int idx = 0;
        if (!dyn) { if (it_static < nfull) { idx = it_static; it_static += gridDim.x; } else dyn = true; }
        if (dyn) {
            __syncthreads();
            if (tid == 0) nxt[0] = atomicAdd(ticket, 1);
            __syncthreads();
            idx = nxt[0];
            if (idx >= npart) break;
            idx += nfull;
        }
        int u, c;
        if (idx < nfull) { int lo = 0, hi = 1024; while (hi - lo > 1) { const int mid = (lo + hi) >> 1; if (pre[mid] <= idx) lo = mid; else hi = mid; } u = lo; c = idx - pre[u]; }
        else { const int j = idx - nfull; int lo = 0, hi = 1024; while (hi - lo > 1) { const int mid = (lo + hi) >> 1; if (prp[mid] <= j) lo = mid; else hi = mid; } u = lo; c = cnt[u] / QCH; }
        const int bh = u >> 6, n = u & 63, b = bh >> 3, h = bh & 7;
        int tid = tid_, fr = fr_, fq = fq_; asm volatile("" : "+v"(tid), "+v"(fr), "+v"(fq));
        const int count = cnt[u], qbase = c * QCH;
        const int ntile = min(QCH / 16, (count - qbase + 15) >> 4);
        const unsigned* lp = list + (size_t)bh * LIST_PER_BH + list_base(n);
        const bf16_t* qb0 = proj + (size_t)(b * SEQ) * DIN + h * 128 + 8 * fq;
        int tile = wave;
        unsigned ent_c = 0u, ent_n = 0u;
        if (tile < ntile) ent_c = lp[min(qbase + tile * 16 + fr, count - 1)];
        if (tile + 8 < ntile) ent_n = lp[min(qbase + (tile + 8) * 16 + fr, count - 1)];
        __syncthreads();
        const bf16_t* Kg = proj + (size_t)(b * SEQ + n * 256) * DIN + C_K + h * 128;
        stage_kv(Kl, Vl, Kg, Kg + (C_V - C_K), DIN, tid, kmx);
        bf16x8 qc[4];
        { const bf16_t* qp = qb0 + (size_t)(ent_c & 0x3fffu) * DIN;
#pragma unroll
          for (int k = 0; k < 4; ++k) qc[k] = *(const bf16x8*)(qp + 32 * k); }
        float qn_c = qnorm(qc);
        __syncthreads();
        const float kmax = kmax_of(kmx);
        for (; tile < ntile; tile += 8) {
            bf16x8 qn[4]; unsigned ent_nn = 0u;
#pragma unroll
            for (int k = 0; k < 4; ++k) qn[k] = qc[k];
            if (tile + 8 < ntile) {
                const bf16_t* qp = qb0 + (size_t)(ent_n & 0x3fffu) * DIN;
#pragma unroll
                for (int k = 0; k < 4; ++k) qn[k] = *(const bf16x8*)(qp + 32 * k);
                if (tile + 16 < ntile) ent_nn = lp[min(qbase + (tile + 16) * 16 + fr, count - 1)];
            }
            const bool valid = qbase + tile * 16 + fr < count;
            const int sq = (int)(ent_c & 0x3fffu), slot = (int)(ent_c >> 14);
            const bool do_mask = __any(slot == 3);
            const int qrel = sq - n * 256;
            int smax = 8;
            if (do_mask) { int qm = qrel;
#pragma unroll
                for (int o = 1; o < 64; o <<= 1) qm = max(qm, __shfl_xor(qm, o));
                smax = min(8, (qm >> 5) + 1); }
            smax = __builtin_amdgcn_readfirstlane(smax);
            f32x4 oacc[8]; float mx, l;
            attn_core(Kl, Vl, qc, fr, fq, do_mask, qrel, smax, qn_c * kmax, oacc, mx, l);
            qn_c = qnorm(qn);
            __builtin_amdgcn_sched_barrier(0);
            if (valid) {
                const size_t pidx = ((size_t)bh * SEQ + sq) * 4 + slot;
                bf16_t* op = PO + pidx * 128 + 4 * fq;
#pragma unroll
                for (int dt = 0; dt < 8; ++dt) { u32x2 w; w.x = cvt_pk_bf16(oacc[dt][0], oacc[dt][1]); w.y = cvt_pk_bf16(oacc[dt][2], oacc[dt][3]); *(u32x2*)(op + 16 * dt) = w; }
                if (fq == 0) PML[pidx] = (f32x2){mx, l};
            }
            ent_c = ent_n; ent_n = ent_nn;
#pragma unroll
            for (int k = 0; k < 4; ++k) qc[k] = qn[k];
        }
    }
    const bf16_t* mkv = (const bf16_t*)(ws + WS_MKV);
    for (int item = blockIdx.x; item < BATCH * 4 * (SEQ / MQCH); item += gridDim.x) {
        const int c = item & 31, hm = (item >> 5) & 3, b = item >> 7;
        int tid = tid_, fr = fr_, fq = fq_; asm volatile("" : "+v"(tid), "+v"(fr), "+v"(fq));
        __syncthreads();
        const bf16_t* Kg = mkv + (size_t)(b * MEMLEN) * 1024 + hm * 128;
        stage_kv(Kl, Vl, Kg, Kg + 512, 1024, tid, kmx);
        const bf16_t* qb0 = proj + (size_t)(b * SEQ + c * MQCH + fr) * DIN + C_QME + hm * 128 + 8 * fq;
        bf16x8 qc[4];
#pragma unroll
        for (int k = 0; k < 4; ++k) qc[k] = *(const bf16x8*)(qb0 + (size_t)(wave * 16) * DIN + 32 * k);
        float qn_c = qnorm(qc);
        __syncthreads();
        const float kmax = kmax_of(kmx);
        for (int tile = wave; tile < MQCH / 16; tile += 8) {
            bf16x8 qn[4];
#pragma unroll
            for (int k = 0; k < 4; ++k) qn[k] = qc[k];
            if (tile + 8 < MQCH / 16) {
#pragma unroll
                for (int k = 0; k < 4; ++k) qn[k] = *(const bf16x8*)(qb0 + (size_t)((tile + 8) * 16) * DIN + 32 * k); }
            const int sq = c * MQCH + tile * 16 + fr; const size_t row = (size_t)(b * SEQ + sq);
            f32x4 oacc[8]; float mx, l;
            attn_core(Kl, Vl, qc, fr, fq, false, 0, 8, qn_c * kmax, oacc, mx, l);
            qn_c = qnorm(qn);
            __builtin_amdgcn_sched_barrier(0);
            const float rl = 1.f / l;
            const bf16_t* gp = proj + row * DIN + C_GME + hm * 128 + 4 * fq;
            bf16_t* yp = Y + row * DM + 1536 + hm * 128 + 4 * fq;
            u32x2 gv[8];
#pragma unroll
            for (int dt = 0; dt < 8; ++dt) gv[dt] = *(const u32x2*)(gp + 16 * dt);
            __builtin_amdgcn_sched_barrier(0);
#pragma unroll
            for (int dt = 0; dt < 8; ++dt) { const u32x2 g = gv[dt];
                u32x2 w; w.x = cvt_pk_bf16(oacc[dt][0] * rl * bflo(g.x), oacc[dt][1] * rl * bfhi(g.x)); w.y = cvt_pk_bf16(oacc[dt][2] * rl * bflo(g.y), oacc[dt][3] * rl * bfhi(g.y));
                *(u32x2*)(yp + 16 * dt) = w; }
#pragma unroll
            for (int k = 0; k < 4; ++k) qc[k] = qn[k];
        }
    }
    const bf16_t* wsb = (const bf16_t*)(ws + WS_WSB);
    for (int item = blockIdx.x; item < BATCH * (SEQ / 128); item += gridDim.x) {
        const size_t row0 = (size_t)item * 128;
        int fr = fr_, fq = fq_, lane = lane_; asm volatile("" : "+v"(fr), "+v"(fq), "+v"(lane));
        __syncthreads();
        {
            const f32x4 g0 = *(const f32x4*)(a.gln_g + 8 * lane), g1 = *(const f32x4*)(a.gln_g + 8 * lane + 4), b0 = *(const f32x4*)(a.gln_b + 8 * lane), b1 = *(const f32x4*)(a.gln_b + 8 * lane + 4);
            u32x4 raw[16];
#pragma unroll
            for (int i = 0; i < 16; ++i) raw[i] = *(const u32x4*)(proj + (row0 + wave + 8 * i) * DIN + C_VG + 8 * lane);
#pragma unroll
            for (int i = 0; i < 16; ++i) {
                const int tk = wave + 8 * i;
                float v[8] = {bflo(raw[i].x), bfhi(raw[i].x), bflo(raw[i].y), bfhi(raw[i].y), bflo(raw[i].z), bfhi(raw[i].z), bflo(raw[i].w), bfhi(raw[i].w)};
                float sm = 0.f;
#pragma unroll
                for (int e = 0; e < 8; ++e) sm += v[e];
#pragma unroll
                for (int o = 1; o < 64; o <<= 1) sm += __shfl_xor(sm, o);
                const float mu = sm * (1.f / 512.f); float q = 0.f;
#pragma unroll
                for (int e = 0; e < 8; ++e) { v[e] -= mu; q += v[e] * v[e]; }
#pragma unroll
                for (int o = 1; o < 64; o <<= 1) q += __shfl_xor(q, o);
                const float rstd = 1.f / sqrtf(q * (1.f / 512.f) + LN_EPS);
#pragma unroll
                for (int e = 0; e < 8; ++e) { const float o = v[e] * rstd * (e < 4 ? g0[e] : g1[e - 4]) + (e < 4 ? b0[e] : b1[e - 4]);
                    *(LAS bf16_t*)(lds + (8 * lane + e) * 272 + tk * 2) = (bf16_t)(cvt_pk_bf16(o, 0.f) & 0xffffu); }
            }
        }
        __syncthreads();
        const int g = wave >> 1, th = wave & 1;
        f32x4 acc[8][4];
#pragma unroll
        for (int ct = 0; ct < 8; ++ct)
#pragma unroll
            for (int tt = 0; tt < 4; ++tt) acc[ct][tt] = (f32x4){0.f, 0.f, 0.f, 0.f};
#pragma unroll
        for (int k = 0; k < 4; ++k) {
            bf16x8 wf[4];
#pragma unroll
            for (int tt = 0; tt < 4; ++tt) wf[tt] = *(const bf16x8*)(wsb + (size_t)(g * 128 + 64 * th + 16 * tt + fr) * 128 + 32 * k + 8 * fq);
#pragma unroll
            for (int ct = 0; ct < 8; ++ct) { const bf16x8 av = *(const LAS bf16x8*)(lds + (128 * g + 16 * ct + fr) * 272 + (32 * k + 8 * fq) * 2);
#pragma unroll
                for (int tt = 0; tt < 4; ++tt) acc[ct][tt] = __builtin_amdgcn_mfma_f32_16x16x32_bf16(av, wf[tt], acc[ct][tt], 0, 0, 0); }
        }
#pragma unroll
        for (int tt = 0; tt < 4; ++tt) { const int t = 64 * th + 16 * tt + fr; const float bs = a.b_s[g * 128 + t]; const size_t row = row0 + t;
            u32x2 uuv[8], ggv[8];
#pragma unroll
            for (int ct = 0; ct < 8; ++ct) { const int ch = 128 * g + 16 * ct + 4 * fq; uuv[ct] = *(const u32x2*)(proj + row * DIN + C_U + ch); ggv[ct] = *(const u32x2*)(proj + row * DIN + C_GG + ch); }
            __builtin_amdgcn_sched_barrier(0);
#pragma unroll
            for (int ct = 0; ct < 8; ++ct) { const int ch = 128 * g + 16 * ct + 4 * fq;
                const u32x2 uu = uuv[ct], gg = ggv[ct];
                const f32x4 m = acc[ct][tt] + bs;
                u32x2 w; w.x = cvt_pk_bf16(bflo(uu.x) * m[0] * bflo(gg.x), bfhi(uu.x) * m[1] * bfhi(gg.x)); w.y = cvt_pk_bf16(bflo(uu.y) * m[2] * bflo(gg.y), bfhi(uu.y) * m[3] * bfhi(gg.y));
                *(u32x2*)(Y + row * DM + 1024 + ch) = w; } }
    }
}

__device__ __forceinline__ void phase4(const Args& a) {
    unsigned char* ws = a.ws;
    const int tid = threadIdx.x, lane = tid & 63, wave = tid >> 6;
    const bf16_t* proj = (const bf16_t*)(ws + WS_PROJ);
    const bf16_t* PO = (const bf16_t*)(ws + WS_PO); const f32x2* PML = (const f32x2*)(ws + WS_PML);
    bf16_t* Y = (bf16_t*)(ws + WS_Y);
    const int rl_ = lane >> 3, d0 = (lane & 7) * 16;
    const int nw = gridDim.x * 8;
    for (int t0 = blockIdx.x * 8 + wave; t0 < 16 * (SEQ / 8); t0 += 2 * nw) {
        f32x2 ml[2][4]; u32x4 pp[2][4][2]; u32x4 gg[2][2];
#pragma unroll
        for (int r = 0; r < 2; ++r) {
            const int t = (t0 + r * nw < 16 * (SEQ / 8)) ? t0 + r * nw : t0;
            const int bh = t / (SEQ / 8), s = (t % (SEQ / 8)) * 8 + rl_, b = bh >> 3, h = bh & 7, qb = s >> 8, nv = qb < 3 ? qb : 3;
            const size_t pbase = ((size_t)bh * SEQ + s) * 4; const size_t row = (size_t)b * SEQ + s;
#pragma unroll
            for (int j = 0; j < 4; ++j) { const bool ok = (j == 3) || (j < nv);
                ml[r][j] = ok ? PML[pbase + j] : (f32x2){-INFINITY, 0.f};
                if (ok) { pp[r][j][0] = *(const u32x4*)(PO + (pbase + j) * 128 + d0); pp[r][j][1] = *(const u32x4*)(PO + (pbase + j) * 128 + d0 + 8); }
                else { pp[r][j][0] = (u32x4){0u, 0u, 0u, 0u}; pp[r][j][1] = pp[r][j][0]; } }
            gg[r][0] = *(const u32x4*)(proj + row * DIN + C_GMO + h * 128 + d0); gg[r][1] = *(const u32x4*)(proj + row * DIN + C_GMO + h * 128 + d0 + 8);
        }
        __builtin_amdgcn_sched_barrier(0);
#pragma unroll
        for (int r = 0; r < 2; ++r) {
            const int t = t0 + r * nw;
            if (t < 16 * (SEQ / 8)) {
                const int bh = t / (SEQ / 8), s = (t % (SEQ / 8)) * 8 + rl_, b = bh >> 3, h = bh & 7; const size_t row = (size_t)b * SEQ + s;
                float M = -INFINITY;
#pragma unroll
                for (int j = 0; j < 4; ++j) M = fmaxf(M, ml[r][j].x);
                float o[16]; float L = 0.f;
#pragma unroll
                for (int e = 0; e < 16; ++e) o[e] = 0.f;
#pragma unroll
                for (int j = 0; j < 4; ++j) { const float w = fast_exp2(ml[r][j].x - M); L += w * ml[r][j].y;
                    const u32x4 p0 = pp[r][j][0], p1 = pp[r][j][1];
                    o[0] += w * bflo(p0.x); o[1] += w * bfhi(p0.x); o[2] += w * bflo(p0.y); o[3] += w * bfhi(p0.y); o[4] += w * bflo(p0.z); o[5] += w * bfhi(p0.z); o[6] += w * bflo(p0.w); o[7] += w * bfhi(p0.w);
                    o[8] += w * bflo(p1.x); o[9] += w * bfhi(p1.x); o[10] += w * bflo(p1.y); o[11] += w * bfhi(p1.y); o[12] += w * bflo(p1.z); o[13] += w * bfhi(p1.z); o[14] += w * bflo(p1.w); o[15] += w * bfhi(p1.w); }
                const float rl = 1.f / L;
                const u32x4 g0 = gg[r][0], g1 = gg[r][1];
                u32x4 w0, w1;
                w0.x = cvt_pk_bf16(o[0] * rl * bflo(g0.x), o[1] * rl * bfhi(g0.x)); w0.y = cvt_pk_bf16(o[2] * rl * bflo(g0.y), o[3] * rl * bfhi(g0.y));
                w0.z = cvt_pk_bf16(o[4] * rl * bflo(g0.z), o[5] * rl * bfhi(g0.z)); w0.w = cvt_pk_bf16(o[6] * rl * bflo(g0.w), o[7] * rl * bfhi(g0.w));
                w1.x = cvt_pk_bf16(o[8] * rl * bflo(g1.x), o[9] * rl * bfhi(g1.x)); w1.y = cvt_pk_bf16(o[10] * rl * bflo(g1.y), o[11] * rl * bfhi(g1.y));
                w1.z = cvt_pk_bf16(o[12] * rl * bflo(g1.z), o[13] * rl * bfhi(g1.z)); w1.w = cvt_pk_bf16(o[14] * rl * bflo(g1.w), o[15] * rl * bfhi(g1.w));
                *(u32x4*)(Y + row * DM + h * 128 + d0) = w0; *(u32x4*)(Y + row * DM + h * 128 + d0 + 8) = w1;
            }
        }
        __builtin_amdgcn_sched_barrier(0);
    }
}

__device__ __forceinline__ void phase6(const Args& a) {
    const int tid = threadIdx.x, lane = tid & 63, wave = tid >> 6;
    const bf16_t* sub = (const bf16_t*)(a.ws + WS_SUB);
    for (int row = blockIdx.x * 8 + wave; row < MROWS; row += gridDim.x * 8) {
        const f32x4* xp = (const f32x4*)(a.x + (size_t)row * DM) + lane;
        const u32x2* sp = (const u32x2*)(sub + (size_t)row * DM) + lane;
        f32x4* rp = (f32x4*)(a.out + (size_t)row * DM) + lane;
        f32x4 v[8]; u32x2 sv[8]; float s = 0.f;
#pragma unroll
        for (int j = 0; j < 8; ++j) { v[j] = __builtin_nontemporal_load(xp + 64 * j); sv[j] = sp[64 * j]; }
#pragma unroll
        for (int j = 0; j < 8; ++j) { v[j] = v[j] * ALPHA + (f32x4){bflo(sv[j].x), bfhi(sv[j].x), bflo(sv[j].y), bfhi(sv[j].y)}; s += (v[j][0] + v[j][1]) + (v[j][2] + v[j][3]); }
#pragma unroll
        for (int o = 1; o < 64; o <<= 1) s += __shfl_xor(s, o);
        const float mu = s * (1.f / DM); float q = 0.f;
#pragma unroll
        for (int j = 0; j < 8; ++j) { v[j] = v[j] - mu; q += (v[j][0] * v[j][0] + v[j][1] * v[j][1]) + (v[j][2] * v[j][2] + v[j][3] * v[j][3]); }
#pragma unroll
        for (int o = 1; o < 64; o <<= 1) q += __shfl_xor(q, o);
        const float rstd = 1.f / sqrtf(q * (1.f / DM) + LN_EPS);
#pragma unroll
        for (int j = 0; j < 8; ++j) { const f32x4 g = ((const f32x4*)a.ln_g)[lane + 64 * j], bb = ((const f32x4*)a.ln_b)[lane + 64 * j]; __builtin_nontemporal_store(v[j] * rstd * g + bb, rp + 64 * j); }
    }
}

#define XB_TMO      128
#define XB_XCNT(j)  (256  + 64 * (j))
#define XB_XSUB(j)  (1280 + 64 * (j))
#define XB_XGEN(j)  (2304 + 64 * (j))
#define XB_TOP      3328
#define XB_TOPGEN   3392
#define XCD_BAR_WORDS 3456
#define XB_SPIN_CAP (1u << 18)
__device__ __forceinline__ unsigned xb_ld(unsigned* p)              { return __hip_atomic_load(p, __ATOMIC_RELAXED, __HIP_MEMORY_SCOPE_AGENT); }
__device__ __forceinline__ unsigned xb_add(unsigned* p, unsigned v) { return __hip_atomic_fetch_add(p, v, __ATOMIC_RELAXED, __HIP_MEMORY_SCOPE_AGENT); }
__device__ __forceinline__ unsigned xb_xcc_id() { return (unsigned)__builtin_amdgcn_s_getreg((3 << 11) | 20) & 0xFu; }
#define XB_SPIN(cond, bar) do { unsigned _sp = 0; while (cond) { __builtin_amdgcn_s_sleep(1); \
    if ((++_sp & 255u) == 0u) { if (xb_ld(&(bar)[XB_TMO])) break; if (_sp > XB_SPIN_CAP) { atomicAdd(&(bar)[XB_TMO], 1u); break; } } } } while (0)
struct XcdBarrier { unsigned* bar; unsigned x; volatile LAS unsigned* st; };
__device__ __forceinline__ XcdBarrier xcd_barrier_post(unsigned* bar, volatile LAS unsigned* st) {
    XcdBarrier b; b.bar = bar; b.x = xb_xcc_id(); b.st = st;
    if (threadIdx.x == 0) (void)xb_add(&bar[XB_XCNT(b.x)], 1u);
    return b;
}
__device__ __forceinline__ void xcd_barrier_complete(unsigned* bar, unsigned x, unsigned& nloc, unsigned& nx) {
    const unsigned G = gridDim.x * gridDim.y * gridDim.z;
    unsigned sum, cnt, mine, sp = 0u;
    for (;;) {
        sum = 0u; cnt = 0u; mine = 0u;
#pragma unroll
        for (unsigned j = 0; j < 16; ++j) { const unsigned c = xb_ld(&bar[XB_XCNT(j)]); sum += c; cnt += (c > 0u) ? 1u : 0u; mine = (j == x) ? c : mine; }
        if (sum == G) break;
        __builtin_amdgcn_s_sleep(1);
        if ((++sp & 255u) == 0u) { if (xb_ld(&bar[XB_TMO])) break; if (sp > XB_SPIN_CAP) { atomicAdd(&bar[XB_TMO], 1u); break; } }
    }
    nloc = mine > 0u ? mine : 1u; nx = cnt > 0u ? cnt : 1u;
}
__device__ __forceinline__ void xcd_barrier(const XcdBarrier& b) {
    asm volatile("s_waitcnt vmcnt(0)" ::: "memory");
    __syncthreads();
    if (threadIdx.x == 0) {
        unsigned* bar = b.bar;
        __builtin_amdgcn_s_waitcnt(0);
        unsigned nloc = b.st[0], nx = b.st[1];
        if (nloc == 0u) { xcd_barrier_complete(bar, b.x, nloc, nx); b.st[0] = nloc; b.st[1] = nx; }
        const unsigned old = xb_add(&bar[XB_XSUB(b.x)], 1u);
        const unsigned gen = old / nloc;
        if (old + 1u == (gen + 1u) * nloc) {
            __builtin_amdgcn_fence(__ATOMIC_RELEASE, "agent");
            asm volatile("s_waitcnt vmcnt(0)" ::: "memory");
            const unsigned og = xb_add(&bar[XB_TOP], 1u);
            const unsigned tg = og / nx;
            if (og + 1u == (tg + 1u) * nx) xb_add(&bar[XB_TOPGEN], 1u);
            else XB_SPIN(xb_ld(&bar[XB_TOPGEN]) == tg, bar);
            __builtin_amdgcn_fence(__ATOMIC_ACQUIRE, "agent");
            xb_add(&bar[XB_XGEN(b.x)], 1u);
            asm volatile("s_waitcnt vmcnt(0)" ::: "memory");
        } else {
            XB_SPIN(xb_ld(&bar[XB_XGEN(b.x)]) == gen, bar);
            __builtin_amdgcn_fence(__ATOMIC_ACQUIRE, "agent");
            asm volatile("s_waitcnt vmcnt(0)" ::: "memory");
        }
    }
    __syncthreads();
}

__global__ void __launch_bounds__(512, 2) hymba_fwd(Args a) {
    extern __shared__ __attribute__((aligned(16))) unsigned char lds_raw[];
    LAS unsigned char* lds = (LAS unsigned char*)lds_raw;
    unsigned char* ws = a.ws;
    const int lo = a.ph_lo, hi = a.ph_hi, G = gridDim.x;
#define IN(k) (lo <= (k) && (k) < hi)
#define SEAM(k) do { if (IN(k) && IN((k) + 1)) xcd_barrier(xbar); } while (0)
    volatile LAS unsigned* xst = (volatile LAS unsigned*)(lds + LDS_BYTES - 64);
    if (threadIdx.x < 2) xst[threadIdx.x] = 0u;
    __syncthreads();
    XcdBarrier xbar; xbar.bar = (unsigned*)(ws + WS_BAR); xbar.x = 0; xbar.st = xst;
    if (IN(0) && IN(1)) xbar = xcd_barrier_post((unsigned*)(ws + WS_BAR), xst);
    if (IN(0)) phase0(a, lds);
    SEAM(0);
    if (IN(1)) {
        { pg8::Gemm g{(const bf16_t*)(ws + WS_XB), (const bf16_t*)(ws + WS_WIN), MROWS, DIN, DM}; pg8::StaticOrder S; S.init(g.M, g.N, G, (int)blockIdx.x);
          EpiProj E{(bf16_t*)(ws + WS_PROJ), (const float*)(ws + WS_COS), (const float*)(ws + WS_SIN), (float*)(ws + WS_KSUM)};
          pg8::gemm_phase<EpiProj, pg8::StaticOrder, true, true>(lds, g, S, E); }
    }
    SEAM(1);
    if (IN(2)) phase2(a, lds);
    SEAM(2);
    if (IN(3)) phase3(a, lds);
    SEAM(3);
    if (IN(4)) phase4(a);
    SEAM(4);
    if (IN(5)) {
        pg8::Gemm g{(const bf16_t*)(ws + WS_Y), (const bf16_t*)(ws + WS_WOUT), MROWS, DM, DM}; pg8::StaticOrder S; S.init(g.M, g.N, G, (int)blockIdx.x);
        EpiPlain E{(bf16_t*)(ws + WS_SUB), DM};
        pg8::gemm_phase<EpiPlain, pg8::StaticOrder, true, true>(lds, g, S, E);
    }
    SEAM(5);
    if (IN(6)) phase6(a);
#undef IN
#undef SEAM
}

extern "C" void kernel_launch(void* const* d_in, const int* in_sizes, int n_in, void* d_out, int out_size, void* d_ws, size_t ws_size, hipStream_t stream) {
    static int grid = 0;
    if (grid == 0) {
        if (n_in != 12 || ws_size < WS_END) { fprintf(stderr, "kernel_launch: unexpected inputs (n_in %d, ws %zu)\n", n_in, ws_size); grid = -1; return; }
        int dev = 0, cus = 0, per_cu = 0;
        hipGetDevice(&dev); hipDeviceGetAttribute(&cus, hipDeviceAttributeMultiprocessorCount, dev);
        hipFuncSetAttribute((const void*)hymba_fwd, hipFuncAttributeMaxDynamicSharedMemorySize, LDS_BYTES);
        hipOccupancyMaxActiveBlocksPerMultiprocessor(&per_cu, (const void*)hymba_fwd, 512, LDS_BYTES);
        if (per_cu < 1) { fprintf(stderr, "kernel_launch: occupancy query reports %d blocks per CU\n", per_cu); per_cu = 1; }
        grid = cus * per_cu;
        (void)hipGetLastError();
    }
    if (grid < 0) return;
    Args a{};
    a.x = (const float*)d_in[0]; a.mem = (const float*)d_in[1]; a.pos = (const int*)d_in[2]; a.w_in = (const float*)d_in[3]; a.w_mkv = (const float*)d_in[4];
    a.gln_g = (const float*)d_in[5]; a.gln_b = (const float*)d_in[6]; a.w_s = (const float*)d_in[7]; a.b_s = (const float*)d_in[8]; a.w_out = (const float*)d_in[9];
    a.ln_g = (const float*)d_in[10]; a.ln_b = (const float*)d_in[11]; a.out = (float*)d_out; a.ws = (unsigned char*)d_ws;
#if MK_MULTI
    for (int p = 0; p < 7; ++p) { a.ph_lo = p; a.ph_hi = p + 1; hipLaunchKernelGGL(hymba_fwd, dim3(grid), dim3(512), LDS_BYTES, stream, a); }
#else
    a.ph_lo = 0; a.ph_hi = 7;
    (void)hipMemsetAsync((char*)d_ws + WS_BAR, 0, BAR_WORDS_N * 4, stream);
    void* args[] = {&a};
    hipError_t e = hipLaunchCooperativeKernel((const void*)hymba_fwd, dim3(grid), dim3(512), args, LDS_BYTES, stream);
    if (e != hipSuccess) fprintf(stderr, "cooperative launch failed: %s (grid %d)\n", hipGetErrorString(e), grid);
#endif
}
```

```cpp
#include <hip/hip_runtime.h>
#include <hip/hip_cooperative_groups.h>
#include <cstdio>
#include <cstdint>
namespace cg = cooperative_groups;

#ifndef MK_MULTI
#define MK_MULTI 0
#endif

#define LAS __attribute__((address_space(3)))
typedef unsigned short bf16_t;
typedef short bf16x8 __attribute__((ext_vector_type(8)));
typedef float f32x4 __attribute__((ext_vector_type(4)));
typedef float f32x2 __attribute__((ext_vector_type(2)));
typedef unsigned u32x4 __attribute__((ext_vector_type(4)));
typedef unsigned u32x2 __attribute__((ext_vector_type(2)));

constexpr int BATCH = 2, SEQ = 16384, DM = 2048, DIN = 6656, MROWS = BATCH * SEQ, NBLK = 64, MEMLEN = 256;
constexpr int C_K = 1024, C_V = 2048, C_GMO = 3072, C_U = 4096, C_VG = 4608, C_GG = 5120, C_QME = 5632, C_GME = 6144;
constexpr float QSCALE = 0.08838834764831845f * 1.4426950408889634f;
constexpr float ALPHA = 1.189207115002721f;
constexpr float LN_EPS = 1e-5f;
constexpr int LIST_PER_BH = 256 * 2080;
constexpr int QCH = 1024;
constexpr int MQCH = 512;

constexpr size_t MiB = 1u << 20;
constexpr size_t WS_CNT = 0;
constexpr size_t WS_BAR = 8192;
constexpr size_t WS_KSUM = 64 * 1024;
constexpr size_t WS_WIN = 1 * MiB;
constexpr size_t WS_WOUT = 28 * MiB;
constexpr size_t WS_WMKV = 36 * MiB;
constexpr size_t WS_WSB = 40 * MiB;
constexpr size_t WS_MEMB = 41 * MiB;
constexpr size_t WS_MKV = 43 * MiB;
constexpr size_t WS_COS = 44 * MiB;
constexpr size_t WS_SIN = 52 * MiB;
constexpr size_t WS_LIST = 60 * MiB;
constexpr size_t WS_PML = 96 * MiB;
constexpr size_t WS_Y = 104 * MiB;
constexpr size_t WS_PROJ = 232 * MiB;
constexpr size_t WS_PO = 648 * MiB;
constexpr size_t WS_SUB = 648 * MiB;
constexpr size_t WS_XB = 648 * MiB;
constexpr size_t WS_END = 904 * MiB;
constexpr int LDS_BYTES = 152 * 1024;
constexpr int BAR_WORDS_N = 3456;

namespace pg8 {
constexpr int BM = 256, BK = 64, HALF = 128, HTB = HALF * BK * 2, STAGE_BYTES = 8 * HTB, NXCD = 8, WGM = 8;
__host__ __device__ __forceinline__ int lds_byte(int r, int c) { const int st = (r >> 4) * 2 + (c >> 5), rr = r & 15, cc = c & 31, ob = rr * 64 + cc * 2; return st * 1024 + (ob ^ (((ob >> 9) & 1) << 5)); }
__host__ __device__ __forceinline__ void stage_rc(int b, int& R, int& C) { const int st = b / 1024, sb = b % 1024, swz = sb ^ (((sb >> 9) & 1) << 5); R = (st >> 1) * 16 + swz / 64; C = (st & 1) * 32 + (swz % 64) / 2; }
__host__ __device__ __forceinline__ int perm32(int rho) { const int n = rho >> 4, i = rho & 15; return 8 * (i >> 2) + 4 * n + (i & 3); }
struct Unit { int pm, pn; };
struct Gemm { const bf16_t* A; const bf16_t* Bt; int M, N, K; };
struct StaticOrder {
    int nM, nN, nwg, G, c;
    __host__ __device__ void init(int M, int N, int G_, int c_) { nM = M / BM; nN = N / BM; nwg = nM * nN; G = G_; c = c_; }
    __host__ __device__ bool next(int i, Unit& u) const {
        const long L = (long)i * G + c; if (L >= nwg) return false;
        int wgid = (int)L; { const int q = nwg / NXCD, r = nwg % NXCD, xcd = wgid % NXCD, off = wgid / NXCD; wgid = (xcd < r ? xcd * (q + 1) : r * (q + 1) + (xcd - r) * q) + off; }
        const int nig = WGM * nN, gid = wgid / nig, fm = gid * WGM, gsz = (nM - fm) < WGM ? (nM - fm) : WGM;
        u.pm = fm + ((wgid % nig) % gsz); u.pn = (wgid % nig) / gsz; return true;
    }
    __device__ __forceinline__ void a_ready(const Unit&) const {}
    __device__ __forceinline__ void done(const Unit&) const {}
};
__device__ __forceinline__ unsigned cvt_pk_bf16(float lo, float hi) { unsigned r; asm volatile("v_cvt_pk_bf16_f32 %0, %1, %2" : "=v"(r) : "v"(lo), "v"(hi)); return r; }

template <class Epi, class Sched, bool ALIGN_EPI = false, bool SP2 = false>
__device__ __forceinline__ void gemm_phase(LAS unsigned char* lds, const Gemm g, const Sched& S, const Epi& E) {
    const int tid = threadIdx.x, wid = __builtin_amdgcn_readfirstlane(tid >> 6), lane = tid & 63, wr = wid >> 2, wc = wid & 3, fr = lane & 15, fq = lane >> 4;
    const int K = g.K, nt = K / BK;
    unsigned voffA[2], voffB[2];
#pragma unroll
    for (int i = 0; i < 2; ++i) { int R, C; stage_rc(tid * 16 + i * 8192, R, C); const int Rb = Epi::PERM ? ((R & ~31) + perm32(R & 31)) : R;
        voffA[i] = (unsigned)(R * K + C) * 2u; voffB[i] = (unsigned)(Rb * K + C) * 2u; }
    const size_t kstep = (size_t)(BK * 2);
    const size_t hstep = (size_t)HALF * K * 2;
    const size_t tstep = 2 * hstep;
    const unsigned ldsw = (unsigned)wid * 1024u;
    const int aoff = lds_byte(wr * 64 + fr, fq * 8), boff = lds_byte(wc * 32 + fr, fq * 8);
#define PG8_SA(b, h) (((b) * 2 + (h)) * HTB)
#define PG8_SB(b, h) ((4 + (b) * 2 + (h)) * HTB)
#define PG8_STAGE(bufoff, gbase, voff) do { _Pragma("unroll") for (int _i = 0; _i < 2; ++_i) \
        __builtin_amdgcn_global_load_lds((const unsigned*)((const char*)(gbase) + (voff)[_i]), (LAS unsigned*)(lds + (bufoff) + ldsw + _i * 8192), 16, 0, 0); } while (0)
#define PG8_LDA(dst, b, h) do { _Pragma("unroll") for (int m = 0; m < 4; ++m) _Pragma("unroll") for (int k = 0; k < 2; ++k) dst[m][k] = *(const LAS bf16x8*)(lds + PG8_SA(b, h) + aoff + m * 2048 + k * 1024); } while (0)
#define PG8_LDB(dst, b, h) do { _Pragma("unroll") for (int n = 0; n < 2; ++n) _Pragma("unroll") for (int k = 0; k < 2; ++k) dst[n][k] = *(const LAS bf16x8*)(lds + PG8_SB(b, h) + boff + n * 2048 + k * 1024); } while (0)
#define PG8_MMA(ai, bj, At, Bt) do { __builtin_amdgcn_s_setprio(1); _Pragma("unroll") for (int m = 0; m < 4; ++m) _Pragma("unroll") for (int n = 0; n < 2; ++n) _Pragma("unroll") for (int k = 0; k < 2; ++k) \
        acc[ai][bj][m][n] = __builtin_amdgcn_mfma_f32_16x16x32_bf16(Bt[n][k], At[m][k], acc[ai][bj][m][n], 0, 0, 0); __builtin_amdgcn_s_setprio(0); } while (0)
#define PG8_WAIT_V(n) asm volatile("s_waitcnt vmcnt(" #n ")" ::: "memory")
#define PG8_WAIT_L(n) asm volatile("s_waitcnt lgkmcnt(" #n ")" ::: "memory")
#define PG8_BAR __builtin_amdgcn_s_barrier()
#define PG8_SCHED __builtin_amdgcn_sched_barrier(0)
    Unit cur, nxt; int ui = 0;
    if (!S.next(0, cur)) return;
    f32x4 acc[2][2][4][2];
#pragma unroll
    for (int a = 0; a < 2; ++a)
#pragma unroll
        for (int b = 0; b < 2; ++b)
#pragma unroll
            for (int m = 0; m < 4; ++m)
#pragma unroll
                for (int n = 0; n < 2; ++n) acc[a][b][m][n] = (f32x4){0.f, 0.f, 0.f, 0.f};
    bf16x8 At[4][2], B0[2][2], B1[2][2];
    const char* cA = (const char*)g.A + (size_t)cur.pm * tstep; const char* cB = (const char*)g.Bt + (size_t)cur.pn * tstep;
    S.a_ready(cur);
    if constexpr (SP2) {
        PG8_STAGE(PG8_SB(0, 0), cB, voffB); PG8_STAGE(PG8_SB(0, 1), cB + hstep, voffB); PG8_STAGE(PG8_SA(0, 0), cA, voffA); PG8_STAGE(PG8_SA(0, 1), cA + hstep, voffA);
        if (wr == 1) PG8_BAR;
        PG8_WAIT_V(2); PG8_BAR;
        PG8_STAGE(PG8_SB(1, 0), cB + kstep, voffB); PG8_STAGE(PG8_SA(1, 0), cA + kstep, voffA); PG8_STAGE(PG8_SB(1, 1), cB + hstep + kstep, voffB);
        PG8_WAIT_V(6); PG8_BAR;
    } else {
        PG8_STAGE(PG8_SB(0, 0), cB, voffB); PG8_STAGE(PG8_SA(0, 0), cA, voffA); PG8_STAGE(PG8_SB(0, 1), cB + hstep, voffB); PG8_STAGE(PG8_SA(0, 1), cA + hstep, voffA);
        if (wr == 1) PG8_BAR;
        PG8_WAIT_V(4); PG8_BAR;
        PG8_STAGE(PG8_SB(1, 0), cB + kstep, voffB); PG8_STAGE(PG8_SA(1, 0), cA + kstep, voffA); PG8_STAGE(PG8_SB(1, 1), cB + hstep + kstep, voffB);
        PG8_WAIT_V(6); PG8_BAR;
    }
    for (;;) {
        const bool has_next = S.next(ui + 1, nxt);
        const char* nA = has_next ? (const char*)g.A + (size_t)nxt.pm * tstep : cA; const char* nB = has_next ? (const char*)g.Bt + (size_t)nxt.pn * tstep : cB;
        for (int t = 0; t < nt; t += 2) {
            const bool last = (t == nt - 2);
            const char* a1 = cA + (size_t)(t + 1) * kstep;
            const char* a2 = last ? nA : cA + (size_t)(t + 2) * kstep; const char* b2 = last ? nB : cB + (size_t)(t + 2) * kstep;
            const char* a3 = a2 + kstep; const char* b3 = b2 + kstep;
            if (last && has_next) S.a_ready(nxt);
            if constexpr (SP2) {
            PG8_LDB(B0, 0, 0); PG8_LDB(B1, 0, 1); PG8_SCHED; PG8_LDA(At, 0, 0); PG8_STAGE(PG8_SA(1, 1), a1 + hstep, voffA);
            PG8_WAIT_V(8); PG8_WAIT_L(0); PG8_BAR; PG8_MMA(0, 0, At, B0); PG8_MMA(0, 1, At, B1); PG8_BAR; PG8_SCHED;
            PG8_LDA(At, 0, 1); PG8_STAGE(PG8_SB(0, 0), b2, voffB); PG8_STAGE(PG8_SB(0, 1), b2 + hstep, voffB); PG8_STAGE(PG8_SA(0, 0), a2, voffA);
            PG8_WAIT_V(8); PG8_WAIT_L(0); PG8_BAR; PG8_MMA(1, 0, At, B0); PG8_MMA(1, 1, At, B1); PG8_BAR; PG8_SCHED;
            PG8_LDB(B0, 1, 0); PG8_LDB(B1, 1, 1); PG8_SCHED; PG8_LDA(At, 1, 0); PG8_STAGE(PG8_SA(0, 1), a2 + hstep, voffA);
            PG8_WAIT_V(8); PG8_WAIT_L(0); PG8_BAR; PG8_MMA(0, 0, At, B0); PG8_MMA(0, 1, At, B1); PG8_BAR; PG8_SCHED;
            PG8_LDA(At, 1, 1); PG8_STAGE(PG8_SB(1, 0), b3, voffB); PG8_STAGE(PG8_SB(1, 1), b3 + hstep, voffB); PG8_STAGE(PG8_SA(1, 0), a3, voffA);
            PG8_WAIT_V(8); PG8_WAIT_L(0); PG8_BAR; PG8_MMA(1, 0, At, B0); PG8_MMA(1, 1, At, B1); PG8_BAR; PG8_SCHED;
            } else {
            PG8_LDB(B0, 0, 0); PG8_SCHED; PG8_LDA(At, 0, 0); PG8_STAGE(PG8_SA(1, 1), a1 + hstep, voffA);
            PG8_WAIT_L(8); PG8_BAR; PG8_WAIT_L(0); PG8_MMA(0, 0, At, B0); PG8_BAR; PG8_SCHED;
            PG8_LDB(B1, 0, 1); PG8_STAGE(PG8_SB(0, 0), b2, voffB);
            PG8_BAR; PG8_WAIT_L(0); PG8_MMA(0, 1, At, B1); PG8_BAR;
            PG8_LDA(At, 0, 1); PG8_STAGE(PG8_SA(0, 0), a2, voffA);
            PG8_BAR; PG8_WAIT_L(0); PG8_MMA(1, 0, At, B0); PG8_BAR; PG8_SCHED;
            PG8_STAGE(PG8_SB(0, 1), b2 + hstep, voffB);
            PG8_WAIT_V(6); PG8_BAR; PG8_MMA(1, 1, At, B1); PG8_BAR;
            PG8_LDB(B0, 1, 0); PG8_SCHED; PG8_LDA(At, 1, 0); PG8_STAGE(PG8_SA(0, 1), a2 + hstep, voffA);
            PG8_WAIT_L(8); PG8_BAR; PG8_WAIT_L(0); PG8_MMA(0, 0, At, B0); PG8_BAR; PG8_SCHED;
            PG8_LDB(B1, 1, 1); PG8_STAGE(PG8_SB(1, 0), b3, voffB);
            PG8_BAR; PG8_WAIT_L(0); PG8_MMA(0, 1, At, B1); PG8_BAR;
            PG8_LDA(At, 1, 1); PG8_STAGE(PG8_SA(1, 0), a3, voffA);
            PG8_BAR; PG8_WAIT_L(0); PG8_MMA(1, 0, At, B0); PG8_BAR; PG8_SCHED;
            PG8_STAGE(PG8_SB(1, 1), b3 + hstep, voffB);
            PG8_WAIT_V(6); PG8_BAR; PG8_MMA(1, 1, At, B1); PG8_BAR;
            }
        }
        if constexpr (ALIGN_EPI) { if (wr == 0) PG8_BAR; }
        E(acc, cur, wr, wc, fr, fq); S.done(cur);
        if (!has_next) break;
#pragma unroll
        for (int a = 0; a < 2; ++a)
#pragma unroll
            for (int b = 0; b < 2; ++b)
#pragma unroll
                for (int m = 0; m < 4; ++m)
#pragma unroll
                    for (int n = 0; n < 2; ++n) acc[a][b][m][n] = (f32x4){0.f, 0.f, 0.f, 0.f};
        cur = nxt; cA = nA; cB = nB; ++ui;
        if constexpr (ALIGN_EPI) { if (wr == 1) PG8_BAR; }
    }
    PG8_WAIT_V(0);
    if constexpr (!ALIGN_EPI) { if (wr == 0) PG8_BAR; }
    PG8_BAR;
#undef PG8_SA
#undef PG8_SB
#undef PG8_STAGE
#undef PG8_LDA
#undef PG8_LDB
#undef PG8_MMA
#undef PG8_WAIT_V
#undef PG8_WAIT_L
#undef PG8_BAR
#undef PG8_SCHED
}
}

using pg8::cvt_pk_bf16;
__device__ __forceinline__ float bf2f(unsigned short b) { return __builtin_bit_cast(float, (unsigned)b << 16); }
__device__ __forceinline__ float bflo(unsigned w) { return __builtin_bit_cast(float, w << 16); }
__device__ __forceinline__ float bfhi(unsigned w) { return __builtin_bit_cast(float, w & 0xffff0000u); }
__device__ __forceinline__ float fast_exp2(float x) { return __builtin_amdgcn_exp2f(x); }
__device__ __forceinline__ float fast_rcp(float x) { return __builtin_amdgcn_rcpf(x); }
__device__ __forceinline__ float silu_f(float x) { return x * fast_rcp(1.f + fast_exp2(-1.4426950408889634f * x)); }
__device__ __forceinline__ float gelu_tanh_f(float x) {
    const float t = x * (1.f + 0.044715f * x * x) * (-1.5957691216057308f * 1.4426950408889634f);
    return x * fast_rcp(1.f + fast_exp2(t));
}
#define LDS_WAIT() asm volatile("s_waitcnt lgkmcnt(0)" ::: "memory")

struct EpiProj {
    static constexpr bool PERM = true;
    bf16_t* O; const float* cosT; const float* sinT; float* ksum;
    __device__ __forceinline__ void operator()(const f32x4 (&acc)[2][2][4][2], const pg8::Unit& u, int wr, int wc, int fr, int fq) const {
        const int pn = u.pn;
        const int type = pn < 4 ? 0 : pn < 8 ? 1 : pn < 12 ? 2 : pn < 16 ? 3 : pn < 20 ? 4 : pn < 22 ? 3 : pn < 24 ? 5 : 3;
        const int row0 = u.pm * 256 + wr * 64 + fr;
        const int col0 = pn * 256 + wc * 32 + 8 * fq;
        float cs[2][8];
#pragma unroll
        for (int bj = 0; bj < 2; ++bj)
#pragma unroll
            for (int e = 0; e < 8; ++e) cs[bj][e] = 0.f;
#pragma unroll
        for (int ai = 0; ai < 2; ++ai) {
            f32x4 c4v[4], s4v[4];
#pragma unroll
            for (int m = 0; m < 4; ++m) { c4v[m] = (f32x4){1.f, 1.f, 1.f, 1.f}; s4v[m] = (f32x4){0.f, 0.f, 0.f, 0.f}; }
            if (type <= 1) {
#pragma unroll
                for (int m = 0; m < 4; ++m) { const size_t ro = (size_t)(row0 + ai * 128 + m * 16) * 64 + 16 * wc + 4 * fq; c4v[m] = *(const f32x4*)(cosT + ro); s4v[m] = *(const f32x4*)(sinT + ro); }
            }
            __builtin_amdgcn_sched_barrier(0);
#pragma unroll
            for (int m = 0; m < 4; ++m) {
                const int row = row0 + ai * 128 + m * 16;
                const f32x4 c4 = c4v[m], s4 = s4v[m];
                bf16_t* rowp = O + (size_t)row * DIN + col0;
#pragma unroll
                for (int bj = 0; bj < 2; ++bj) {
                    f32x4 v0 = acc[ai][bj][m][0], v1 = acc[ai][bj][m][1];
                    float o[8];
                    if (type <= 1) {
                        o[0] = v0[0] * c4[0] - v0[1] * s4[0]; o[1] = v0[1] * c4[0] + v0[0] * s4[0];
                        o[2] = v0[2] * c4[1] - v0[3] * s4[1]; o[3] = v0[3] * c4[1] + v0[2] * s4[1];
                        o[4] = v1[0] * c4[2] - v1[1] * s4[2]; o[5] = v1[1] * c4[2] + v1[0] * s4[2];
                        o[6] = v1[2] * c4[3] - v1[3] * s4[3]; o[7] = v1[3] * c4[3] + v1[2] * s4[3];
                        if (type == 0) {
#pragma unroll
                            for (int e = 0; e < 8; ++e) o[e] *= QSCALE;
                        } else {
#pragma unroll
                            for (int e = 0; e < 8; ++e) cs[bj][e] += o[e];
                        }
                    } else {
#pragma unroll
                        for (int e = 0; e < 4; ++e) { o[e] = v0[e]; o[4 + e] = v1[e]; }
                        if (type == 3) {
#pragma unroll
                            for (int e = 0; e < 8; ++e) o[e] = silu_f(o[e]);
                        } else if (type == 4) {
#pragma unroll
                            for (int e = 0; e < 8; ++e) o[e] = gelu_tanh_f(o[e]);
                        } else if (type == 5) {
#pragma unroll
                            for (int e = 0; e < 8; ++e) o[e] *= QSCALE;
                        }
                    }
                    u32x4 w; w.x = cvt_pk_bf16(o[0], o[1]); w.y = cvt_pk_bf16(o[2], o[3]); w.z = cvt_pk_bf16(o[4], o[5]); w.w = cvt_pk_bf16(o[6], o[7]);
                    __builtin_nontemporal_store(w, (u32x4*)(rowp + bj * 128));
                }
            }
            __builtin_amdgcn_sched_barrier(0);
        }
        if (type == 1) {
#pragma unroll
            for (int bj = 0; bj < 2; ++bj)
#pragma unroll
                for (int e = 0; e < 8; ++e) {
                    float v = cs[bj][e];
                    v += __shfl_xor(v, 1); v += __shfl_xor(v, 2); v += __shfl_xor(v, 4); v += __shfl_xor(v, 8);
                    cs[bj][e] = v;
                }
            if (fr == 0) {
                float* kp = ksum + (size_t)u.pm * 1024 + (pn - 4) * 256 + wc * 32 + 8 * fq;
#pragma unroll
                for (int bj = 0; bj < 2; ++bj)
#pragma unroll
                    for (int e = 0; e < 8; ++e) atomicAdd(kp + bj * 128 + e, cs[bj][e]);
            }
        }
    }
};
struct EpiPlain {
    static constexpr bool PERM = true;
    bf16_t* O; int ldc;
    __device__ __forceinline__ void operator()(const f32x4 (&acc)[2][2][4][2], const pg8::Unit& u, int wr, int wc, int fr, int fq) const {
        const int row0 = u.pm * 256 + wr * 64 + fr, col0 = u.pn * 256 + wc * 32 + 8 * fq;
#pragma unroll
        for (int ai = 0; ai < 2; ++ai)
#pragma unroll
            for (int m = 0; m < 4; ++m) { bf16_t* rowp = O + (size_t)(row0 + ai * 128 + m * 16) * ldc + col0;
#pragma unroll
                for (int bj = 0; bj < 2; ++bj) { const f32x4 v0 = acc[ai][bj][m][0], v1 = acc[ai][bj][m][1];
                    u32x4 w; w.x = cvt_pk_bf16(v0[0], v0[1]); w.y = cvt_pk_bf16(v0[2], v0[3]); w.z = cvt_pk_bf16(v1[0], v1[1]); w.w = cvt_pk_bf16(v1[2], v1[3]);
                    *(u32x4*)(rowp + bj * 128) = w; } }
    }
};
struct EpiResid {
    static constexpr bool PERM = true;
    const float* __restrict__ x; float* __restrict__ out;
    __device__ __forceinline__ void operator()(const f32x4 (&acc)[2][2][4][2], const pg8::Unit& u, int wr, int wc, int fr, int fq) const {
        const int row0 = u.pm * 256 + wr * 64 + fr, col0 = u.pn * 256 + wc * 32 + 8 * fq;
#pragma unroll
        for (int ai = 0; ai < 2; ++ai) {
            f32x4 xv[4][2][2];
#pragma unroll
            for (int m = 0; m < 4; ++m) { const size_t off = (size_t)(row0 + ai * 128 + m * 16) * DM + col0;
#pragma unroll
                for (int bj = 0; bj < 2; ++bj)
#pragma unroll
                    for (int n = 0; n < 2; ++n) xv[m][bj][n] = *(const f32x4*)(x + off + bj * 128 + 4 * n); }
            __builtin_amdgcn_sched_barrier(0);
#pragma unroll
            for (int m = 0; m < 4; ++m) { const size_t off = (size_t)(row0 + ai * 128 + m * 16) * DM + col0;
#pragma unroll
                for (int bj = 0; bj < 2; ++bj)
#pragma unroll
                    for (int n = 0; n < 2; ++n) *(f32x4*)(out + off + bj * 128 + 4 * n) = xv[m][bj][n] * ALPHA + acc[ai][bj][m][n]; }
            __builtin_amdgcn_sched_barrier(0);
        }
    }
};

struct Args { const float* x; const float* mem; const int* pos; const float* w_in; const float* w_mkv; const float* gln_g; const float* gln_b;
              const float* w_s; const float* b_s; const float* w_out; const float* ln_g; const float* ln_b; float* out; unsigned char* ws; int ph_lo, ph_hi; };

__device__ __forceinline__ void p0_transpose_item(const float* W, int K, int N, bf16_t* WT, bool permute_qk, LAS float* scr, int item, int lane) {
    const int nblk = N / 32, kb = item / nblk, nb = item % nblk, k0 = 64 * kb, n0 = 32 * nb;
    const int ncol = n0 + (lane & 31);
    int src = ncol;
    if (permute_qk && ncol < 2048) { const int p = ncol & 127; src = (ncol & ~127) + ((p & 1) << 6) + (p >> 1); }
#pragma unroll 8
    for (int i = 0; i < 32; ++i) { const int kk = 2 * i + (lane >> 5); scr[kk * 33 + (lane & 31)] = W[(size_t)(k0 + kk) * N + src]; }
    LDS_WAIT();
    const int c = lane & 7;
#pragma unroll
    for (int j = 0; j < 4; ++j) { const int n = (lane >> 3) + 8 * j; const LAS float* s = scr + (8 * c) * 33 + n;
        u32x4 o; o.x = cvt_pk_bf16(s[0 * 33], s[1 * 33]); o.y = cvt_pk_bf16(s[2 * 33], s[3 * 33]); o.z = cvt_pk_bf16(s[4 * 33], s[5 * 33]); o.w = cvt_pk_bf16(s[6 * 33], s[7 * 33]);
        *(u32x4*)(WT + (size_t)(n0 + n) * K + k0 + 8 * c) = o; }
    LDS_WAIT();
}

__device__ __forceinline__ void phase0(const Args& a, LAS unsigned char* lds) {
    unsigned char* ws = a.ws;
    const int tid = threadIdx.x, lane = tid & 63, wave = tid >> 6;
    const int G = gridDim.x;
    const size_t gtid = (size_t)blockIdx.x * 512 + tid, NT = (size_t)G * 512;
    { int* cnt = (int*)(ws + WS_CNT); for (size_t i = gtid; i < 1088; i += NT) cnt[i] = 0;
      float* ks = (float*)(ws + WS_KSUM); for (size_t i = gtid; i < 128 * 1024; i += NT) ks[i] = 0.f; }
    { LAS float* scr = (LAS float*)(lds + wave * 16384);
      const int gw = blockIdx.x * 8 + wave, NGW = G * 8;
      constexpr int I_IN = (DM / 64) * (DIN / 32), I_OUT = (DM / 64) * (DM / 32), I_MKV = (DM / 64) * (1024 / 32);
      for (int it = gw; it < I_IN + I_OUT + I_MKV; it += NGW) {
          int r = it;
          if (r < I_IN) { p0_transpose_item(a.w_in, DM, DIN, (bf16_t*)(ws + WS_WIN), true, scr, r, lane); continue; } r -= I_IN;
          if (r < I_OUT) { p0_transpose_item(a.w_out, DM, DM, (bf16_t*)(ws + WS_WOUT), false, scr, r, lane); continue; } r -= I_OUT;
          p0_transpose_item(a.w_mkv, DM, 1024, (bf16_t*)(ws + WS_WMKV), false, scr, r, lane);
      } }
    { const size_t n8 = (size_t)MROWS * DM / 8; u32x4* xb = (u32x4*)(ws + WS_XB);
      for (size_t i0 = gtid; i0 < n8; i0 += 4 * NT) {
          f32x4 v[4][2];
#pragma unroll
          for (int j = 0; j < 4; ++j) { const size_t i = i0 + j * NT; if (i < n8) { v[j][0] = __builtin_nontemporal_load((const f32x4*)a.x + 2 * i); v[j][1] = __builtin_nontemporal_load((const f32x4*)a.x + 2 * i + 1); } }
          __builtin_amdgcn_sched_barrier(0);
#pragma unroll
          for (int j = 0; j < 4; ++j) { const size_t i = i0 + j * NT; if (i < n8) { const f32x4 v0 = v[j][0], v1 = v[j][1];
              u32x4 o; o.x = cvt_pk_bf16(v0[0], v0[1]); o.y = cvt_pk_bf16(v0[2], v0[3]); o.z = cvt_pk_bf16(v1[0], v1[1]); o.w = cvt_pk_bf16(v1[2], v1[3]); xb[i] = o; } }
          __builtin_amdgcn_sched_barrier(0);
      }
      const size_t m8 = (size_t)BATCH * MEMLEN * DM / 8; u32x4* mb = (u32x4*)(ws + WS_MEMB);
      for (size_t i = gtid; i < m8; i += NT) { const f32x4 v0 = ((const f32x4*)a.mem)[2 * i], v1 = ((const f32x4*)a.mem)[2 * i + 1];
          u32x4 o; o.x = cvt_pk_bf16(v0[0], v0[1]); o.y = cvt_pk_bf16(v0[2], v0[3]); o.z = cvt_pk_bf16(v1[0], v1[1]); o.w = cvt_pk_bf16(v1[2], v1[3]); mb[i] = o; } }
    { bf16_t* wsb = (bf16_t*)(ws + WS_WSB);
      for (size_t i = gtid; i < 4 * 128 * 128; i += NT) { const int t = (int)(i >> 7) & 127, s = (int)i & 127; const float v = s <= t ? a.w_s[i] : 0.f; wsb[i] = (bf16_t)(cvt_pk_bf16(v, 0.f) & 0xffffu); } }
    { float* cT = (float*)(ws + WS_COS); float* sT = (float*)(ws + WS_SIN);
      LAS float* invf = (LAS float*)(lds + 8 * 16384);
      if (tid < 64) invf[tid] = (float)exp2(-(double)tid * (13.287712379549449 / 64.0));
      __syncthreads();
      for (size_t e = gtid; e < (size_t)MROWS * 64; e += NT) { const int row = (int)(e >> 6), i = (int)e & 63;
          const float inv = invf[i];
          const float ang = (float)a.pos[row] * inv;
          const double rev = (double)ang * 0.15915494309189535; const float fr = (float)(rev - rint(rev));
          cT[e] = __builtin_amdgcn_cosf(fr); sT[e] = __builtin_amdgcn_sinf(fr); } }
}

__device__ __forceinline__ int list_base(int n) { return 256 * (64 * n - (n * (n - 1)) / 2); }
__device__ __forceinline__ unsigned long long shfl_xor_u64(unsigned long long v, int m) {
    unsigned lo = (unsigned)v, hi = (unsigned)(v >> 32); lo = __shfl_xor(lo, m); hi = __shfl_xor(hi, m); return ((unsigned long long)hi << 32) | lo; }

__device__ __forceinline__ void phase2(const Args& a, LAS unsigned char* lds) {
    unsigned char* ws = a.ws;
    const int tid = threadIdx.x, lane = tid & 63, wave = __builtin_amdgcn_readfirstlane(tid >> 6), fr = lane & 15, fq = lane >> 4;
    const bf16_t* proj = (const bf16_t*)(ws + WS_PROJ);
    const float* ksum = (const float*)(ws + WS_KSUM);
    int* cnt = (int*)(ws + WS_CNT);
    unsigned* list = (unsigned*)(ws + WS_LIST);
    LAS unsigned char* Kl = lds;
    LAS int* lcnt = (LAS int*)(lds + 16384);
    LAS int* gbase = (LAS int*)(lds + 16384 + 256);
    { const bf16_t* memb = (const bf16_t*)(ws + WS_MEMB); const bf16_t* wt = (const bf16_t*)(ws + WS_WMKV); bf16_t* mkv = (bf16_t*)(ws + WS_MKV);
      for (int t = blockIdx.x; t < 256; t += gridDim.x) {
          const int m0 = (t & 15) * 32 + 16 * (wave & 1), n0 = (t >> 4) * 64 + 16 * (wave >> 1);
          const bf16_t* ap = wt + (size_t)(n0 + fr) * DM + 8 * fq; const bf16_t* bp = memb + (size_t)(m0 + fr) * DM + 8 * fq;
          f32x4 acc = (f32x4){0.f, 0.f, 0.f, 0.f};
          bf16x8 av[8], bv[8], an[8], bn[8];
#pragma unroll
          for (int i = 0; i < 8; ++i) { av[i] = *(const bf16x8*)(ap + 32 * i); bv[i] = *(const bf16x8*)(bp + 32 * i); }
#pragma unroll 1
          for (int kb = 0; kb < 8; ++kb) {
              const int kn = kb < 7 ? kb + 1 : kb;
#pragma unroll
              for (int i = 0; i < 8; ++i) { an[i] = *(const bf16x8*)(ap + 32 * (8 * kn + i)); bn[i] = *(const bf16x8*)(bp + 32 * (8 * kn + i)); }
              __builtin_amdgcn_sched_barrier(0);
#pragma unroll
              for (int i = 0; i < 8; ++i) acc = __builtin_amdgcn_mfma_f32_16x16x32_bf16(av[i], bv[i], acc, 0, 0, 0);
              __builtin_amdgcn_sched_barrier(0);
#pragma unroll
              for (int i = 0; i < 8; ++i) { av[i] = an[i]; bv[i] = bn[i]; }
          }
          u32x2 w; w.x = cvt_pk_bf16(acc[0], acc[1]); w.y = cvt_pk_bf16(acc[2], acc[3]);
          *(u32x2*)(mkv + (size_t)(m0 + fr) * 1024 + n0 + 4 * fq) = w; } }
    LAS int* pend_n = (LAS int*)(lds + 18432);
    LAS int* pend_lp = (LAS int*)(lds + 18432 + 16384);
    LAS int* lcnt4 = (LAS int*)(lds + 16384);
    LAS int* gbase4 = (LAS int*)(lds + 16384 + 1024);
    for (int grp = blockIdx.x; grp < 256; grp += gridDim.x) {
        const int bh = grp >> 4, qb0 = (grp & 15) * 4, b = bh >> 3, h = bh & 7;
        { const int n = tid >> 3, c2 = tid & 7; const float* kp = ksum + (size_t)(b * 64 + n) * 1024 + h * 128 + c2 * 16;
          const f32x4 v0 = *(const f32x4*)kp, v1 = *(const f32x4*)(kp + 4), v2 = *(const f32x4*)(kp + 8), v3 = *(const f32x4*)(kp + 12);
          u32x4 w0, w1; w0.x = cvt_pk_bf16(v0[0], v0[1]); w0.y = cvt_pk_bf16(v0[2], v0[3]); w0.z = cvt_pk_bf16(v1[0], v1[1]); w0.w = cvt_pk_bf16(v1[2], v1[3]);
          w1.x = cvt_pk_bf16(v2[0], v2[1]); w1.y = cvt_pk_bf16(v2[2], v2[3]); w1.z = cvt_pk_bf16(v3[0], v3[1]); w1.w = cvt_pk_bf16(v3[2], v3[3]);
          *(LAS u32x4*)(Kl + n * 256 + (((2 * c2) ^ (n & 15)) << 4)) = w0; *(LAS u32x4*)(Kl + n * 256 + (((2 * c2 + 1) ^ (n & 15)) << 4)) = w1;
          if (tid < 256) lcnt4[tid] = 0; }
        const bf16_t* qbase = proj + (size_t)(b * SEQ + wave * 32 + fr) * DIN + h * 128 + 8 * fq;
        bf16x8 qcur[2][4];
#pragma unroll
        for (int tt = 0; tt < 2; ++tt)
#pragma unroll
            for (int k = 0; k < 4; ++k) qcur[tt][k] = *(const bf16x8*)(qbase + (size_t)(qb0 * 256 + tt * 16) * DIN + 32 * k);
        __syncthreads();
#pragma unroll 1
        for (int kk = 0; kk < 4; ++kk) {
            const int qb = qb0 + kk;
            bf16x8 qnxt[2][4];
            { const int qbn = kk < 3 ? qb + 1 : qb;
#pragma unroll
              for (int tt = 0; tt < 2; ++tt)
#pragma unroll
                  for (int k = 0; k < 4; ++k) qnxt[tt][k] = *(const bf16x8*)(qbase + (size_t)(qbn * 256 + tt * 16) * DIN + 32 * k); }
#pragma unroll
            for (int tt = 0; tt < 2; ++tt) {
                unsigned long long best0 = 0ull, best1 = 0ull, best2 = 0ull;
#pragma unroll
                for (int nt = 0; nt < 4; ++nt) {
                    if (16 * nt < qb) {
                        f32x4 g = (f32x4){0.f, 0.f, 0.f, 0.f};
#pragma unroll
                        for (int k = 0; k < 4; ++k) { const bf16x8 av = *(const LAS bf16x8*)(Kl + (16 * nt + fr) * 256 + (((4 * k + fq) ^ fr) << 4)); g = __builtin_amdgcn_mfma_f32_16x16x32_bf16(av, qcur[tt][k], g, 0, 0, 0); }
#pragma unroll
                        for (int j = 0; j < 4; ++j) { const int n = 16 * nt + 4 * fq + j;
                            const float gj = j == 0 ? g.x : j == 1 ? g.y : j == 2 ? g.z : g.w; const unsigned bits = __float_as_uint(gj); const unsigned ord = (bits & 0x80000000u) ? ~bits : (bits | 0x80000000u);
                            unsigned long long key = n < qb ? (((unsigned long long)ord << 32) | (unsigned)(63 - n)) : 0ull;
                            if (key > best0) { const unsigned long long t = best0; best0 = key; key = t; }
                            if (key > best1) { const unsigned long long t = best1; best1 = key; key = t; }
                            if (key > best2) { best2 = key; } }
                    }
                }
                int ptr = 0; int myn = -1;
#pragma unroll
                for (int r = 0; r < 3; ++r) {
                    const unsigned long long cand = ptr == 0 ? best0 : ptr == 1 ? best1 : ptr == 2 ? best2 : 0ull;
                    unsigned long long g = cand; { const unsigned long long o = shfl_xor_u64(g, 16); g = o > g ? o : g; } { const unsigned long long o = shfl_xor_u64(g, 32); g = o > g ? o : g; }
                    if (g != 0ull && cand == g) ++ptr;
                    if (fq == r && g != 0ull) myn = 63 - (int)(unsigned)(g & 0xffffffffull);
                }
                if (fq == 3) myn = qb;
                int lp = 0;
                if (myn >= 0) lp = __hip_atomic_fetch_add(lcnt4 + kk * 64 + myn, 1, __ATOMIC_RELAXED, __HIP_MEMORY_SCOPE_WORKGROUP);
                pend_n[(kk * 2 + tt) * 512 + tid] = myn; pend_lp[(kk * 2 + tt) * 512 + tid] = lp;
            }
#pragma unroll
            for (int tt = 0; tt < 2; ++tt)
#pragma unroll
                for (int k = 0; k < 4; ++k) qcur[tt][k] = qnxt[tt][k];
        }
        __syncthreads();
        if (tid < 256) { const int c = lcnt4[tid]; gbase4[tid] = c ? atomicAdd(cnt + bh * 64 + (tid & 63), c) : 0; }
        __syncthreads();
#pragma unroll 1
        for (int e = 0; e < 8; ++e) { const int kk = e >> 1, tt = e & 1; const int myn = pend_n[e * 512 + tid];
            if (myn >= 0) { const int s = (qb0 + kk) * 256 + (wave * 2 + tt) * 16 + fr;
                list[(size_t)bh * LIST_PER_BH + list_base(myn) + gbase4[kk * 64 + myn] + pend_lp[e * 512 + tid]] = (unsigned)s | ((unsigned)fq << 14); } }
        __syncthreads();
    }
}

__device__ __forceinline__ float sq8(u32x4 v) {
    const float a = bflo(v.x), b = bfhi(v.x), c = bflo(v.y), d = bfhi(v.y), e = bflo(v.z), f = bfhi(v.z), g = bflo(v.w), h = bfhi(v.w);
    return ((a * a + b * b) + (c * c + d * d)) + ((e * e + f * f) + (g * g + h * h)); }
__device__ __forceinline__ void stage_kv(LAS unsigned char* Kl, LAS unsigned char* Vl, const bf16_t* Kg, const bf16_t* Vg, int stride, int tid, LAS float* kmx) {
    float nmax = 0.f;
#pragma unroll
    for (int it = 0; it < 8; ++it) { const int q = tid + 512 * it, c = q & 15, r = q >> 4;
        const u32x4 v = *(const u32x4*)(Kg + (size_t)r * stride + 8 * c);
        *(LAS u32x4*)(Kl + r * 256 + ((c ^ (r & 15)) << 4)) = v;
        float n2 = sq8(v); n2 += __shfl_xor(n2, 1); n2 += __shfl_xor(n2, 2); n2 += __shfl_xor(n2, 4); n2 += __shfl_xor(n2, 8);
        nmax = fmaxf(nmax, n2); }
    nmax = fmaxf(nmax, __shfl_xor(nmax, 16)); nmax = fmaxf(nmax, __shfl_xor(nmax, 32));
    if ((tid & 63) == 0) kmx[tid >> 6] = nmax;
#pragma unroll
    for (int it = 0; it < 4; ++it) { const int q = tid + 512 * it, c = q & 15, kp = q >> 4, kq = 2 * kp;
        const int key = (kq & 0xE0) | (((kq >> 2) & 1) << 4) | (((kq >> 3) & 3) << 2) | (kq & 3);
        const u32x4 v0 = *(const u32x4*)(Vg + (size_t)key * stride + 8 * c), v1 = *(const u32x4*)(Vg + (size_t)(key + 1) * stride + 8 * c);
        const unsigned a0[4] = {v0.x, v0.y, v0.z, v0.w}, a1[4] = {v1.x, v1.y, v1.z, v1.w};
#pragma unroll
        for (int i = 0; i < 8; ++i) { const int d = 8 * c + i;
            const unsigned lo = (i & 1) ? (a0[i >> 1] >> 16) : (a0[i >> 1] & 0xffffu), hi = (i & 1) ? (a1[i >> 1] & 0xffff0000u) : (a1[i >> 1] << 16);
            *(LAS unsigned*)(Vl + d * 512 + ((((kq >> 3)) ^ (d & 15)) << 4) + (kq & 7) * 2) = lo | hi; } }
}
__device__ __forceinline__ float kmax_of(const LAS float* kmx) {
    float m = kmx[0];
#pragma unroll
    for (int i = 1; i < 8; ++i) m = fmaxf(m, kmx[i]);
    return sqrtf(m) * 1.002f; }

__device__ __forceinline__ float qnorm(const bf16x8 (&qf)[4]) {
    float qq = 0.f;
#pragma unroll
    for (int k = 0; k < 4; ++k) qq += sq8(__builtin_bit_cast(u32x4, qf[k]));
    qq += __shfl_xor(qq, 16); qq += __shfl_xor(qq, 32);
    return sqrtf(qq); }
#define AT_SCHED() __builtin_amdgcn_sched_barrier(0)
#define AT_LOADK(S) do { _Pragma("unroll") for (int k = 0; k < 4; ++k) { kf[2 * k] = *(const LAS bf16x8*)(Kl + kb[k] + (S) * 8192); kf[2 * k + 1] = *(const LAS bf16x8*)(Kl + kb[k] + (S) * 8192 + 4096); } } while (0)
#define AT_LOADV(S) do { const unsigned vb = (unsigned)fr * 512u + ((unsigned)((4 * (S) + fq) ^ fr) << 4); _Pragma("unroll") for (int dt = 0; dt < 8; ++dt) vf[dt] = *(const LAS bf16x8*)(Vl + vb + dt * 8192); } while (0)
__device__ __forceinline__ void attn_core(const LAS unsigned char* Kl, const LAS unsigned char* Vl, const bf16x8 (&qf)[4], int fr, int fq, bool do_mask, int qrel, int smax, float kmax,
                                          f32x4 (&oacc)[8], float& m_out, float& l_out) {
    asm volatile("" : "+v"(fr), "+v"(fq));
    unsigned kb[4];
#pragma unroll
    for (int k = 0; k < 4; ++k) kb[k] = (unsigned)fr * 256u + ((unsigned)((4 * k + fq) ^ fr) << 4);
    bf16x8 kf[8], vf[8];
    AT_LOADK(0); AT_LOADV(0);
    const float m = kmax;
    float l = 0.f;
#pragma unroll
    for (int dt = 0; dt < 8; ++dt) oacc[dt] = (f32x4){0.f, 0.f, 0.f, 0.f};
    f32x4 c0 = (f32x4){-m, -m, -m, -m}, c1 = c0;
    AT_SCHED();
#pragma unroll
    for (int k = 0; k < 4; ++k) { c0 = __builtin_amdgcn_mfma_f32_16x16x32_bf16(kf[2 * k], qf[k], c0, 0, 0, 0); c1 = __builtin_amdgcn_mfma_f32_16x16x32_bf16(kf[2 * k + 1], qf[k], c1, 0, 0, 0); }
    AT_SCHED();
    if (1 < smax) AT_LOADK(1);
#pragma unroll
    for (int s = 0; s < 8; ++s) {
        if (s < smax) {
            AT_SCHED();
            f32x4 n0 = (f32x4){-m, -m, -m, -m}, n1 = n0;
            if (s + 1 < smax) {
#pragma unroll
                for (int k = 0; k < 4; ++k) { n0 = __builtin_amdgcn_mfma_f32_16x16x32_bf16(kf[2 * k], qf[k], n0, 0, 0, 0); n1 = __builtin_amdgcn_mfma_f32_16x16x32_bf16(kf[2 * k + 1], qf[k], n1, 0, 0, 0); }
            }
            AT_SCHED();
            if (s + 2 < smax) AT_LOADK(s + 2);
            AT_SCHED();
            float p[8] = {c0.x, c0.y, c0.z, c0.w, c1.x, c1.y, c1.z, c1.w};
            if (do_mask) {
#pragma unroll
                for (int j = 0; j < 4; ++j) { if (32 * s + 4 * fq + j > qrel) p[j] = -INFINITY; if (32 * s + 16 + 4 * fq + j > qrel) p[4 + j] = -INFINITY; }
            }
#pragma unroll
            for (int j = 0; j < 8; ++j) p[j] = fast_exp2(p[j]);
            l += ((p[0] + p[1]) + (p[2] + p[3])) + ((p[4] + p[5]) + (p[6] + p[7]));
            u32x4 w; w.x = cvt_pk_bf16(p[0], p[1]); w.y = cvt_pk_bf16(p[2], p[3]); w.z = cvt_pk_bf16(p[4], p[5]); w.w = cvt_pk_bf16(p[6], p[7]);
            const bf16x8 pb = __builtin_bit_cast(bf16x8, w);
            AT_SCHED();
#pragma unroll
            for (int dt = 0; dt < 8; ++dt) oacc[dt] = __builtin_amdgcn_mfma_f32_16x16x32_bf16(vf[dt], pb, oacc[dt], 0, 0, 0);
            AT_SCHED();
            if (s + 1 < smax) AT_LOADV(s + 1);
            c0 = n0; c1 = n1;
        }
    }
    AT_SCHED();
    l += __shfl_xor(l, 16); l += __shfl_xor(l, 32);
    m_out = m; l_out = l;
}

__device__ __forceinline__ void phase3(const Args& a, LAS unsigned char* lds) {
    unsigned char* ws = a.ws;
    const int tid = threadIdx.x, lane = tid & 63, wave = __builtin_amdgcn_readfirstlane(tid >> 6), fr = lane & 15, fq = lane >> 4;
    const int fr_ = fr, fq_ = fq, lane_ = lane, tid_ = tid;
    const bf16_t* proj = (const bf16_t*)(ws + WS_PROJ);
    const int* cnt = (const int*)(ws + WS_CNT);
    const unsigned* list = (const unsigned*)(ws + WS_LIST);
    bf16_t* PO = (bf16_t*)(ws + WS_PO); f32x2* PML = (f32x2*)(ws + WS_PML);
    bf16_t* Y = (bf16_t*)(ws + WS_Y);
    LAS unsigned char* Kl = lds; LAS unsigned char* Vl = lds + 65536;
    LAS int* pre = (LAS int*)(lds + 131072);
    LAS float* kmx = (LAS float*)(lds + 131072 + 12288);
    LAS int* prp = (LAS int*)(lds + 131072 + 4352);
    LAS int* nxt = (LAS int*)(lds + 131072 + 12288 + 64);
    if (wave == 0) {
        int locf[16], locp[16]; int sumf = 0, sump = 0;
#pragma unroll
        for (int i = 0; i < 16; ++i) { const int c = cnt[lane * 16 + i]; locf[i] = c / QCH; locp[i] = (c % QCH) ? 1 : 0; sumf += locf[i]; sump += locp[i]; }
        int incf = sumf, incp = sump;
#pragma unroll
        for (int o = 1; o < 64; o <<= 1) { const int vf_ = __shfl_up(incf, o), vp_ = __shfl_up(incp, o); if (lane >= o) { incf += vf_; incp += vp_; } }
        int runf = incf - sumf, runp = incp - sump;
#pragma unroll
        for (int i = 0; i < 16; ++i) { pre[lane * 16 + i] = runf; prp[lane * 16 + i] = runp; runf += locf[i]; runp += locp[i]; }
        if (lane == 63) { pre[1024] = runf; prp[1024] = runp; }
    }
    __syncthreads();
    const int nfull = pre[1024], npart = prp[1024];
    int* ticket = (int*)(ws + WS_CNT) + 1024;
    int it_static = blockIdx.x; bool dyn = false;
    for (;;) {
        int idx = 0;
        if (!dyn) { if (it_static < nfull) { idx = it_static; it_static += gridDim.x; } else dyn = true; }
        if (dyn) {
            __syncthreads();
            if (tid == 0) nxt[0] = atomicAdd(ticket, 1);
            __syncthreads();
            idx = nxt[0];
            if (idx >= npart) break;
            idx += nfull;
        }
        int u, c;
        if (idx < nfull) { int lo = 0, hi = 1024; while (hi - lo > 1) { const int mid = (lo + hi) >> 1; if (pre[mid] <= idx) lo = mid; else hi = mid; } u = lo; c = idx - pre[u]; }
        else { const int j = idx - nfull; int lo = 0, hi = 1024; while (hi - lo > 1) { const int mid = (lo + hi) >> 1; if (prp[mid] <= j) lo = mid; else hi = mid; } u = lo; c = cnt[u] / QCH; }
        const int bh = u >> 6, n = u & 63, b = bh >> 3, h = bh & 7;
        int tid = tid_, fr = fr_, fq = fq_; asm volatile("" : "+v"(tid), "+v"(fr), "+v"(fq));
        const int count = cnt[u], qbase = c * QCH;
        const int ntile = min(QCH / 16, (count - qbase + 15) >> 4);
        const unsigned* lp = list + (size_t)bh * LIST_PER_BH + list_base(n);
        const bf16_t* qb0 = proj + (size_t)(b * SEQ) * DIN + h * 128 + 8 * fq;
        int tile = wave;
        unsigned ent_c = 0u, ent_n = 0u;
        if (tile < ntile) ent_c = lp[min(qbase + tile * 16 + fr, count - 1)];
        if (tile + 8 < ntile) ent_n = lp[min(qbase + (tile + 8) * 16 + fr, count - 1)];
        __syncthreads();
        const bf16_t* Kg = proj + (size_t)(b * SEQ + n * 256) * DIN + C_K + h * 128;
        stage_kv(Kl, Vl, Kg, Kg + (C_V - C_K), DIN, tid, kmx);
        bf16x8 qc[4];
        { const bf16_t* qp = qb0 + (size_t)(ent_c & 0x3fffu) * DIN;
#pragma unroll
          for (int k = 0; k < 4; ++k) qc[k] = *(const bf16x8*)(qp + 32 * k); }
        float qn_c = qnorm(qc);
        __syncthreads();
        const float kmax = kmax_of(kmx);
        for (; tile < ntile; tile += 8) {
            bf16x8 qn[4]; unsigned ent_nn = 0u;
#pragma unroll
            for (int k = 0; k < 4; ++k) qn[k] = qc[k];
            if (tile + 8 < ntile) {
                const bf16_t* qp = qb0 + (size_t)(ent_n & 0x3fffu) * DIN;
#pragma unroll
                for (int k = 0; k < 4; ++k) qn[k] = *(const bf16x8*)(qp + 32 * k);
                if (tile + 16 < ntile) ent_nn = lp[min(qbase + (tile + 16) * 16 + fr, count - 1)];
            }
            const bool valid = qbase + tile * 16 + fr < count;
            const int sq = (int)(ent_c & 0x3fffu), slot = (int)(ent_c >> 14);
            const bool do_mask = __any(slot == 3);
            const int qrel = sq - n * 256;
            int smax = 8;
            if (do_mask) { int qm = qrel;
#pragma unroll
                for (int o = 1; o < 64; o <<= 1) qm = max(qm, __shfl_xor(qm, o));
                smax = min(8, (qm >> 5) + 1); }
            smax = __builtin_amdgcn_readfirstlane(smax);
            f32x4 oacc[8]; float mx, l;
            attn_core(Kl, Vl, qc, fr, fq, do_mask, qrel, smax, qn_c * kmax, oacc, mx, l);
            qn_c = qnorm(qn);
            __builtin_amdgcn_sched_barrier(0);
            if (valid) {
                const size_t pidx = ((size_t)bh * SEQ + sq) * 4 + slot;
                bf16_t* op = PO + pidx * 128 + 4 * fq;
#pragma unroll
                for (int dt = 0; dt < 8; ++dt) { u32x2 w; w.x = cvt_pk_bf16(oacc[dt][0], oacc[dt][1]); w.y = cvt_pk_bf16(oacc[dt][2], oacc[dt][3]); *(u32x2*)(op + 16 * dt) = w; }
                if (fq == 0) PML[pidx] = (f32x2){mx, l};
            }
            ent_c = ent_n; ent_n = ent_nn;
#pragma unroll
            for (int k = 0; k < 4; ++k) qc[k] = qn[k];
        }
    }
    const bf16_t* mkv = (const bf16_t*)(ws + WS_MKV);
    for (int item = blockIdx.x; item < BATCH * 4 * (SEQ / MQCH); item += gridDim.x) {
        const int c = item & 31, hm = (item >> 5) & 3, b = item >> 7;
        int tid = tid_, fr = fr_, fq = fq_; asm volatile("" : "+v"(tid), "+v"(fr), "+v"(fq));
        __syncthreads();
        const bf16_t* Kg = mkv + (size_t)(b * MEMLEN) * 1024 + hm * 128;
        stage_kv(Kl, Vl, Kg, Kg + 512, 1024, tid, kmx);
        const bf16_t* qb0 = proj + (size_t)(b * SEQ + c * MQCH + fr) * DIN + C_QME + hm * 128 + 8 * fq;
        bf16x8 qc[4];
#pragma unroll
        for (int k = 0; k < 4; ++k) qc[k] = *(const bf16x8*)(qb0 + (size_t)(wave * 16) * DIN + 32 * k);
        float qn_c = qnorm(qc);
        __syncthreads();
        const float kmax = kmax_of(kmx);
        for (int tile = wave; tile < MQCH / 16; tile += 8) {
            bf16x8 qn[4];
#pragma unroll
            for (int k = 0; k < 4; ++k) qn[k] = qc[k];
            if (tile + 8 < MQCH / 16) {
#pragma unroll
                for (int k = 0; k < 4; ++k) qn[k] = *(const bf16x8*)(qb0 + (size_t)((tile + 8) * 16) * DIN + 32 * k); }
            const int sq = c * MQCH + tile * 16 + fr; const size_t row = (size_t)(b * SEQ + sq);
            f32x4 oacc[8]; float mx, l;
            attn_core(Kl, Vl, qc, fr, fq, false, 0, 8, qn_c * kmax, oacc, mx, l);
            qn_c = qnorm(qn);
            __builtin_amdgcn_sched_barrier(0);
            const float rl = 1.f / l;
            const bf16_t* gp = proj + row * DIN + C_GME + hm * 128 + 4 * fq;
            bf16_t* yp = Y + row * DM + 1536 + hm * 128 + 4 * fq;
            u32x2 gv[8];
#pragma unroll
            for (int dt = 0; dt < 8; ++dt) gv[dt] = *(const u32x2*)(gp + 16 * dt);
            __builtin_amdgcn_sched_barrier(0);
#pragma unroll
            for (int dt = 0; dt < 8; ++dt) { const u32x2 g = gv[dt];
                u32x2 w; w.x = cvt_pk_bf16(oacc[dt][0] * rl * bflo(g.x), oacc[dt][1] * rl * bfhi(g.x)); w.y = cvt_pk_bf16(oacc[dt][2] * rl * bflo(g.y), oacc[dt][3] * rl * bfhi(g.y));
                *(u32x2*)(yp + 16 * dt) = w; }
#pragma unroll
            for (int k = 0; k < 4; ++k) qc[k] = qn[k];
        }
    }
    const bf16_t* wsb = (const bf16_t*)(ws + WS_WSB);
    for (int item = blockIdx.x; item < BATCH * (SEQ / 128); item += gridDim.x) {
        const size_t row0 = (size_t)item * 128;
        int fr = fr_, fq = fq_, lane = lane_; asm volatile("" : "+v"(fr), "+v"(fq), "+v"(lane));
        __syncthreads();
        {
            const f32x4 g0 = *(const f32x4*)(a.gln_g + 8 * lane), g1 = *(const f32x4*)(a.gln_g + 8 * lane + 4), b0 = *(const f32x4*)(a.gln_b + 8 * lane), b1 = *(const f32x4*)(a.gln_b + 8 * lane + 4);
            u32x4 raw[16];
#pragma unroll
            for (int i = 0; i < 16; ++i) raw[i] = *(const u32x4*)(proj + (row0 + wave + 8 * i) * DIN + C_VG + 8 * lane);
#pragma unroll
            for (int i = 0; i < 16; ++i) {
                const int tk = wave + 8 * i;
                float v[8] = {bflo(raw[i].x), bfhi(raw[i].x), bflo(raw[i].y), bfhi(raw[i].y), bflo(raw[i].z), bfhi(raw[i].z), bflo(raw[i].w), bfhi(raw[i].w)};
                float sm = 0.f;
#pragma unroll
                for (int e = 0; e < 8; ++e) sm += v[e];
#pragma unroll
                for (int o = 1; o < 64; o <<= 1) sm += __shfl_xor(sm, o);
                const float mu = sm * (1.f / 512.f); float q = 0.f;
#pragma unroll
                for (int e = 0; e < 8; ++e) { v[e] -= mu; q += v[e] * v[e]; }
#pragma unroll
                for (int o = 1; o < 64; o <<= 1) q += __shfl_xor(q, o);
                const float rstd = 1.f / sqrtf(q * (1.f / 512.f) + LN_EPS);
#pragma unroll
                for (int e = 0; e < 8; ++e) { const float o = v[e] * rstd * (e < 4 ? g0[e] : g1[e - 4]) + (e < 4 ? b0[e] : b1[e - 4]);
                    *(LAS bf16_t*)(lds + (8 * lane + e) * 272 + tk * 2) = (bf16_t)(cvt_pk_bf16(o, 0.f) & 0xffffu); }
            }
        }
        __syncthreads();
        const int g = wave >> 1, th = wave & 1;
        f32x4 acc[8][4];
#pragma unroll
        for (int ct = 0; ct < 8; ++ct)
#pragma unroll
            for (int tt = 0; tt < 4; ++tt) acc[ct][tt] = (f32x4){0.f, 0.f, 0.f, 0.f};
#pragma unroll
        for (int k = 0; k < 4; ++k) {
            bf16x8 wf[4];
#pragma unroll
            for (int tt = 0; tt < 4; ++tt) wf[tt] = *(const bf16x8*)(wsb + (size_t)(g * 128 + 64 * th + 16 * tt + fr) * 128 + 32 * k + 8 * fq);
#pragma unroll
            for (int ct = 0; ct < 8; ++ct) { const bf16x8 av = *(const LAS bf16x8*)(lds + (128 * g + 16 * ct + fr) * 272 + (32 * k + 8 * fq) * 2);
#pragma unroll
                for (int tt = 0; tt < 4; ++tt) acc[ct][tt] = __builtin_amdgcn_mfma_f32_16x16x32_bf16(av, wf[tt], acc[ct][tt], 0, 0, 0); }
        }
#pragma unroll
        for (int tt = 0; tt < 4; ++tt) { const int t = 64 * th + 16 * tt + fr; const float bs = a.b_s[g * 128 + t]; const size_t row = row0 + t;
            u32x2 uuv[8], ggv[8];
#pragma unroll
            for (int ct = 0; ct < 8; ++ct) { const int ch = 128 * g + 16 * ct + 4 * fq; uuv[ct] = *(const u32x2*)(proj + row * DIN + C_U + ch); ggv[ct] = *(const u32x2*)(proj + row * DIN + C_GG + ch); }
            __builtin_amdgcn_sched_barrier(0);
#pragma unroll
            for (int ct = 0; ct < 8; ++ct) { const int ch = 128 * g + 16 * ct + 4 * fq;
                const u32x2 uu = uuv[ct], gg = ggv[ct];
                const f32x4 m = acc[ct][tt] + bs;
                u32x2 w; w.x = cvt_pk_bf16(bflo(uu.x) * m[0] * bflo(gg.x), bfhi(uu.x) * m[1] * bfhi(gg.x)); w.y = cvt_pk_bf16(bflo(uu.y) * m[2] * bflo(gg.y), bfhi(uu.y) * m[3] * bfhi(gg.y));
                *(u32x2*)(Y + row * DM + 1024 + ch) = w; } }
    }
}

__device__ __forceinline__ void phase4(const Args& a) {
    unsigned char* ws = a.ws;
    const int tid = threadIdx.x, lane = tid & 63, wave = tid >> 6;
    const bf16_t* proj = (const bf16_t*)(ws + WS_PROJ);
    const bf16_t* PO = (const bf16_t*)(ws + WS_PO); const f32x2* PML = (const f32x2*)(ws + WS_PML);
    bf16_t* Y = (bf16_t*)(ws + WS_Y);
    const int rl_ = lane >> 3, d0 = (lane & 7) * 16;
    const int nw = gridDim.x * 8;
    for (int t0 = blockIdx.x * 8 + wave; t0 < 16 * (SEQ / 8); t0 += 2 * nw) {
        f32x2 ml[2][4]; u32x4 pp[2][4][2]; u32x4 gg[2][2];
#pragma unroll
        for (int r = 0; r < 2; ++r) {
            const int t = (t0 + r * nw < 16 * (SEQ / 8)) ? t0 + r * nw : t0;
            const int bh = t / (SEQ / 8), s = (t % (SEQ / 8)) * 8 + rl_, b = bh >> 3, h = bh & 7, qb = s >> 8, nv = qb < 3 ? qb : 3;
            const size_t pbase = ((size_t)bh * SEQ + s) * 4; const size_t row = (size_t)b * SEQ + s;
#pragma unroll
            for (int j = 0; j < 4; ++j) { const bool ok = (j == 3) || (j < nv);
                ml[r][j] = ok ? PML[pbase + j] : (f32x2){-INFINITY, 0.f};
                if (ok) { pp[r][j][0] = *(const u32x4*)(PO + (pbase + j) * 128 + d0); pp[r][j][1] = *(const u32x4*)(PO + (pbase + j) * 128 + d0 + 8); }
                else { pp[r][j][0] = (u32x4){0u, 0u, 0u, 0u}; pp[r][j][1] = pp[r][j][0]; } }
            gg[r][0] = *(const u32x4*)(proj + row * DIN + C_GMO + h * 128 + d0); gg[r][1] = *(const u32x4*)(proj + row * DIN + C_GMO + h * 128 + d0 + 8);
        }
        __builtin_amdgcn_sched_barrier(0);
#pragma unroll
        for (int r = 0; r < 2; ++r) {
            const int t = t0 + r * nw;
            if (t < 16 * (SEQ / 8)) {
                const int bh = t / (SEQ / 8), s = (t % (SEQ / 8)) * 8 + rl_, b = bh >> 3, h = bh & 7; const size_t row = (size_t)b * SEQ + s;
                float M = -INFINITY;
#pragma unroll
                for (int j = 0; j < 4; ++j) M = fmaxf(M, ml[r][j].x);
                float o[16]; float L = 0.f;
#pragma unroll
                for (int e = 0; e < 16; ++e) o[e] = 0.f;
#pragma unroll
                for (int j = 0; j < 4; ++j) { const float w = fast_exp2(ml[r][j].x - M); L += w * ml[r][j].y;
                    const u32x4 p0 = pp[r][j][0], p1 = pp[r][j][1];
                    o[0] += w * bflo(p0.x); o[1] += w * bfhi(p0.x); o[2] += w * bflo(p0.y); o[3] += w * bfhi(p0.y); o[4] += w * bflo(p0.z); o[5] += w * bfhi(p0.z); o[6] += w * bflo(p0.w); o[7] += w * bfhi(p0.w);
                    o[8] += w * bflo(p1.x); o[9] += w * bfhi(p1.x); o[10] += w * bflo(p1.y); o[11] += w * bfhi(p1.y); o[12] += w * bflo(p1.z); o[13] += w * bfhi(p1.z); o[14] += w * bflo(p1.w); o[15] += w * bfhi(p1.w); }
                const float rl = 1.f / L;
                const u32x4 g0 = gg[r][0], g1 = gg[r][1];
                u32x4 w0, w1;
                w0.x = cvt_pk_bf16(o[0] * rl * bflo(g0.x), o[1] * rl * bfhi(g0.x)); w0.y = cvt_pk_bf16(o[2] * rl * bflo(g0.y), o[3] * rl * bfhi(g0.y));
                w0.z = cvt_pk_bf16(o[4] * rl * bflo(g0.z), o[5] * rl * bfhi(g0.z)); w0.w = cvt_pk_bf16(o[6] * rl * bflo(g0.w), o[7] * rl * bfhi(g0.w));
                w1.x = cvt_pk_bf16(o[8] * rl * bflo(g1.x), o[9] * rl * bfhi(g1.x)); w1.y = cvt_pk_bf16(o[10] * rl * bflo(g1.y), o[11] * rl * bfhi(g1.y));
                w1.z = cvt_pk_bf16(o[12] * rl * bflo(g1.z), o[13] * rl * bfhi(g1.z)); w1.w = cvt_pk_bf16(o[14] * rl * bflo(g1.w), o[15] * rl * bfhi(g1.w));
                *(u32x4*)(Y + row * DM + h * 128 + d0) = w0; *(u32x4*)(Y + row * DM + h * 128 + d0 + 8) = w1;
            }
        }
        __builtin_amdgcn_sched_barrier(0);
    }
}

__device__ __forceinline__ void phase6(const Args& a) {
    const int tid = threadIdx.x, lane = tid & 63, wave = tid >> 6;
    const bf16_t* sub = (const bf16_t*)(a.ws + WS_SUB);
    for (int row = blockIdx.x * 8 + wave; row < MROWS; row += gridDim.x * 8) {
        const f32x4* xp = (const f32x4*)(a.x + (size_t)row * DM) + lane;
        const u32x2* sp = (const u32x2*)(sub + (size_t)row * DM) + lane;
        f32x4* rp = (f32x4*)(a.out + (size_t)row * DM) + lane;
        f32x4 v[8]; u32x2 sv[8]; float s = 0.f;
#pragma unroll
        for (int j = 0; j < 8; ++j) { v[j] = __builtin_nontemporal_load(xp + 64 * j); sv[j] = sp[64 * j]; }
#pragma unroll
        for (int j = 0; j < 8; ++j) { v[j] = v[j] * ALPHA + (f32x4){bflo(sv[j].x), bfhi(sv[j].x), bflo(sv[j].y), bfhi(sv[j].y)}; s += (v[j][0] + v[j][1]) + (v[j][2] + v[j][3]); }
#pragma unroll
        for (int o = 1; o < 64; o <<= 1) s += __shfl_xor(s, o);
        const float mu = s * (1.f / DM); float q = 0.f;
#pragma unroll
        for (int j = 0; j < 8; ++j) { v[j] = v[j] - mu; q += (v[j][0] * v[j][0] + v[j][1] * v[j][1]) + (v[j][2] * v[j][2] + v[j][3] * v[j][3]); }
#pragma unroll
        for (int o = 1; o < 64; o <<= 1) q += __shfl_xor(q, o);
        const float rstd = 1.f / sqrtf(q * (1.f / DM) + LN_EPS);
#pragma unroll
        for (int j = 0; j < 8; ++j) { const f32x4 g = ((const f32x4*)a.ln_g)[lane + 64 * j], bb = ((const f32x4*)a.ln_b)[lane + 64 * j]; __builtin_nontemporal_store(v[j] * rstd * g + bb, rp + 64 * j); }
    }
}

#define XB_TMO      128
#define XB_XCNT(j)  (256  + 64 * (j))
#define XB_XSUB(j)  (1280 + 64 * (j))
#define XB_XGEN(j)  (2304 + 64 * (j))
#define XB_TOP      3328
#define XB_TOPGEN   3392
#define XCD_BAR_WORDS 3456
#define XB_SPIN_CAP (1u << 18)
__device__ __forceinline__ unsigned xb_ld(unsigned* p)              { return __hip_atomic_load(p, __ATOMIC_RELAXED, __HIP_MEMORY_SCOPE_AGENT); }
__device__ __forceinline__ unsigned xb_add(unsigned* p, unsigned v) { return __hip_atomic_fetch_add(p, v, __ATOMIC_RELAXED, __HIP_MEMORY_SCOPE_AGENT); }
__device__ __forceinline__ unsigned xb_xcc_id() { return (unsigned)__builtin_amdgcn_s_getreg((3 << 11) | 20) & 0xFu; }
#define XB_SPIN(cond, bar) do { unsigned _sp = 0; while (cond) { __builtin_amdgcn_s_sleep(1); \
    if ((++_sp & 255u) == 0u) { if (xb_ld(&(bar)[XB_TMO])) break; if (_sp > XB_SPIN_CAP) { atomicAdd(&(bar)[XB_TMO], 1u); break; } } } } while (0)
struct XcdBarrier { unsigned* bar; unsigned x; volatile LAS unsigned* st; };
__device__ __forceinline__ XcdBarrier xcd_barrier_post(unsigned* bar, volatile LAS unsigned* st) {
    XcdBarrier b; b.bar = bar; b.x = xb_xcc_id(); b.st = st;
    if (threadIdx.x == 0) (void)xb_add(&bar[XB_XCNT(b.x)], 1u);
    return b;
}
__device__ __forceinline__ void xcd_barrier_complete(unsigned* bar, unsigned x, unsigned& nloc, unsigned& nx) {
    const unsigned G = gridDim.x * gridDim.y * gridDim.z;
    unsigned sum, cnt, mine, sp = 0u;
    for (;;) {
        sum = 0u; cnt = 0u; mine = 0u;
#pragma unroll
        for (unsigned j = 0; j < 16; ++j) { const unsigned c = xb_ld(&bar[XB_XCNT(j)]); sum += c; cnt += (c > 0u) ? 1u : 0u; mine = (j == x) ? c : mine; }
        if (sum == G) break;
        __builtin_amdgcn_s_sleep(1);
        if ((++sp & 255u) == 0u) { if (xb_ld(&bar[XB_TMO])) break; if (sp > XB_SPIN_CAP) { atomicAdd(&bar[XB_TMO], 1u); break; } }
    }
    nloc = mine > 0u ? mine : 1u; nx = cnt > 0u ? cnt : 1u;
}
__device__ __forceinline__ void xcd_barrier(const XcdBarrier& b) {
    asm volatile("s_waitcnt vmcnt(0)" ::: "memory");
    __syncthreads();
    if (threadIdx.x == 0) {
        unsigned* bar = b.bar;
        __builtin_amdgcn_s_waitcnt(0);
        unsigned nloc = b.st[0], nx = b.st[1];
        if (nloc == 0u) { xcd_barrier_complete(bar, b.x, nloc, nx); b.st[0] = nloc; b.st[1] = nx; }
        const unsigned old = xb_add(&bar[XB_XSUB(b.x)], 1u);
        const unsigned gen = old / nloc;
        if (old + 1u == (gen + 1u) * nloc) {
            __builtin_amdgcn_fence(__ATOMIC_RELEASE, "agent");
            asm volatile("s_waitcnt vmcnt(0)" ::: "memory");
            const unsigned og = xb_add(&bar[XB_TOP], 1u);
            const unsigned tg = og / nx;
            if (og + 1u == (tg + 1u) * nx) xb_add(&bar[XB_TOPGEN], 1u);
            else XB_SPIN(xb_ld(&bar[XB_TOPGEN]) == tg, bar);
            __builtin_amdgcn_fence(__ATOMIC_ACQUIRE, "agent");
            xb_add(&bar[XB_XGEN(b.x)], 1u);
            asm volatile("s_waitcnt vmcnt(0)" ::: "memory");
        } else {
            XB_SPIN(xb_ld(&bar[XB_XGEN(b.x)]) == gen, bar);
            __builtin_amdgcn_fence(__ATOMIC_ACQUIRE, "agent");
            asm volatile("s_waitcnt vmcnt(0)" ::: "memory");
        }
    }
    __syncthreads();
}

__global__ void __launch_bounds__(512, 2) hymba_fwd(Args a) {
    extern __shared__ __attribute__((aligned(16))) unsigned char lds_raw[];
    LAS unsigned char* lds = (LAS unsigned char*)lds_raw;
    unsigned char* ws = a.ws;
    const int lo = a.ph_lo, hi = a.ph_hi, G = gridDim.x;
#define IN(k) (lo <= (k) && (k) < hi)
#define SEAM(k) do { if (IN(k) && IN((k) + 1)) xcd_barrier(xbar); } while (0)
    volatile LAS unsigned* xst = (volatile LAS unsigned*)(lds + LDS_BYTES - 64);
    if (threadIdx.x < 2) xst[threadIdx.x] = 0u;
    __syncthreads();
    XcdBarrier xbar; xbar.bar = (unsigned*)(ws + WS_BAR); xbar.x = 0; xbar.st = xst;
    if (IN(0) && IN(1)) xbar = xcd_barrier_post((unsigned*)(ws + WS_BAR), xst);
    if (IN(0)) phase0(a, lds);
    SEAM(0);
    if (IN(1)) {
        { pg8::Gemm g{(const bf16_t*)(ws + WS_XB), (const bf16_t*)(ws + WS_WIN), MROWS, DIN, DM}; pg8::StaticOrder S; S.init(g.M, g.N, G, (int)blockIdx.x);
          EpiProj E{(bf16_t*)(ws + WS_PROJ), (const float*)(ws + WS_COS), (const float*)(ws + WS_SIN), (float*)(ws + WS_KSUM)};
          pg8::gemm_phase<EpiProj, pg8::StaticOrder, true, true>(lds, g, S, E); }
    }
    SEAM(1);
    if (IN(2)) phase2(a, lds);
    SEAM(2);
    if (IN(3)) phase3(a, lds);
    SEAM(3);
    if (IN(4)) phase4(a);
    SEAM(4);
    if (IN(5)) {
        pg8::Gemm g{(const bf16_t*)(ws + WS_Y), (const bf16_t*)(ws + WS_WOUT), MROWS, DM, DM}; pg8::StaticOrder S; S.init(g.M, g.N, G, (int)blockIdx.x);
        EpiPlain E{(bf16_t*)(ws + WS_SUB), DM};
        pg8::gemm_phase<EpiPlain, pg8::StaticOrder, true, true>(lds, g, S, E);
    }
    SEAM(5);
    if (IN(6)) phase6(a);
#undef IN
#undef SEAM
}

extern "C" void kernel_launch(void* const* d_in, const int* in_sizes, int n_in, void* d_out, int out_size, void* d_ws, size_t ws_size, hipStream_t stream) {
    static int grid = 0;
    if (grid == 0) {
        if (n_in != 12 || ws_size < WS_END) { fprintf(stderr, "kernel_launch: unexpected inputs (n_in %d, ws %zu)\n", n_in, ws_size); grid = -1; return; }
        int dev = 0, cus = 0, per_cu = 0;
        hipGetDevice(&dev); hipDeviceGetAttribute(&cus, hipDeviceAttributeMultiprocessorCount, dev);
        hipFuncSetAttribute((const void*)hymba_fwd, hipFuncAttributeMaxDynamicSharedMemorySize, LDS_BYTES);
        hipOccupancyMaxActiveBlocksPerMultiprocessor(&per_cu, (const void*)hymba_fwd, 512, LDS_BYTES);
        if (per_cu < 1) { fprintf(stderr, "kernel_launch: occupancy query reports %d blocks per CU\n", per_cu); per_cu = 1; }
        grid = cus * per_cu;
        (void)hipGetLastError();
    }
    if (grid < 0) return;
    Args a{};
    a.x = (const float*)d_in[0]; a.mem = (const float*)d_in[1]; a.pos = (const int*)d_in[2]; a.w_in = (const float*)d_in[3]; a.w_mkv = (const float*)d_in[4];
    a.gln_g = (const float*)d_in[5]; a.gln_b = (const float*)d_in[6]; a.w_s = (const float*)d_in[7]; a.b_s = (const float*)d_in[8]; a.w_out = (const float*)d_in[9];
    a.ln_g = (const float*)d_in[10]; a.ln_b = (const float*)d_in[11]; a.out = (float*)d_out; a.ws = (unsigned char*)d_ws;
#if MK_MULTI
    for (int p = 0; p < 7; ++p) { a.ph_lo = p; a.ph_hi = p + 1; hipLaunchKernelGGL(hymba_fwd, dim3(grid), dim3(512), LDS_BYTES, stream, a); }
#else
    a.ph_lo = 0; a.ph_hi = 7;
    (void)hipMemsetAsync((char*)d_ws + WS_BAR, 0, BAR_WORDS_N * 4, stream);
    void* args[] = {&a};
    hipError_t e = hipLaunchCooperativeKernel((const void*)hymba_fwd, dim3(grid), dim3(512), args, LDS_BYTES, stream);
    if (e != hipSuccess) fprintf(stderr, "cooperative launch failed: %s (grid %d)\n", hipGetErrorString(e), grid);
#endif
}
```

```cpp
#include <hip/hip_runtime.h>
#include <hip/hip_cooperative_groups.h>
#include <cstdio>
#include <cstdint>
namespace cg = cooperative_groups;

#ifndef MK_MULTI
#define MK_MULTI 0
#endif

#define LAS __attribute__((address_space(3)))
typedef unsigned short bf16_t;
typedef short bf16x8 __attribute__((ext_vector_type(8)));
typedef float f32x4 __attribute__((ext_vector_type(4)));
typedef float f32x2 __attribute__((ext_vector_type(2)));
typedef unsigned u32x4 __attribute__((ext_vector_type(4)));
typedef unsigned u32x2 __attribute__((ext_vector_type(2)));

constexpr int BATCH = 2, SEQ = 16384, DM = 2048, DIN = 6656, MROWS = BATCH * SEQ, NBLK = 64, MEMLEN = 256;
constexpr int C_K = 1024, C_V = 2048, C_GMO = 3072, C_U = 4096, C_VG = 4608, C_GG = 5120, C_QME = 5632, C_GME = 6144;
constexpr float QSCALE = 0.08838834764831845f * 1.4426950408889634f;
constexpr float ALPHA = 1.189207115002721f;
constexpr float LN_EPS = 1e-5f;
constexpr int LIST_PER_BH = 256 * 2080;
constexpr int QCH = 1024;
constexpr int MQCH = 512;

constexpr size_t MiB = 1u << 20;
constexpr size_t WS_CNT = 0;
constexpr size_t WS_BAR = 8192;
constexpr size_t WS_KSUM = 64 * 1024;
constexpr size_t WS_WIN = 1 * MiB;
constexpr size_t WS_WOUT = 28 * MiB;
constexpr size_t WS_WMKV = 36 * MiB;
constexpr size_t WS_WSB = 40 * MiB;
constexpr size_t WS_MEMB = 41 * MiB;
constexpr size_t WS_MKV = 43 * MiB;
constexpr size_t WS_COS = 44 * MiB;
constexpr size_t WS_SIN = 52 * MiB;
constexpr size_t WS_LIST = 60 * MiB;
constexpr size_t WS_PML = 96 * MiB;
constexpr size_t WS_Y = 104 * MiB;
constexpr size_t WS_PROJ = 232 * MiB;
constexpr size_t WS_PO = 648 * MiB;
constexpr size_t WS_SUB = 648 * MiB;
constexpr size_t WS_XB = 648 * MiB;
constexpr size_t WS_END = 904 * MiB;
constexpr int LDS_BYTES = 152 * 1024;
constexpr int BAR_WORDS_N = 3456;

namespace pg8 {
constexpr int BM = 256, BK = 64, HALF = 128, HTB = HALF * BK * 2, STAGE_BYTES = 8 * HTB, NXCD = 8, WGM = 8;
__host__ __device__ __forceinline__ int lds_byte(int r, int c) { const int st = (r >> 4) * 2 + (c >> 5), rr = r & 15, cc = c & 31, ob = rr * 64 + cc * 2; return st * 1024 + (ob ^ (((ob >> 9) & 1) << 5)); }
__host__ __device__ __forceinline__ void stage_rc(int b, int& R, int& C) { const int st = b / 1024, sb = b % 1024, swz = sb ^ (((sb >> 9) & 1) << 5); R = (st >> 1) * 16 + swz / 64; C = (st & 1) * 32 + (swz % 64) / 2; }
__host__ __device__ __forceinline__ int perm32(int rho) { const int n = rho >> 4, i = rho & 15; return 8 * (i >> 2) + 4 * n + (i & 3); }
struct Unit { int pm, pn; };
struct Gemm { const bf16_t* A; const bf16_t* Bt; int M, N, K; };
struct StaticOrder {
    int nM, nN, nwg, G, c;
    __host__ __device__ void init(int M, int N, int G_, int c_) { nM = M / BM; nN = N / BM; nwg = nM * nN; G = G_; c = c_; }
    __host__ __device__ bool next(int i, Unit& u) const {
        const long L = (long)i * G + c; if (L >= nwg) return false;
        int wgid = (int)L; { const int q = nwg / NXCD, r = nwg % NXCD, xcd = wgid % NXCD, off = wgid / NXCD; wgid = (xcd < r ? xcd * (q + 1) : r * (q + 1) + (xcd - r) * q) + off; }
        const int nig = WGM * nN, gid = wgid / nig, fm = gid * WGM, gsz = (nM - fm) < WGM ? (nM - fm) : WGM;
        u.pm = fm + ((wgid % nig) % gsz); u.pn = (wgid % nig) / gsz; return true;
    }
    __device__ __forceinline__ void a_ready(const Unit&) const {}
    __device__ __forceinline__ void done(const Unit&) const {}
};
__device__ __forceinline__ unsigned cvt_pk_bf16(float lo, float hi) { unsigned r; asm volatile("v_cvt_pk_bf16_f32 %0, %1, %2" : "=v"(r) : "v"(lo), "v"(hi)); return r; }

template <class Epi, class Sched, bool ALIGN_EPI = false, bool SP2 = false>
__device__ __forceinline__ void gemm_phase(LAS unsigned char* lds, const Gemm g, const Sched& S, const Epi& E) {
    const int tid = threadIdx.x, wid = __builtin_amdgcn_readfirstlane(tid >> 6), lane = tid & 63, wr = wid >> 2, wc = wid & 3, fr = lane & 15, fq = lane >> 4;
    const int K = g.K, nt = K / BK;
    unsigned voffA[2], voffB[2];
#pragma unroll
    for (int i = 0; i < 2; ++i) { int R, C; stage_rc(tid * 16 + i * 8192, R, C); const int Rb = Epi::PERM ? ((R & ~31) + perm32(R & 31)) : R;
        voffA[i] = (unsigned)(R * K + C) * 2u; voffB[i] = (unsigned)(Rb * K + C) * 2u; }
    const size_t kstep = (size_t)(BK * 2);
    const size_t hstep = (size_t)HALF * K * 2;
    const size_t tstep = 2 * hstep;
    const unsigned ldsw = (unsigned)wid * 1024u;
    const int aoff = lds_byte(wr * 64 + fr, fq * 8), boff = lds_byte(wc * 32 + fr, fq * 8);
#define PG8_SA(b, h) (((b) * 2 + (h)) * HTB)
#define PG8_SB(b, h) ((4 + (b) * 2 + (h)) * HTB)
#define PG8_STAGE(bufoff, gbase, voff) do { _Pragma("unroll") for (int _i = 0; _i < 2; ++_i) \
        __builtin_amdgcn_global_load_lds((const unsigned*)((const char*)(gbase) + (voff)[_i]), (LAS unsigned*)(lds + (bufoff) + ldsw + _i * 8192), 16, 0, 0); } while (0)
#define PG8_LDA(dst, b, h) do { _Pragma("unroll") for (int m = 0; m < 4; ++m) _Pragma("unroll") for (int k = 0; k < 2; ++k) dst[m][k] = *(const LAS bf16x8*)(lds + PG8_SA(b, h) + aoff + m * 2048 + k * 1024); } while (0)
#define PG8_LDB(dst, b, h) do { _Pragma("unroll") for (int n = 0; n < 2; ++n) _Pragma("unroll") for (int k = 0; k < 2; ++k) dst[n][k] = *(const LAS bf16x8*)(lds + PG8_SB(b, h) + boff + n * 2048 + k * 1024); } while (0)
#define PG8_MMA(ai, bj, At, Bt) do { __builtin_amdgcn_s_setprio(1); _Pragma("unroll") for (int m = 0; m < 4; ++m) _Pragma("unroll") for (int n = 0; n < 2; ++n) _Pragma("unroll") for (int k = 0; k < 2; ++k) \
        acc[ai][bj][m][n] = __builtin_amdgcn_mfma_f32_16x16x32_bf16(Bt[n][k], At[m][k], acc[ai][bj][m][n], 0, 0, 0); __builtin_amdgcn_s_setprio(0); } while (0)
#define PG8_WAIT_V(n) asm volatile("s_waitcnt vmcnt(" #n ")" ::: "memory")
#define PG8_WAIT_L(n) asm volatile("s_waitcnt lgkmcnt(" #n ")" ::: "memory")
#define PG8_BAR __builtin_amdgcn_s_barrier()
#define PG8_SCHED __builtin_amdgcn_sched_barrier(0)
    Unit cur, nxt; int ui = 0;
    if (!S.next(0, cur)) return;
    f32x4 acc[2][2][4][2];
#pragma unroll
    for (int a = 0; a < 2; ++a)
#pragma unroll
        for (int b = 0; b < 2; ++b)
#pragma unroll
            for (int m = 0; m < 4; ++m)
#pragma unroll
                for (int n = 0; n < 2; ++n) acc[a][b][m][n] = (f32x4){0.f, 0.f, 0.f, 0.f};
    bf16x8 At[4][2], B0[2][2], B1[2][2];
    const char* cA = (const char*)g.A + (size_t)cur.pm * tstep; const char* cB = (const char*)g.Bt + (size_t)cur.pn * tstep;
    S.a_ready(cur);
    if constexpr (SP2) {
        PG8_STAGE(PG8_SB(0, 0), cB, voffB); PG8_STAGE(PG8_SB(0, 1), cB + hstep, voffB); PG8_STAGE(PG8_SA(0, 0), cA, voffA); PG8_STAGE(PG8_SA(0, 1), cA + hstep, voffA);
        if (wr == 1) PG8_BAR;
        PG8_WAIT_V(2); PG8_BAR;
        PG8_STAGE(PG8_SB(1, 0), cB + kstep, voffB); PG8_STAGE(PG8_SA(1, 0), cA + kstep, voffA); PG8_STAGE(PG8_SB(1, 1), cB + hstep + kstep, voffB);
        PG8_WAIT_V(6); PG8_BAR;
    } else {
        PG8_STAGE(PG8_SB(0, 0), cB, voffB); PG8_STAGE(PG8_SA(0, 0), cA, voffA); PG8_STAGE(PG8_SB(0, 1), cB + hstep, voffB); PG8_STAGE(PG8_SA(0, 1), cA + hstep, voffA);
        if (wr == 1) PG8_BAR;
        PG8_WAIT_V(4); PG8_BAR;
        PG8_STAGE(PG8_SB(1, 0), cB + kstep, voffB); PG8_STAGE(PG8_SA(1, 0), cA + kstep, voffA); PG8_STAGE(PG8_SB(1, 1), cB + hstep + kstep, voffB);
        PG8_WAIT_V(6); PG8_BAR;
    }
    for (;;) {
        const bool has_next = S.next(ui + 1, nxt);
        const char* nA = has_next ? (const char*)g.A + (size_t)nxt.pm * tstep : cA; const char* nB = has_next ? (const char*)g.Bt + (size_t)nxt.pn * tstep : cB;
        for (int t = 0; t < nt; t += 2) {
            const bool last = (t == nt - 2);
            const char* a1 = cA + (size_t)(t + 1) * kstep;
            const char* a2 = last ? nA : cA + (size_t)(t + 2) * kstep; const char* b2 = last ? nB : cB + (size_t)(t + 2) * kstep;
            const char* a3 = a2 + kstep; const char* b3 = b2 + kstep;
            if (last && has_next) S.a_ready(nxt);
            if constexpr (SP2) {
            PG8_LDB(B0, 0, 0); PG8_LDB(B1, 0, 1); PG8_SCHED; PG8_LDA(At, 0, 0); PG8_STAGE(PG8_SA(1, 1), a1 + hstep, voffA);
            PG8_WAIT_V(8); PG8_WAIT_L(0); PG8_BAR; PG8_MMA(0, 0, At, B0); PG8_MMA(0, 1, At, B1); PG8_BAR; PG8_SCHED;
            PG8_LDA(At, 0, 1); PG8_STAGE(PG8_SB(0, 0), b2, voffB); PG8_STAGE(PG8_SB(0, 1), b2 + hstep, voffB); PG8_STAGE(PG8_SA(0, 0), a2, voffA);
            PG8_WAIT_V(8); PG8_WAIT_L(0); PG8_BAR; PG8_MMA(1, 0, At, B0); PG8_MMA(1, 1, At, B1); PG8_BAR; PG8_SCHED;
            PG8_LDB(B0, 1, 0); PG8_LDB(B1, 1, 1); PG8_SCHED; PG8_LDA(At, 1, 0); PG8_STAGE(PG8_SA(0, 1), a2 + hstep, voffA);
            PG8_WAIT_V(8); PG8_WAIT_L(0); PG8_BAR; PG8_MMA(0, 0, At, B0); PG8_MMA(0, 1, At, B1); PG8_BAR; PG8_SCHED;
            PG8_LDA(At, 1, 1); PG8_STAGE(PG8_SB(1, 0), b3, voffB); PG8_STAGE(PG8_SB(1, 1), b3 + hstep, voffB); PG8_STAGE(PG8_SA(1, 0), a3, voffA);
            PG8_WAIT_V(8); PG8_WAIT_L(0); PG8_BAR; PG8_MMA(1, 0, At, B0); PG8_MMA(1, 1, At, B1); PG8_BAR; PG8_SCHED;
            } else {
            PG8_LDB(B0, 0, 0); PG8_SCHED; PG8_LDA(At, 0, 0); PG8_STAGE(PG8_SA(1, 1), a1 + hstep, voffA);
            PG8_WAIT_L(8); PG8_BAR; PG8_WAIT_L(0); PG8_MMA(0, 0, At, B0); PG8_BAR; PG8_SCHED;
            PG8_LDB(B1, 0, 1); PG8_STAGE(PG8_SB(0, 0), b2, voffB);
            PG8_BAR; PG8_WAIT_L(0); PG8_MMA(0, 1, At, B1); PG8_BAR;
            PG8_LDA(At, 0, 1); PG8_STAGE(PG8_SA(0, 0), a2, voffA);
            PG8_BAR; PG8_WAIT_L(0); PG8_MMA(1, 0, At, B0); PG8_BAR; PG8_SCHED;
            PG8_STAGE(PG8_SB(0, 1), b2 + hstep, voffB);
            PG8_WAIT_V(6); PG8_BAR; PG8_MMA(1, 1, At, B1); PG8_BAR;
            PG8_LDB(B0, 1, 0); PG8_SCHED; PG8_LDA(At, 1, 0); PG8_STAGE(PG8_SA(0, 1), a2 + hstep, voffA);
            PG8_WAIT_L(8); PG8_BAR; PG8_WAIT_L(0); PG8_MMA(0, 0, At, B0); PG8_BAR; PG8_SCHED;
            PG8_LDB(B1, 1, 1); PG8_STAGE(PG8_SB(1, 0), b3, voffB);
            PG8_BAR; PG8_WAIT_L(0); PG8_MMA(0, 1, At, B1); PG8_BAR;
            PG8_LDA(At, 1, 1); PG8_STAGE(PG8_SA(1, 0), a3, voffA);
            PG8_BAR; PG8_WAIT_L(0); PG8_MMA(1, 0, At, B0); PG8_BAR; PG8_SCHED;
            PG8_STAGE(PG8_SB(1, 1), b3 + hstep, voffB);
            PG8_WAIT_V(6); PG8_BAR; PG8_MMA(1, 1, At, B1); PG8_BAR;
            }
        }
        if constexpr (ALIGN_EPI) { if (wr == 0) PG8_BAR; }
        E(acc, cur, wr, wc, fr, fq); S.done(cur);
        if (!has_next) break;
#pragma unroll
        for (int a = 0; a < 2; ++a)
#pragma unroll
            for (int b = 0; b < 2; ++b)
#pragma unroll
                for (int m = 0; m < 4; ++m)
#pragma unroll
                    for (int n = 0; n < 2; ++n) acc[a][b][m][n] = (f32x4){0.f, 0.f, 0.f, 0.f};
        cur = nxt; cA = nA; cB = nB; ++ui;
        if constexpr (ALIGN_EPI) { if (wr == 1) PG8_BAR; }
    }
    PG8_WAIT_V(0);
    if constexpr (!ALIGN_EPI) { if (wr == 0) PG8_BAR; }
    PG8_BAR;
#undef PG8_SA
#undef PG8_SB
#undef PG8_STAGE
#undef PG8_LDA
#undef PG8_LDB
#undef PG8_MMA
#undef PG8_WAIT_V
#undef PG8_WAIT_L
#undef PG8_BAR
#undef PG8_SCHED
}
}

using pg8::cvt_pk_bf16;
__device__ __forceinline__ float bf2f(unsigned short b) { return __builtin_bit_cast(float, (unsigned)b << 16); }
__device__ __forceinline__ float bflo(unsigned w) { return __builtin_bit_cast(float, w << 16); }
__device__ __forceinline__ float bfhi(unsigned w) { return __builtin_bit_cast(float, w & 0xffff0000u); }
__device__ __forceinline__ float fast_exp2(float x) { return __builtin_amdgcn_exp2f(x); }
__device__ __forceinline__ float fast_rcp(float x) { return __builtin_amdgcn_rcpf(x); }
__device__ __forceinline__ float silu_f(float x) { return x * fast_rcp(1.f + fast_exp2(-1.4426950408889634f * x)); }
__device__ __forceinline__ float gelu_tanh_f(float x) {
    const float t = x * (1.f + 0.044715f * x * x) * (-1.5957691216057308f * 1.4426950408889634f);
    return x * fast_rcp(1.f + fast_exp2(t));
}
#define LDS_WAIT() asm volatile("s_waitcnt lgkmcnt(0)" ::: "memory")

struct EpiProj {
    static constexpr bool PERM = true;
    bf16_t* O; const float* cosT; const float* sinT; float* ksum;
    __device__ __forceinline__ void operator()(const f32x4 (&acc)[2][2][4][2], const pg8::Unit& u, int wr, int wc, int fr, int fq) const {
        const int pn = u.pn;
        const int type = pn < 4 ? 0 : pn < 8 ? 1 : pn < 12 ? 2 : pn < 16 ? 3 : pn < 20 ? 4 : pn < 22 ? 3 : pn < 24 ? 5 : 3;
        const int row0 = u.pm * 256 + wr * 64 + fr;
        const int col0 = pn * 256 + wc * 32 + 8 * fq;
        float cs[2][8];
#pragma unroll
        for (int bj = 0; bj < 2; ++bj)
#pragma unroll
            for (int e = 0; e < 8; ++e) cs[bj][e] = 0.f;
#pragma unroll
        for (int ai = 0; ai < 2; ++ai) {
            f32x4 c4v[4], s4v[4];
#pragma unroll
            for (int m = 0; m < 4; ++m) { c4v[m] = (f32x4){1.f, 1.f, 1.f, 1.f}; s4v[m] = (f32x4){0.f, 0.f, 0.f, 0.f}; }
            if (type <= 1) {
#pragma unroll
                for (int m = 0; m < 4; ++m) { const size_t ro = (size_t)(row0 + ai * 128 + m * 16) * 64 + 16 * wc + 4 * fq; c4v[m] = *(const f32x4*)(cosT + ro); s4v[m] = *(const f32x4*)(sinT + ro); }
            }
            __builtin_amdgcn_sched_barrier(0);
#pragma unroll
            for (int m = 0; m < 4; ++m) {
                const int row = row0 + ai * 128 + m * 16;
                const f32x4 c4 = c4v[m], s4 = s4v[m];
                bf16_t* rowp = O + (size_t)row * DIN + col0;
#pragma unroll
                for (int bj = 0; bj < 2; ++bj) {
                    f32x4 v0 = acc[ai][bj][m][0], v1 = acc[ai][bj][m][1];
                    float o[8];
                    if (type <= 1) {
                        o[0] = v0[0] * c4[0] - v0[1] * s4[0]; o[1] = v0[1] * c4[0] + v0[0] * s4[0];
                        o[2] = v0[2] * c4[1] - v0[3] * s4[1]; o[3] = v0[3] * c4[1] + v0[2] * s4[1];
                        o[4] = v1[0] * c4[2] - v1[1] * s4[2]; o[5] = v1[1] * c4[2] + v1[0] * s4[2];
                        o[6] = v1[2] * c4[3] - v1[3] * s4[3]; o[7] = v1[3] * c4[3] + v1[2] * s4[3];
                        if (type == 0) {
#pragma unroll
                            for (int e = 0; e < 8; ++e) o[e] *= QSCALE;
                        } else {
#pragma unroll
                            for (int e = 0; e < 8; ++e) cs[bj][e] += o[e];
                        }
                    } else {
#pragma unroll
                        for (int e = 0; e < 4; ++e) { o[e] = v0[e]; o[4 + e] = v1[e]; }
                        if (type == 3) {
#pragma unroll
                            for (int e = 0; e < 8; ++e) o[e] = silu_f(o[e]);
                        } else if (type == 4) {
#pragma unroll
                            for (int e = 0; e < 8; ++e) o[e] = gelu_tanh_f(o[e]);
                        } else if (type == 5) {
#pragma unroll
                            for (int e = 0; e < 8; ++e) o[e] *= QSCALE;
                        }
                    }
                    u32x4 w; w.x = cvt_pk_bf16(o[0], o[1]); w.y = cvt_pk_bf16(o[2], o[3]); w.z = cvt_pk_bf16(o[4], o[5]); w.w = cvt_pk_bf16(o[6], o[7]);
                    __builtin_nontemporal_store(w, (u32x4*)(rowp + bj * 128));
                }
            }
            __builtin_amdgcn_sched_barrier(0);
        }
        if (type == 1) {
#pragma unroll
            for (int bj = 0; bj < 2; ++bj)
#pragma unroll
                for (int e = 0; e < 8; ++e) {
                    float v = cs[bj][e];
                    v += __shfl_xor(v, 1); v += __shfl_xor(v, 2); v += __shfl_xor(v, 4); v += __shfl_xor(v, 8);
                    cs[bj][e] = v;
                }
            if (fr == 0) {
                float* kp = ksum + (size_t)u.pm * 1024 + (pn - 4) * 256 + wc * 32 + 8 * fq;
#pragma unroll
                for (int bj = 0; bj < 2; ++bj)
#pragma unroll
                    for (int e = 0; e < 8; ++e) atomicAdd(kp + bj * 128 + e, cs[bj][e]);
            }
        }
    }
};
struct EpiPlain {
    static constexpr bool PERM = true;
    bf16_t* O; int ldc;
    __device__ __forceinline__ void operator()(const f32x4 (&acc)[2][2][4][2], const pg8::Unit& u, int wr, int wc, int fr, int fq) const {
        const int row0 = u.pm * 256 + wr * 64 + fr, col0 = u.pn * 256 + wc * 32 + 8 * fq;
#pragma unroll
        for (int ai = 0; ai < 2; ++ai)
#pragma unroll
            for (int m = 0; m < 4; ++m) { bf16_t* rowp = O + (size_t)(row0 + ai * 128 + m * 16) * ldc + col0;
#pragma unroll
                for (int bj = 0; bj < 2; ++bj) { const f32x4 v0 = acc[ai][bj][m][0], v1 = acc[ai][bj][m][1];
                    u32x4 w; w.x = cvt_pk_bf16(v0[0], v0[1]); w.y = cvt_pk_bf16(v0[2], v0[3]); w.z = cvt_pk_bf16(v1[0], v1[1]); w.w = cvt_pk_bf16(v1[2], v1[3]);
                    *(u32x4*)(rowp + bj * 128) = w; } }
    }
};
struct EpiResid {
    static constexpr bool PERM = true;
    const float* __restrict__ x; float* __restrict__ out;
    __device__ __forceinline__ void operator()(const f32x4 (&acc)[2][2][4][2], const pg8::Unit& u, int wr, int wc, int fr, int fq) const {
        const int row0 = u.pm * 256 + wr * 64 + fr, col0 = u.pn * 256 + wc * 32 + 8 * fq;
#pragma unroll
        for (int ai = 0; ai < 2; ++ai) {
            f32x4 xv[4][2][2];
#pragma unroll
            for (int m = 0; m < 4; ++m) { const size_t off = (size_t)(row0 + ai * 128 + m * 16) * DM + col0;
#pragma unroll
                for (int bj = 0; bj < 2; ++bj)
#pragma unroll
                    for (int n = 0; n < 2; ++n) xv[m][bj][n] = *(const f32x4*)(x + off + bj * 128 + 4 * n); }
            __builtin_amdgcn_sched_barrier(0);
#pragma unroll
            for (int m = 0; m < 4; ++m) { const size_t off = (size_t)(row0 + ai * 128 + m * 16) * DM + col0;
#pragma unroll
                for (int bj = 0; bj < 2; ++bj)
#pragma unroll
                    for (int n = 0; n < 2; ++n) *(f32x4*)(out + off + bj * 128 + 4 * n) = xv[m][bj][n] * ALPHA + acc[ai][bj][m][n]; }
            __builtin_amdgcn_sched_barrier(0);
        }
    }
};

struct Args { const float* x; const float* mem; const int* pos; const float* w_in; const float* w_mkv; const float* gln_g; const float* gln_b;
              const float* w_s; const float* b_s; const float* w_out; const float* ln_g; const float* ln_b; float* out; unsigned char* ws; int ph_lo, ph_hi; };

__device__ __forceinline__ void p0_transpose_item(const float* W, int K, int N, bf16_t* WT, bool permute_qk, LAS float* scr, int item, int lane) {
    const int nblk = N / 32, kb = item / nblk, nb = item % nblk, k0 = 64 * kb, n0 = 32 * nb;
    const int ncol = n0 + (lane & 31);
    int src = ncol;
    if (permute_qk && ncol < 2048) { const int p = ncol & 127; src = (ncol & ~127) + ((p & 1) << 6) + (p >> 1); }
#pragma unroll 8
    for (int i = 0; i < 32; ++i) { const int kk = 2 * i + (lane >> 5); scr[kk * 33 + (lane & 31)] = W[(size_t)(k0 + kk) * N + src]; }
    LDS_WAIT();
    const int c = lane & 7;
#pragma unroll
    for (int j = 0; j < 4; ++j) { const int n = (lane >> 3) + 8 * j; const LAS float* s = scr + (8 * c) * 33 + n;
        u32x4 o; o.x = cvt_pk_bf16(s[0 * 33], s[1 * 33]); o.y = cvt_pk_bf16(s[2 * 33], s[3 * 33]); o.z = cvt_pk_bf16(s[4 * 33], s[5 * 33]); o.w = cvt_pk_bf16(s[6 * 33], s[7 * 33]);
        *(u32x4*)(WT + (size_t)(n0 + n) * K + k0 + 8 * c) = o; }
    LDS_WAIT();
}

__device__ __forceinline__ void phase0(const Args& a, LAS unsigned char* lds) {
    unsigned char* ws = a.ws;
    const int tid = threadIdx.x, lane = tid & 63, wave = tid >> 6;
    const int G = gridDim.x;
    const size_t gtid = (size_t)blockIdx.x * 512 + tid, NT = (size_t)G * 512;
    { int* cnt = (int*)(ws + WS_CNT); for (size_t i = gtid; i < 1088; i += NT) cnt[i] = 0;
      float* ks = (float*)(ws + WS_KSUM); for (size_t i = gtid; i < 128 * 1024; i += NT) ks[i] = 0.f; }
    { LAS float* scr = (LAS float*)(lds + wave * 16384);
      const int gw = blockIdx.x * 8 + wave, NGW = G * 8;
      constexpr int I_IN = (DM / 64) * (DIN / 32), I_OUT = (DM / 64) * (DM / 32), I_MKV = (DM / 64) * (1024 / 32);
      for (int it = gw; it < I_IN + I_OUT + I_MKV; it += NGW) {
          int r = it;
          if (r < I_IN) { p0_transpose_item(a.w_in, DM, DIN, (bf16_t*)(ws + WS_WIN), true, scr, r, lane); continue; } r -= I_IN;
          if (r < I_OUT) { p0_transpose_item(a.w_out, DM, DM, (bf16_t*)(ws + WS_WOUT), false, scr, r, lane); continue; } r -= I_OUT;
          p0_transpose_item(a.w_mkv, DM, 1024, (bf16_t*)(ws + WS_WMKV), false, scr, r, lane);
      } }
    { const size_t n8 = (size_t)MROWS * DM / 8; u32x4* xb = (u32x4*)(ws + WS_XB);
      for (size_t i0 = gtid; i0 < n8; i0 += 4 * NT) {
          f32x4 v[4][2];
#pragma unroll
          for (int j = 0; j < 4; ++j) { const size_t i = i0 + j * NT; if (i < n8) { v[j][0] = __builtin_nontemporal_load((const f32x4*)a.x + 2 * i); v[j][1] = __builtin_nontemporal_load((const f32x4*)a.x + 2 * i + 1); } }
          __builtin_amdgcn_sched_barrier(0);
#pragma unroll
          for (int j = 0; j < 4; ++j) { const size_t i = i0 + j * NT; if (i < n8) { const f32x4 v0 = v[j][0], v1 = v[j][1];
              u32x4 o; o.x = cvt_pk_bf16(v0[0], v0[1]); o.y = cvt_pk_bf16(v0[2], v0[3]); o.z = cvt_pk_bf16(v1[0], v1[1]); o.w = cvt_pk_bf16(v1[2], v1[3]); xb[i] = o; } }
          __builtin_amdgcn_sched_barrier(0);
      }
      const size_t m8 = (size_t)BATCH * MEMLEN * DM / 8; u32x4* mb = (u32x4*)(ws + WS_MEMB);
      for (size_t i = gtid; i < m8; i += NT) { const f32x4 v0 = ((const f32x4*)a.mem)[2 * i], v1 = ((const f32x4*)a.mem)[2 * i + 1];
          u32x4 o; o.x = cvt_pk_bf16(v0[0], v0[1]); o.y = cvt_pk_bf16(v0[2], v0[3]); o.z = cvt_pk_bf16(v1[0], v1[1]); o.w = cvt_pk_bf16(v1[2], v1[3]); mb[i] = o; } }
    { bf16_t* wsb = (bf16_t*)(ws + WS_WSB);
      for (size_t i = gtid; i < 4 * 128 * 128; i += NT) { const int t = (int)(i >> 7) & 127, s = (int)i & 127; const float v = s <= t ? a.w_s[i] : 0.f; wsb[i] = (bf16_t)(cvt_pk_bf16(v, 0.f) & 0xffffu); } }
    { float* cT = (float*)(ws + WS_COS); float* sT = (float*)(ws + WS_SIN);
      LAS float* invf = (LAS float*)(lds + 8 * 16384);
      if (tid < 64) invf[tid] = (float)exp2(-(double)tid * (13.287712379549449 / 64.0));
      __syncthreads();
      for (size_t e = gtid; e < (size_t)MROWS * 64; e += NT) { const int row = (int)(e >> 6), i = (int)e & 63;
          const float inv = invf[i];
          const float ang = (float)a.pos[row] * inv;
          const double rev = (double)ang * 0.15915494309189535; const float fr = (float)(rev - rint(rev));
          cT[e] = __builtin_amdgcn_cosf(fr); sT[e] = __builtin_amdgcn_sinf(fr); } }
}

__device__ __forceinline__ int list_base(int n) { return 256 * (64 * n - (n * (n - 1)) / 2); }
__device__ __forceinline__ unsigned long long shfl_xor_u64(unsigned long long v, int m) {
    unsigned lo = (unsigned)v, hi = (unsigned)(v >> 32); lo = __shfl_xor(lo, m); hi = __shfl_xor(hi, m); return ((unsigned long long)hi << 32) | lo; }

__device__ __forceinline__ void phase2(const Args& a, LAS unsigned char* lds) {
    unsigned char* ws = a.ws;
    const int tid = threadIdx.x, lane = tid & 63, wave = __builtin_amdgcn_readfirstlane(tid >> 6), fr = lane & 15, fq = lane >> 4;
    const bf16_t* proj = (const bf16_t*)(ws + WS_PROJ);
    const float* ksum = (const float*)(ws + WS_KSUM);
    int* cnt = (int*)(ws + WS_CNT);
    unsigned* list = (unsigned*)(ws + WS_LIST);
    LAS unsigned char* Kl = lds;
    LAS int* lcnt = (LAS int*)(lds + 16384);
    LAS int* gbase = (LAS int*)(lds + 16384 + 256);
    { const bf16_t* memb = (const bf16_t*)(ws + WS_MEMB); const bf16_t* wt = (const bf16_t*)(ws + WS_WMKV); bf16_t* mkv = (bf16_t*)(ws + WS_MKV);
      for (int t = blockIdx.x; t < 256; t += gridDim.x) {
          const int m0 = (t & 15) * 32 + 16 * (wave & 1), n0 = (t >> 4) * 64 + 16 * (wave >> 1);
          const bf16_t* ap = wt + (size_t)(n0 + fr) * DM + 8 * fq; const bf16_t* bp = memb + (size_t)(m0 + fr) * DM + 8 * fq;
          f32x4 acc = (f32x4){0.f, 0.f, 0.f, 0.f};
          bf16x8 av[8], bv[8], an[8], bn[8];
#pragma unroll
          for (int i = 0; i < 8; ++i) { av[i] = *(const bf16x8*)(ap + 32 * i); bv[i] = *(const bf16x8*)(bp + 32 * i); }
#pragma unroll 1
          for (int kb = 0; kb < 8; ++kb) {
              const int kn = kb < 7 ? kb + 1 : kb;
#pragma unroll
              for (int i = 0; i < 8; ++i) { an[i] = *(const bf16x8*)(ap + 32 * (8 * kn + i)); bn[i] = *(const bf16x8*)(bp + 32 * (8 * kn + i)); }
              __builtin_amdgcn_sched_barrier(0);
#pragma unroll
              for (int i = 0; i < 8; ++i) acc = __builtin_amdgcn_mfma_f32_16x16x32_bf16(av[i], bv[i], acc, 0, 0, 0);
              __builtin_amdgcn_sched_barrier(0);
#pragma unroll
              for (int i = 0; i < 8; ++i) { av[i] = an[i]; bv[i] = bn[i]; }
          }
          u32x2 w; w.x = cvt_pk_bf16(acc[0], acc[1]); w.y = cvt_pk_bf16(acc[2], acc[3]);
          *(u32x2*)(mkv + (size_t)(m0 + fr) * 1024 + n0 + 4 * fq) = w; } }
    LAS int* pend_n = (LAS int*)(lds + 18432);
    LAS int* pend_lp = (LAS int*)(lds + 18432 + 16384);
    LAS int* lcnt4 = (LAS int*)(lds + 16384);
    LAS int* gbase4 = (LAS int*)(lds + 16384 + 1024);
    for (int grp = blockIdx.x; grp < 256; grp += gridDim.x) {
        const int bh = grp >> 4, qb0 = (grp & 15) * 4, b = bh >> 3, h = bh & 7;
        { const int n = tid >> 3, c2 = tid & 7; const float* kp = ksum + (size_t)(b * 64 + n) * 1024 + h * 128 + c2 * 16;
          const f32x4 v0 = *(const f32x4*)kp, v1 = *(const f32x4*)(kp + 4), v2 = *(const f32x4*)(kp + 8), v3 = *(const f32x4*)(kp + 12);
          u32x4 w0, w1; w0.x = cvt_pk_bf16(v0[0], v0[1]); w0.y = cvt_pk_bf16(v0[2], v0[3]); w0.z = cvt_pk_bf16(v1[0], v1[1]); w0.w = cvt_pk_bf16(v1[2], v1[3]);
          w1.x = cvt_pk_bf16(v2[0], v2[1]); w1.y = cvt_pk_bf16(v2[2], v2[3]); w1.z = cvt_pk_bf16(v3[0], v3[1]); w1.w = cvt_pk_bf16(v3[2], v3[3]);
          *(LAS u32x4*)(Kl + n * 256 + (((2 * c2) ^ (n & 15)) << 4)) = w0; *(LAS u32x4*)(Kl + n * 256 + (((2 * c2 + 1) ^ (n & 15)) << 4)) = w1;
          if (tid < 256) lcnt4[tid] = 0; }
        const bf16_t* qbase = proj + (size_t)(b * SEQ + wave * 32 + fr) * DIN + h * 128 + 8 * fq;
        bf16x8 qcur[2][4];
#pragma unroll
        for (int tt = 0; tt < 2; ++tt)
#pragma unroll
            for (int k = 0; k < 4; ++k) qcur[tt][k] = *(const bf16x8*)(qbase + (size_t)(qb0 * 256 + tt * 16) * DIN + 32 * k);
        __syncthreads();
#pragma unroll 1
        for (int kk = 0; kk < 4; ++kk) {
            const int qb = qb0 + kk;
            bf16x8 qnxt[2][4];
            { const int qbn = kk < 3 ? qb + 1 : qb;
#pragma unroll
              for (int tt = 0; tt < 2; ++tt)
#pragma unroll
                  for (int k = 0; k < 4; ++k) qnxt[tt][k] = *(const bf16x8*)(qbase + (size_t)(qbn * 256 + tt * 16) * DIN + 32 * k); }
#pragma unroll
            for (int tt = 0; tt < 2; ++tt) {
                unsigned long long best0 = 0ull, best1 = 0ull, best2 = 0ull;
#pragma unroll
                for (int nt = 0; nt < 4; ++nt) {
                    if (16 * nt < qb) {
                        f32x4 g = (f32x4){0.f, 0.f, 0.f, 0.f};
#pragma unroll
                        for (int k = 0; k < 4; ++k) { const bf16x8 av = *(const LAS bf16x8*)(Kl + (16 * nt + fr) * 256 + (((4 * k + fq) ^ fr) << 4)); g = __builtin_amdgcn_mfma_f32_16x16x32_bf16(av, qcur[tt][k], g, 0, 0, 0); }
#pragma unroll
                        for (int j = 0; j < 4; ++j) { const int n = 16 * nt + 4 * fq + j;
                            const float gj = j == 0 ? g.x : j == 1 ? g.y : j == 2 ? g.z : g.w; const unsigned bits = __float_as_uint(gj); const unsigned ord = (bits & 0x80000000u) ? ~bits : (bits | 0x80000000u);
                            unsigned long long key = n < qb ? (((unsigned long long)ord << 32) | (unsigned)(63 - n)) : 0ull;
                            if (key > best0) { const unsigned long long t = best0; best0 = key; key = t; }
                            if (key > best1) { const unsigned long long t = best1; best1 = key; key = t; }
                            if (key > best2) { best2 = key; } }
                    }
                }
                int ptr = 0; int myn = -1;
#pragma unroll
                for (int r = 0; r < 3; ++r) {
                    const unsigned long long cand = ptr == 0 ? best0 : ptr == 1 ? best1 : ptr == 2 ? best2 : 0ull;
                    unsigned long long g = cand; { const unsigned long long o = shfl_xor_u64(g, 16); g = o > g ? o : g; } { const unsigned long long o = shfl_xor_u64(g, 32); g = o > g ? o : g; }
                    if (g != 0ull && cand == g) ++ptr;
                    if (fq == r && g != 0ull) myn = 63 - (int)(unsigned)(g & 0xffffffffull);
                }
                if (fq == 3) myn = qb;
                int lp = 0;
                if (myn >= 0) lp = __hip_atomic_fetch_add(lcnt4 + kk * 64 + myn, 1, __ATOMIC_RELAXED, __HIP_MEMORY_SCOPE_WORKGROUP);
                pend_n[(kk * 2 + tt) * 512 + tid] = myn; pend_lp[(kk * 2 + tt) * 512 + tid] = lp;
            }
#pragma unroll
            for (int tt = 0; tt < 2; ++tt)
#pragma unroll
                for (int k = 0; k < 4; ++k) qcur[tt][k] = qnxt[tt][k];
        }
        __syncthreads();
        if (tid < 256) { const int c = lcnt4[tid]; gbase4[tid] = c ? atomicAdd(cnt + bh * 64 + (tid & 63), c) : 0; }
        __syncthreads();
#pragma unroll 1
        for (int e = 0; e < 8; ++e) { const int kk = e >> 1, tt = e & 1; const int myn = pend_n[e * 512 + tid];
            if (myn >= 0) { const int s = (qb0 + kk) * 256 + (wave * 2 + tt) * 16 + fr;
                list[(size_t)bh * LIST_PER_BH + list_base(myn) + gbase4[kk * 64 + myn] + pend_lp[e * 512 + tid]] = (unsigned)s | ((unsigned)fq << 14); } }
        __syncthreads();
    }
}

__device__ __forceinline__ float sq8(u32x4 v) {
    const float a = bflo(v.x), b = bfhi(v.x), c = bflo(v.y), d = bfhi(v.y), e = bflo(v.z), f = bfhi(v.z), g = bflo(v.w), h = bfhi(v.w);
    return ((a * a + b * b) + (c * c + d * d)) + ((e * e + f * f) + (g * g + h * h)); }
__device__ __forceinline__ void stage_kv(LAS unsigned char* Kl, LAS unsigned char* Vl, const bf16_t* Kg, const bf16_t* Vg, int stride, int tid, LAS float* kmx) {
    float nmax = 0.f;
#pragma unroll
    for (int it = 0; it < 8; ++it) { const int q = tid + 512 * it, c = q & 15, r = q >> 4;
        const u32x4 v = *(const u32x4*)(Kg + (size_t)r * stride + 8 * c);
        *(LAS u32x4*)(Kl + r * 256 + ((c ^ (r & 15)) << 4)) = v;
        float n2 = sq8(v); n2 += __shfl_xor(n2, 1); n2 += __shfl_xor(n2, 2); n2 += __shfl_xor(n2, 4); n2 += __shfl_xor(n2, 8);
        nmax = fmaxf(nmax, n2); }
    nmax = fmaxf(nmax, __shfl_xor(nmax, 16)); nmax = fmaxf(nmax, __shfl_xor(nmax, 32));
    if ((tid & 63) == 0) kmx[tid >> 6] = nmax;
#pragma unroll
    for (int it = 0; it < 4; ++it) { const int q = tid + 512 * it, c = q & 15, kp = q >> 4, kq = 2 * kp;
        const int key = (kq & 0xE0) | (((kq >> 2) & 1) << 4) | (((kq >> 3) & 3) << 2) | (kq & 3);
        const u32x4 v0 = *(const u32x4*)(Vg + (size_t)key * stride + 8 * c), v1 = *(const u32x4*)(Vg + (size_t)(key + 1) * stride + 8 * c);
        const unsigned a0[4] = {v0.x, v0.y, v0.z, v0.w}, a1[4] = {v1.x, v1.y, v1.z, v1.w};
#pragma unroll
        for (int i = 0; i < 8; ++i) { const int d = 8 * c + i;
            const unsigned lo = (i & 1) ? (a0[i >> 1] >> 16) : (a0[i >> 1] & 0xffffu), hi = (i & 1) ? (a1[i >> 1] & 0xffff0000u) : (a1[i >> 1] << 16);
            *(LAS unsigned*)(Vl + d * 512 + ((((kq >> 3)) ^ (d & 15)) << 4) + (kq & 7) * 2) = lo | hi; } }
}
__device__ __forceinline__ float kmax_of(const LAS float* kmx) {
    float m = kmx[0];
#pragma unroll
    for (int i = 1; i < 8; ++i) m = fmaxf(m, kmx[i]);
    return sqrtf(m) * 1.002f; }

__device__ __forceinline__ float qnorm(const bf16x8 (&qf)[4]) {
    float qq = 0.f;
#pragma unroll
    for (int k = 0; k < 4; ++k) qq += sq8(__builtin_bit_cast(u32x4, qf[k]));
    qq += __shfl_xor(qq, 16); qq += __shfl_xor(qq, 32);
    return sqrtf(qq); }
#define AT_SCHED() __builtin_amdgcn_sched_barrier(0)
#define AT_LOADK(S) do { _Pragma("unroll") for (int k = 0; k < 4; ++k) { kf[2 * k] = *(const LAS bf16x8*)(Kl + kb[k] + (S) * 8192); kf[2 * k + 1] = *(const LAS bf16x8*)(Kl + kb[k] + (S) * 8192 + 4096); } } while (0)
#define AT_LOADV(S) do { const unsigned vb = (unsigned)fr * 512u + ((unsigned)((4 * (S) + fq) ^ fr) << 4); _Pragma("unroll") for (int dt = 0; dt < 8; ++dt) vf[dt] = *(const LAS bf16x8*)(Vl + vb + dt * 8192); } while (0)
__device__ __forceinline__ void attn_core(const LAS unsigned char* Kl, const LAS unsigned char* Vl, const bf16x8 (&qf)[4], int fr, int fq, bool do_mask, int qrel, int smax, float kmax,
                                          f32x4 (&oacc)[8], float& m_out, float& l_out) {
    asm volatile("" : "+v"(fr), "+v"(fq));
    unsigned kb[4];
#pragma unroll
    for (int k = 0; k < 4; ++k) kb[k] = (unsigned)fr * 256u + ((unsigned)((4 * k + fq) ^ fr) << 4);
    bf16x8 kf[8], vf[8];
    AT_LOADK(0); AT_LOADV(0);
    const float m = kmax;
    float l = 0.f;
#pragma unroll
    for (int dt = 0; dt < 8; ++dt) oacc[dt] = (f32x4){0.f, 0.f, 0.f, 0.f};
    f32x4 c0 = (f32x4){-m, -m, -m, -m}, c1 = c0;
    AT_SCHED();
#pragma unroll
    for (int k = 0; k < 4; ++k) { c0 = __builtin_amdgcn_mfma_f32_16x16x32_bf16(kf[2 * k], qf[k], c0, 0, 0, 0); c1 = __builtin_amdgcn_mfma_f32_16x16x32_bf16(kf[2 * k + 1], qf[k], c1, 0, 0, 0); }
    AT_SCHED();
    if (1 < smax) AT_LOADK(1);
#pragma unroll
    for (int s = 0; s < 8; ++s) {
        if (s < smax) {
            AT_SCHED();
            f32x4 n0 = (f32x4){-m, -m, -m, -m}, n1 = n0;
            if (s + 1 < smax) {
#pragma unroll
                for (int k = 0; k < 4; ++k) { n0 = __builtin_amdgcn_mfma_f32_16x16x32_bf16(kf[2 * k], qf[k], n0, 0, 0, 0); n1 = __builtin_amdgcn_mfma_f32_16x16x32_bf16(kf[2 * k + 1], qf[k], n1, 0, 0, 0); }
            }
            AT_SCHED();
            if (s + 2 < smax) AT_LOADK(s + 2);
            AT_SCHED();
            float p[8] = {c0.x, c0.y, c0.z, c0.w, c1.x, c1.y, c1.z, c1.w};
            if (do_mask) {
#pragma unroll
                for (int j = 0; j < 4; ++j) { if (32 * s + 4 * fq + j > qrel) p[j] = -INFINITY; if (32 * s + 16 + 4 * fq + j > qrel) p[4 + j] = -INFINITY; }
            }
#pragma unroll
            for (int j = 0; j < 8; ++j) p[j] = fast_exp2(p[j]);
            l += ((p[0] + p[1]) + (p[2] + p[3])) + ((p[4] + p[5]) + (p[6] + p[7]));
            u32x4 w; w.x = cvt_pk_bf16(p[0], p[1]); w.y = cvt_pk_bf16(p[2], p[3]); w.z = cvt_pk_bf16(p[4], p[5]); w.w = cvt_pk_bf16(p[6], p[7]);
            const bf16x8 pb = __builtin_bit_cast(bf16x8, w);
            AT_SCHED();
#pragma unroll
            for (int dt = 0; dt < 8; ++dt) oacc[dt] = __builtin_amdgcn_mfma_f32_16x16x32_bf16(vf[dt], pb, oacc[dt], 0, 0, 0);
            AT_SCHED();
            if (s + 1 < smax) AT_LOADV(s + 1);
            c0 = n0; c1 = n1;
        }
    }
    AT_SCHED();
    l += __shfl_xor(l, 16); l += __shfl_xor(l, 32);
    m_out = m; l_out = l;
}

__device__ __forceinline__ void phase3(const Args& a, LAS unsigned char* lds) {
    unsigned char* ws = a.ws;
    const int tid = threadIdx.x, lane = tid & 63, wave = __builtin_amdgcn_readfirstlane(tid >> 6), fr = lane & 15, fq = lane >> 4;
    const int fr_ = fr, fq_ = fq, lane_ = lane, tid_ = tid;
    const bf16_t* proj = (const bf16_t*)(ws + WS_PROJ);
    const int* cnt = (const int*)(ws + WS_CNT);
    const unsigned* list = (const unsigned*)(ws + WS_LIST);
    bf16_t* PO = (bf16_t*)(ws + WS_PO); f32x2* PML = (f32x2*)(ws + WS_PML);
    bf16_t* Y = (bf16_t*)(ws + WS_Y);
    LAS unsigned char* Kl = lds; LAS unsigned char* Vl = lds + 65536;
    LAS int* pre = (LAS int*)(lds + 131072);
    LAS float* kmx = (LAS float*)(lds + 131072 + 12288);
    LAS int* prp = (LAS int*)(lds + 131072 + 4352);
    LAS int* nxt = (LAS int*)(lds + 131072 + 12288 + 64);
    if (wave == 0) {
        int locf[16], locp[16]; int sumf = 0, sump = 0;
#pragma unroll
        for (int i = 0; i < 16; ++i) { const int c = cnt[lane * 16 + i]; locf[i] = c / QCH; locp[i] = (c % QCH) ? 1 : 0; sumf += locf[i]; sump += locp[i]; }
        int incf = sumf, incp = sump;
#pragma unroll
        for (int o = 1; o < 64; o <<= 1) { const int vf_ = __shfl_up(incf, o), vp_ = __shfl_up(incp, o); if (lane >= o) { incf += vf_; incp += vp_; } }
        int runf = incf - sumf, runp = incp - sump;
#pragma unroll
        for (int i = 0; i < 16; ++i) { pre[lane * 16 + i] = runf; prp[lane * 16 + i] = runp; runf += locf[i]; runp += locp[i]; }
        if (lane == 63) { pre[1024] = runf; prp[1024] = runp; }
    }
    __syncthreads();
    const int nfull = pre[1024], npart = prp[1024];
    int* ticket = (int*)(ws + WS_CNT) + 1024;
    int it_static = blockIdx.x; bool dyn = false;
    for (;;) {
        int idx = 0;
        if (!dyn) { if (it_static < nfull) { idx = it_static; it_static += gridDim.x; } else dyn = true; }
        if (dyn) {
            __syncthreads();
            if (tid == 0) nxt[0] = atomicAdd(ticket, 1);
            __syncthreads();
            idx = nxt[0];
            if (idx >= npart) break;
            idx += nfull;
        }
        int u, c;
        if (idx < nfull) { int lo = 0, hi = 1024; while (hi - lo > 1) { const int mid = (lo + hi) >> 1; if (pre[mid] <= idx) lo = mid; else hi = mid; } u = lo; c = idx - pre[u]; }
        else { const int j = idx - nfull; int lo = 0, hi = 1024; while (hi - lo > 1) { const int mid = (lo + hi) >> 1; if (prp[mid] <= j) lo = mid; else hi = mid; } u = lo; c = cnt[u] / QCH; }
        const int bh = u >> 6, n = u & 63, b = bh >> 3, h = bh & 7;
        int tid = tid_, fr = fr_, fq = fq_; asm volatile("" : "+v"(tid), "+v"(fr), "+v"(fq));
        const int count = cnt[u], qbase = c * QCH;
        const int ntile = min(QCH / 16, (count - qbase + 15) >> 4);
        const unsigned* lp = list + (size_t)bh * LIST_PER_BH + list_base(n);
        const bf16_t* qb0 = proj + (size_t)(b * SEQ) * DIN + h * 128 + 8 * fq;
        int tile = wave;
        unsigned ent_c = 0u, ent_n = 0u;
        if (tile < ntile) ent_c = lp[min(qbase + tile * 16 + fr, count - 1)];
        if (tile + 8 < ntile) ent_n = lp[min(qbase + (tile + 8) * 16 + fr, count - 1)];
        __syncthreads();
        const bf16_t* Kg = proj + (size_t)(b * SEQ + n * 256) * DIN + C_K + h * 128;
        stage_kv(Kl, Vl, Kg, Kg + (C_V - C_K), DIN, tid, kmx);
        bf16x8 qc[4];
        { const bf16_t* qp = qb0 + (size_t)(ent_c & 0x3fffu) * DIN;
#pragma unroll
          for (int k = 0; k < 4; ++k) qc[k] = *(const bf16x8*)(qp + 32 * k); }
        float qn_c = qnorm(qc);
        __syncthreads();
        const float kmax = kmax_of(kmx);
        for (; tile < ntile; tile += 8) {
            bf16x8 qn[4]; unsigned ent_nn = 0u;
#pragma unroll
            for (int k = 0; k < 4; ++k) qn[k] = qc[k];
            if (tile + 8 < ntile) {
                const bf16_t* qp = qb0 + (size_t)(ent_n & 0x3fffu) * DIN;
#pragma unroll
                for (int k = 0; k < 4; ++k) qn[k] = *(const bf16x8*)(qp + 32 * k);
                if (tile + 16 < ntile) ent_nn = lp[min(qbase + (tile + 16) * 16 + fr, count - 1)];
            }
            const bool valid = qbase + tile * 16 + fr < count;
            const int sq = (int)(ent_c & 0x3fffu), slot = (int)(ent_c >> 14);
            const bool do_mask = __any(slot == 3);
            const int qrel = sq - n * 256;
            int smax = 8;
            if (do_mask) { int qm = qrel;
#pragma unroll
                for (int o = 1; o < 64; o <<= 1) qm = max(qm, __shfl_xor(qm, o));
                smax = min(8, (qm >> 5) + 1); }
            smax = __builtin_amdgcn_readfirstlane(smax);
            f32x4 oacc[8]; float mx, l;
            attn_core(Kl, Vl, qc, fr, fq, do_mask, qrel, smax, qn_c * kmax, oacc, mx, l);
            qn_c = qnorm(qn);
            __builtin_amdgcn_sched_barrier(0);
            if (valid) {
                const size_t pidx = ((size_t)bh * SEQ + sq) * 4 + slot;
                bf16_t* op = PO + pidx * 128 + 4 * fq;
#pragma unroll
                for (int dt = 0; dt < 8; ++dt) { u32x2 w; w.x = cvt_pk_bf16(oacc[dt][0], oacc[dt][1]); w.y = cvt_pk_bf16(oacc[dt][2], oacc[dt][3]); *(u32x2*)(op + 16 * dt) = w; }
                if (fq == 0) PML[pidx] = (f32x2){mx, l};
            }
            ent_c = ent_n; ent_n = ent_nn;
#pragma unroll
            for (int k = 0; k < 4; ++k) qc[k] = qn[k];
        }
    }
    const bf16_t* mkv = (const bf16_t*)(ws + WS_MKV);
    for (int item = blockIdx.x; item < BATCH * 4 * (SEQ / MQCH); item += gridDim.x) {
        const int c = item & 31, hm = (item >> 5) & 3, b = item >> 7;
        int tid = tid_, fr = fr_, fq = fq_; asm volatile("" : "+v"(tid), "+v"(fr), "+v"(fq));
        __syncthreads();
        const bf16_t* Kg = mkv + (size_t)(b * MEMLEN) * 1024 + hm * 128;
        stage_kv(Kl, Vl, Kg, Kg + 512, 1024, tid, kmx);
        const bf16_t* qb0 = proj + (size_t)(b * SEQ + c * MQCH + fr) * DIN + C_QME + hm * 128 + 8 * fq;
        bf16x8 qc[4];
#pragma unroll
        for (int k = 0; k < 4; ++k) qc[k] = *(const bf16x8*)(qb0 + (size_t)(wave * 16) * DIN + 32 * k);
        float qn_c = qnorm(qc);
        __syncthreads();
        const float kmax = kmax_of(kmx);
        for (int tile = wave; tile < MQCH / 16; tile += 8) {
            bf16x8 qn[4];
#pragma unroll
            for (int k = 0; k < 4; ++k) qn[k] = qc[k];
            if (tile + 8 < MQCH / 16) {
#pragma unroll
                for (int k = 0; k < 4; ++k) qn[k] = *(const bf16x8*)(qb0 + (size_t)((tile + 8) * 16) * DIN + 32 * k); }
            const int sq = c * MQCH + tile * 16 + fr; const size_t row = (size_t)(b * SEQ + sq);
            f32x4 oacc[8]; float mx, l;
            attn_core(Kl, Vl, qc, fr, fq, false, 0, 8, qn_c * kmax, oacc, mx, l);
            qn_c = qnorm(qn);
            __builtin_amdgcn_sched_barrier(0);
            const float rl = 1.f / l;
            const bf16_t* gp = proj + row * DIN + C_GME + hm * 128 + 4 * fq;
            bf16_t* yp = Y + row * DM + 1536 + hm * 128 + 4 * fq;
            u32x2 gv[8];
#pragma unroll
            for (int dt = 0; dt < 8; ++dt) gv[dt] = *(const u32x2*)(gp + 16 * dt);
            __builtin_amdgcn_sched_barrier(0);
#pragma unroll
            for (int dt = 0; dt < 8; ++dt) { const u32x2 g = gv[dt];
                u32x2 w; w.x = cvt_pk_bf16(oacc[dt][0] * rl * bflo(g.x), oacc[dt][1] * rl * bfhi(g.x)); w.y = cvt_pk_bf16(oacc[dt][2] * rl * bflo(g.y), oacc[dt][3] * rl * bfhi(g.y));
                *(u32x2*)(yp + 16 * dt) = w; }
#pragma unroll
            for (int k = 0; k < 4; ++k) qc[k] = qn[k];
        }
    }
    const bf16_t* wsb = (const bf16_t*)(ws + WS_WSB);
    for (int item = blockIdx.x; item < BATCH * (SEQ / 128); item += gridDim.x) {
        const size_t row0 = (size_t)item * 128;
        int fr = fr_, fq = fq_, lane = lane_; asm volatile("" : "+v"(fr), "+v"(fq), "+v"(lane));
        __syncthreads();
        {
            const f32x4 g0 = *(const f32x4*)(a.gln_g + 8 * lane), g1 = *(const f32x4*)(a.gln_g + 8 * lane + 4), b0 = *(const f32x4*)(a.gln_b + 8 * lane), b1 = *(const f32x4*)(a.gln_b + 8 * lane + 4);
            u32x4 raw[16];
#pragma unroll
            for (int i = 0; i < 16; ++i) raw[i] = *(const u32x4*)(proj + (row0 + wave + 8 * i) * DIN + C_VG + 8 * lane);
#pragma unroll
            for (int i = 0; i < 16; ++i) {
                const int tk = wave + 8 * i;
                float v[8] = {bflo(raw[i].x), bfhi(raw[i].x), bflo(raw[i].y), bfhi(raw[i].y), bflo(raw[i].z), bfhi(raw[i].z), bflo(raw[i].w), bfhi(raw[i].w)};
                float sm = 0.f;
#pragma unroll
                for (int e = 0; e < 8; ++e) sm += v[e];
#pragma unroll
                for (int o = 1; o < 64; o <<= 1) sm += __shfl_xor(sm, o);
                const float mu = sm * (1.f / 512.f); float q = 0.f;
#pragma unroll
                for (int e = 0; e < 8; ++e) { v[e] -= mu; q += v[e] * v[e]; }
#pragma unroll
                for (int o = 1; o < 64; o <<= 1) q += __shfl_xor(q, o);
                const float rstd = 1.f / sqrtf(q * (1.f / 512.f) + LN_EPS);
#pragma unroll
                for (int e = 0; e < 8; ++e) { const float o = v[e] * rstd * (e < 4 ? g0[e] : g1[e - 4]) + (e < 4 ? b0[e] : b1[e - 4]);
                    *(LAS bf16_t*)(lds + (8 * lane + e) * 272 + tk * 2) = (bf16_t)(cvt_pk_bf16(o, 0.f) & 0xffffu); }
            }
        }
        __syncthreads();
        const int g = wave >> 1, th = wave & 1;
        f32x4 acc[8][4];
#pragma unroll
        for (int ct = 0; ct < 8; ++ct)
#pragma unroll
            for (int tt = 0; tt < 4; ++tt) acc[ct][tt] = (f32x4){0.f, 0.f, 0.f, 0.f};
#pragma unroll
        for (int k = 0; k < 4; ++k) {
            bf16x8 wf[4];
#pragma unroll
            for (int tt = 0; tt < 4; ++tt) wf[tt] = *(const bf16x8*)(wsb + (size_t)(g * 128 + 64 * th + 16 * tt + fr) * 128 + 32 * k + 8 * fq);
#pragma unroll
            for (int ct = 0; ct < 8; ++ct) { const bf16x8 av = *(const LAS bf16x8*)(lds + (128 * g + 16 * ct + fr) * 272 + (32 * k + 8 * fq) * 2);
#pragma unroll
                for (int tt = 0; tt < 4; ++tt) acc[ct][tt] = __builtin_amdgcn_mfma_f32_16x16x32_bf16(av, wf[tt], acc[ct][tt], 0, 0, 0); }
        }
#pragma unroll
        for (int tt = 0; tt < 4; ++tt) { const int t = 64 * th + 16 * tt + fr; const float bs = a.b_s[g * 128 + t]; const size_t row = row0 + t;
            u32x2 uuv[8], ggv[8];
#pragma unroll
            for (int ct = 0; ct < 8; ++ct) { const int ch = 128 * g + 16 * ct + 4 * fq; uuv[ct] = *(const u32x2*)(proj + row * DIN + C_U + ch); ggv[ct] = *(const u32x2*)(proj + row * DIN + C_GG + ch); }
            __builtin_amdgcn_sched_barrier(0);
#pragma unroll
            for (int ct = 0; ct < 8; ++ct) { const int ch = 128 * g + 16 * ct + 4 * fq;
                const u32x2 uu = uuv[ct], gg = ggv[ct];
                const f32x4 m = acc[ct][tt] + bs;
                u32x2 w; w.x = cvt_pk_bf16(bflo(uu.x) * m[0] * bflo(gg.x), bfhi(uu.x) * m[1] * bfhi(gg.x)); w.y = cvt_pk_bf16(bflo(uu.y) * m[2] * bflo(gg.y), bfhi(uu.y) * m[3] * bfhi(gg.y));
                *(u32x2*)(Y + row * DM + 1024 + ch) = w; } }
    }
}

__device__ __forceinline__ void phase4(const Args& a) {
    unsigned char* ws = a.ws;
    const int tid = threadIdx.x, lane = tid & 63, wave = tid >> 6;
    const bf16_t* proj = (const bf16_t*)(ws + WS_PROJ);
    const bf16_t* PO = (const bf16_t*)(ws + WS_PO); const f32x2* PML = (const f32x2*)(ws + WS_PML);
    bf16_t* Y = (bf16_t*)(ws + WS_Y);
    const int rl_ = lane >> 3, d0 = (lane & 7) * 16;
    const int nw = gridDim.x * 8;
    for (int t0 = blockIdx.x * 8 + wave; t0 < 16 * (SEQ / 8); t0 += 2 * nw) {
        f32x2 ml[2][4]; u32x4 pp[2][4][2]; u32x4 gg[2][2];
#pragma unroll
        for (int r = 0; r < 2; ++r) {
            const int t = (t0 + r * nw < 16 * (SEQ / 8)) ? t0 + r * nw : t0;
            const int bh = 15 - t / (SEQ / 8), s = (t % (SEQ / 8)) * 8 + rl_, b = bh >> 3, h = bh & 7, qb = s >> 8, nv = qb < 3 ? qb : 3;
            const size_t pbase = ((size_t)bh * SEQ + s) * 4; const size_t row = (size_t)b * SEQ + s;
#pragma unroll
            for (int j = 0; j < 4; ++j) { const bool ok = (j == 3) || (j < nv);
                ml[r][j] = ok ? PML[pbase + j] : (f32x2){-INFINITY, 0.f};
                if (ok) { pp[r][j][0] = *(const u32x4*)(PO + (pbase + j) * 128 + d0); pp[r][j][1] = *(const u32x4*)(PO + (pbase + j) * 128 + d0 + 8); }
                else { pp[r][j][0] = (u32x4){0u, 0u, 0u, 0u}; pp[r][j][1] = pp[r][j][0]; } }
            gg[r][0] = *(const u32x4*)(proj + row * DIN + C_GMO + h * 128 + d0); gg[r][1] = *(const u32x4*)(proj + row * DIN + C_GMO + h * 128 + d0 + 8);
        }
        __builtin_amdgcn_sched_barrier(0);
#pragma unroll
        for (int r = 0; r < 2; ++r) {
            const int t = t0 + r * nw;
            if (t < 16 * (SEQ / 8)) {
                const int bh = 15 - t / (SEQ / 8), s = (t % (SEQ / 8)) * 8 + rl_, b = bh >> 3, h = bh & 7; const size_t row = (size_t)b * SEQ + s;
                float M = -INFINITY;
#pragma unroll
                for (int j = 0; j < 4; ++j) M = fmaxf(M, ml[r][j].x);
                float o[16]; float L = 0.f;
#pragma unroll
                for (int e = 0; e < 16; ++e) o[e] = 0.f;
#pragma unroll
                for (int j = 0; j < 4; ++j) { const float w = fast_exp2(ml[r][j].x - M); L += w * ml[r][j].y;
                    const u32x4 p0 = pp[r][j][0], p1 = pp[r][j][1];
                    o[0] += w * bflo(p0.x); o[1] += w * bfhi(p0.x); o[2] += w * bflo(p0.y); o[3] += w * bfhi(p0.y); o[4] += w * bflo(p0.z); o[5] += w * bfhi(p0.z); o[6] += w * bflo(p0.w); o[7] += w * bfhi(p0.w);
                    o[8] += w * bflo(p1.x); o[9] += w * bfhi(p1.x); o[10] += w * bflo(p1.y); o[11] += w * bfhi(p1.y); o[12] += w * bflo(p1.z); o[13] += w * bfhi(p1.z); o[14] += w * bflo(p1.w); o[15] += w * bfhi(p1.w); }
                const float rl = 1.f / L;
                const u32x4 g0 = gg[r][0], g1 = gg[r][1];
                u32x4 w0, w1;
                w0.x = cvt_pk_bf16(o[0] * rl * bflo(g0.x), o[1] * rl * bfhi(g0.x)); w0.y = cvt_pk_bf16(o[2] * rl * bflo(g0.y), o[3] * rl * bfhi(g0.y));
                w0.z = cvt_pk_bf16(o[4] * rl * bflo(g0.z), o[5] * rl * bfhi(g0.z)); w0.w = cvt_pk_bf16(o[6] * rl * bflo(g0.w), o[7] * rl * bfhi(g0.w));
                w1.x = cvt_pk_bf16(o[8] * rl * bflo(g1.x), o[9] * rl * bfhi(g1.x)); w1.y = cvt_pk_bf16(o[10] * rl * bflo(g1.y), o[11] * rl * bfhi(g1.y));
                w1.z = cvt_pk_bf16(o[12] * rl * bflo(g1.z), o[13] * rl * bfhi(g1.z)); w1.w = cvt_pk_bf16(o[14] * rl * bflo(g1.w), o[15] * rl * bfhi(g1.w));
                *(u32x4*)(Y + row * DM + h * 128 + d0) = w0; *(u32x4*)(Y + row * DM + h * 128 + d0 + 8) = w1;
            }
        }
        __builtin_amdgcn_sched_barrier(0);
    }
}

__device__ __forceinline__ void phase6(const Args& a) {
    const int tid = threadIdx.x, lane = tid & 63, wave = tid >> 6;
    const bf16_t* sub = (const bf16_t*)(a.ws + WS_SUB);
    for (int row = blockIdx.x * 8 + wave; row < MROWS; row += gridDim.x * 8) {
        const f32x4* xp = (const f32x4*)(a.x + (size_t)row * DM) + lane;
        const u32x2* sp = (const u32x2*)(sub + (size_t)row * DM) + lane;
        f32x4* rp = (f32x4*)(a.out + (size_t)row * DM) + lane;
        f32x4 v[8]; u32x2 sv[8]; float s = 0.f;
#pragma unroll
        for (int j = 0; j < 8; ++j) { v[j] = __builtin_nontemporal_load(xp + 64 * j); sv[j] = sp[64 * j]; }
#pragma unroll
        for (int j = 0; j < 8; ++j) { v[j] = v[j] * ALPHA + (f32x4){bflo(sv[j].x), bfhi(sv[j].x), bflo(sv[j].y), bfhi(sv[j].y)}; s += (v[j][0] + v[j][1]) + (v[j][2] + v[j][3]); }
#pragma unroll
        for (int o = 1; o < 64; o <<= 1) s += __shfl_xor(s, o);
        const float mu = s * (1.f / DM); float q = 0.f;
#pragma unroll
        for (int j = 0; j < 8; ++j) { v[j] = v[j] - mu; q += (v[j][0] * v[j][0] + v[j][1] * v[j][1]) + (v[j][2] * v[j][2] + v[j][3] * v[j][3]); }
#pragma unroll
        for (int o = 1; o < 64; o <<= 1) q += __shfl_xor(q, o);
        const float rstd = 1.f / sqrtf(q * (1.f / DM) + LN_EPS);
#pragma unroll
        for (int j = 0; j < 8; ++j) { const f32x4 g = ((const f32x4*)a.ln_g)[lane + 64 * j], bb = ((const f32x4*)a.ln_b)[lane + 64 * j]; __builtin_nontemporal_store(v[j] * rstd * g + bb, rp + 64 * j); }
    }
}

#define XB_TMO      128
#define XB_XCNT(j)  (256  + 64 * (j))
#define XB_XSUB(j)  (1280 + 64 * (j))
#define XB_XGEN(j)  (2304 + 64 * (j))
#define XB_TOP      3328
#define XB_TOPGEN   3392
#define XCD_BAR_WORDS 3456
#define XB_SPIN_CAP (1u << 18)
__device__ __forceinline__ unsigned xb_ld(unsigned* p)              { return __hip_atomic_load(p, __ATOMIC_RELAXED, __HIP_MEMORY_SCOPE_AGENT); }
__device__ __forceinline__ unsigned xb_add(unsigned* p, unsigned v) { return __hip_atomic_fetch_add(p, v, __ATOMIC_RELAXED, __HIP_MEMORY_SCOPE_AGENT); }
__device__ __forceinline__ unsigned xb_xcc_id() { return (unsigned)__builtin_amdgcn_s_getreg((3 << 11) | 20) & 0xFu; }
#define XB_SPIN(cond, bar) do { unsigned _sp = 0; while (cond) { __builtin_amdgcn_s_sleep(1); \
    if ((++_sp & 255u) == 0u) { if (xb_ld(&(bar)[XB_TMO])) break; if (_sp > XB_SPIN_CAP) { atomicAdd(&(bar)[XB_TMO], 1u); break; } } } } while (0)
struct XcdBarrier { unsigned* bar; unsigned x; volatile LAS unsigned* st; };
__device__ __forceinline__ XcdBarrier xcd_barrier_post(unsigned* bar, volatile LAS unsigned* st) {
    XcdBarrier b; b.bar = bar; b.x = xb_xcc_id(); b.st = st;
    if (threadIdx.x == 0) (void)xb_add(&bar[XB_XCNT(b.x)], 1u);
    return b;
}
__device__ __forceinline__ void xcd_barrier_complete(unsigned* bar, unsigned x, unsigned& nloc, unsigned& nx) {
    const unsigned G = gridDim.x * gridDim.y * gridDim.z;
    unsigned sum, cnt, mine, sp = 0u;
    for (;;) {
        sum = 0u; cnt = 0u; mine = 0u;
#pragma unroll
        for (unsigned j = 0; j < 16; ++j) { const unsigned c = xb_ld(&bar[XB_XCNT(j)]); sum += c; cnt += (c > 0u) ? 1u : 0u; mine = (j == x) ? c : mine; }
        if (sum == G) break;
        __builtin_amdgcn_s_sleep(1);
        if ((++sp & 255u) == 0u) { if (xb_ld(&bar[XB_TMO])) break; if (sp > XB_SPIN_CAP) { atomicAdd(&bar[XB_TMO], 1u); break; } }
    }
    nloc = mine > 0u ? mine : 1u; nx = cnt > 0u ? cnt : 1u;
}
__device__ __forceinline__ void xcd_barrier(const XcdBarrier& b) {
    asm volatile("s_waitcnt vmcnt(0)" ::: "memory");
    __syncthreads();
    if (threadIdx.x == 0) {
        unsigned* bar = b.bar;
        __builtin_amdgcn_s_waitcnt(0);
        unsigned nloc = b.st[0], nx = b.st[1];
        if (nloc == 0u) { xcd_barrier_complete(bar, b.x, nloc, nx); b.st[0] = nloc; b.st[1] = nx; }
        const unsigned old = xb_add(&bar[XB_XSUB(b.x)], 1u);
        const unsigned gen = old / nloc;
        if (old + 1u == (gen + 1u) * nloc) {
            __builtin_amdgcn_fence(__ATOMIC_RELEASE, "agent");
            asm volatile("s_waitcnt vmcnt(0)" ::: "memory");
            const unsigned og = xb_add(&bar[XB_TOP], 1u);
            const unsigned tg = og / nx;
            if (og + 1u == (tg + 1u) * nx) xb_add(&bar[XB_TOPGEN], 1u);
            else XB_SPIN(xb_ld(&bar[XB_TOPGEN]) == tg, bar);
            __builtin_amdgcn_fence(__ATOMIC_ACQUIRE, "agent");
            xb_add(&bar[XB_XGEN(b.x)], 1u);
            asm volatile("s_waitcnt vmcnt(0)" ::: "memory");
        } else {
            XB_SPIN(xb_ld(&bar[XB_XGEN(b.x)]) == gen, bar);
            __builtin_amdgcn_fence(__ATOMIC_ACQUIRE, "agent");
            asm volatile("s_waitcnt vmcnt(0)" ::: "memory");
        }
    }
    __syncthreads();
}

__global__ void __launch_bounds__(512, 2) hymba_fwd(Args a) {
    extern __shared__ __attribute__((aligned(16))) unsigned char lds_raw[];
    LAS unsigned char* lds = (LAS unsigned char*)lds_raw;
    unsigned char* ws = a.ws;
    const int lo = a.ph_lo, hi = a.ph_hi, G = gridDim.x;
#define IN(k) (lo <= (k) && (k) < hi)
#define SEAM(k) do { if (IN(k) && IN((k) + 1)) xcd_barrier(xbar); } while (0)
    volatile LAS unsigned* xst = (volatile LAS unsigned*)(lds + LDS_BYTES - 64);
    if (threadIdx.x < 2) xst[threadIdx.x] = 0u;
    __syncthreads();
    XcdBarrier xbar; xbar.bar = (unsigned*)(ws + WS_BAR); xbar.x = 0; xbar.st = xst;
    if (IN(0) && IN(1)) xbar = xcd_barrier_post((unsigned*)(ws + WS_BAR), xst);
    if (IN(0)) phase0(a, lds);
    SEAM(0);
    if (IN(1)) {
        { pg8::Gemm g{(const bf16_t*)(ws + WS_XB), (const bf16_t*)(ws + WS_WIN), MROWS, DIN, DM}; pg8::StaticOrder S; S.init(g.M, g.N, G, (int)blockIdx.x);
          EpiProj E{(bf16_t*)(ws + WS_PROJ), (const float*)(ws + WS_COS), (const float*)(ws + WS_SIN), (float*)(ws + WS_KSUM)};
          pg8::gemm_phase<EpiProj, pg8::StaticOrder, true, true>(lds, g, S, E); }
    }
    SEAM(1);
    if (IN(2)) phase2(a, lds);
    SEAM(2);
    if (IN(3)) phase3(a, lds);
    SEAM(3);
    if (IN(4)) phase4(a);
    SEAM(4);
    if (IN(5)) {
        pg8::Gemm g{(const bf16_t*)(ws + WS_Y), (const bf16_t*)(ws + WS_WOUT), MROWS, DM, DM}; pg8::StaticOrder S; S.init(g.M, g.N, G, (int)blockIdx.x);
        EpiPlain E{(bf16_t*)(ws + WS_SUB), DM};
        pg8::gemm_phase<EpiPlain, pg8::StaticOrder, true, true>(lds, g, S, E);
    }
    SEAM(5);
    if (IN(6)) phase6(a);
#undef IN
#undef SEAM
}

extern "C" void kernel_launch(void* const* d_in, const int* in_sizes, int n_in, void* d_out, int out_size, void* d_ws, size_t ws_size, hipStream_t stream) {
    static int grid = 0;
    if (grid == 0) {
        if (n_in != 12 || ws_size < WS_END) { fprintf(stderr, "kernel_launch: unexpected inputs (n_in %d, ws %zu)\n", n_in, ws_size); grid = -1; return; }
        int dev = 0, cus = 0, per_cu = 0;
        hipGetDevice(&dev); hipDeviceGetAttribute(&cus, hipDeviceAttributeMultiprocessorCount, dev);
        hipFuncSetAttribute((const void*)hymba_fwd, hipFuncAttributeMaxDynamicSharedMemorySize, LDS_BYTES);
        hipOccupancyMaxActiveBlocksPerMultiprocessor(&per_cu, (const void*)hymba_fwd, 512, LDS_BYTES);
        if (per_cu < 1) { fprintf(stderr, "kernel_launch: occupancy query reports %d blocks per CU\n", per_cu); per_cu = 1; }
        grid = cus * per_cu;
        (void)hipGetLastError();
    }
    if (grid < 0) return;
    Args a{};
    a.x = (const float*)d_in[0]; a.mem = (const float*)d_in[1]; a.pos = (const int*)d_in[2]; a.w_in = (const float*)d_in[3]; a.w_mkv = (const float*)d_in[4];
    a.gln_g = (const float*)d_in[5]; a.gln_b = (const float*)d_in[6]; a.w_s = (const float*)d_in[7]; a.b_s = (const float*)d_in[8]; a.w_out = (const float*)d_in[9];
    a.ln_g = (const float*)d_in[10]; a.ln_b = (const float*)d_in[11]; a.out = (float*)d_out; a.ws = (unsigned char*)d_ws;
#if MK_MULTI
    for (int p = 0; p < 7; ++p) { a.ph_lo = p; a.ph_hi = p + 1; hipLaunchKernelGGL(hymba_fwd, dim3(grid), dim3(512), LDS_BYTES, stream, a); }
#else
    a.ph_lo = 0; a.ph_hi = 7;
    (void)hipMemsetAsync((char*)d_ws + WS_BAR, 0, BAR_WORDS_N * 4, stream);
    void* args[] = {&a};
    hipError_t e = hipLaunchCooperativeKernel((const void*)hymba_fwd, dim3(grid), dim3(512), args, LDS_BYTES, stream);
    if (e != hipSuccess) fprintf(stderr, "cooperative launch failed: %s (grid %d)\n", hipGetErrorString(e), grid);
#endif
}
```

```cpp
#include <hip/hip_runtime.h>
#include <hip/hip_cooperative_groups.h>
#include <cstdio>
#include <cstdint>
namespace cg = cooperative_groups;

#ifndef MK_MULTI
#define MK_MULTI 0
#endif

#define LAS __attribute__((address_space(3)))
typedef unsigned short bf16_t;
typedef short bf16x8 __attribute__((ext_vector_type(8)));
typedef float f32x4 __attribute__((ext_vector_type(4)));
typedef float f32x2 __attribute__((ext_vector_type(2)));
typedef unsigned u32x4 __attribute__((ext_vector_type(4)));
typedef unsigned u32x2 __attribute__((ext_vector_type(2)));

constexpr int BATCH = 2, SEQ = 16384, DM = 2048, DIN = 6656, MROWS = BATCH * SEQ, NBLK = 64, MEMLEN = 256;
constexpr int C_K = 1024, C_V = 2048, C_GMO = 3072, C_U = 4096, C_VG = 4608, C_GG = 5120, C_QME = 5632, C_GME = 6144;
constexpr float QSCALE = 0.08838834764831845f * 1.4426950408889634f;
constexpr float ALPHA = 1.189207115002721f;
constexpr float LN_EPS = 1e-5f;
constexpr int LIST_PER_BH = 256 * 2080;
constexpr int QCH = 2048;
constexpr int MQCH = 512;

constexpr size_t MiB = 1u << 20;
constexpr size_t WS_CNT = 0;
constexpr size_t WS_BAR = 8192;
constexpr size_t WS_KSUM = 64 * 1024;
constexpr size_t WS_WIN = 1 * MiB;
constexpr size_t WS_WOUT = 28 * MiB;
constexpr size_t WS_WMKV = 36 * MiB;
constexpr size_t WS_WSB = 40 * MiB;
constexpr size_t WS_MEMB = 41 * MiB;
constexpr size_t WS_MKV = 43 * MiB;
constexpr size_t WS_COS = 44 * MiB;
constexpr size_t WS_SIN = 52 * MiB;
constexpr size_t WS_LIST = 60 * MiB;
constexpr size_t WS_PML = 96 * MiB;
constexpr size_t WS_Y = 104 * MiB;
constexpr size_t WS_PROJ = 232 * MiB;
constexpr size_t WS_PO = 648 * MiB;
constexpr size_t WS_SUB = 648 * MiB;
constexpr size_t WS_XB = 648 * MiB;
constexpr size_t WS_END = 904 * MiB;
constexpr int LDS_BYTES = 152 * 1024;
constexpr int BAR_WORDS_N = 3456;

namespace pg8 {
constexpr int BM = 256, BK = 64, HALF = 128, HTB = HALF * BK * 2, STAGE_BYTES = 8 * HTB, NXCD = 8, WGM = 8;
__host__ __device__ __forceinline__ int lds_byte(int r, int c) { const int st = (r >> 4) * 2 + (c >> 5), rr = r & 15, cc = c & 31, ob = rr * 64 + cc * 2; return st * 1024 + (ob ^ (((ob >> 9) & 1) << 5)); }
__host__ __device__ __forceinline__ void stage_rc(int b, int& R, int& C) { const int st = b / 1024, sb = b % 1024, swz = sb ^ (((sb >> 9) & 1) << 5); R = (st >> 1) * 16 + swz / 64; C = (st & 1) * 32 + (swz % 64) / 2; }
__host__ __device__ __forceinline__ int perm32(int rho) { const int n = rho >> 4, i = rho & 15; return 8 * (i >> 2) + 4 * n + (i & 3); }
struct Unit { int pm, pn; };
struct Gemm { const bf16_t* A; const bf16_t* Bt; int M, N, K; };
struct StaticOrder {
    int nM, nN, nwg, G, c;
    __host__ __device__ void init(int M, int N, int G_, int c_) { nM = M / BM; nN = N / BM; nwg = nM * nN; G = G_; c = c_; }
    __host__ __device__ bool next(int i, Unit& u) const {
        const long L = (long)i * G + c; if (L >= nwg) return false;
        int wgid = (int)L; { const int q = nwg / NXCD, r = nwg % NXCD, xcd = wgid % NXCD, off = wgid / NXCD; wgid = (xcd < r ? xcd * (q + 1) : r * (q + 1) + (xcd - r) * q) + off; }
        const int nig = WGM * nN, gid = wgid / nig, fm = gid * WGM, gsz = (nM - fm) < WGM ? (nM - fm) : WGM;
        u.pm = fm + ((wgid % nig) % gsz); u.pn = (wgid % nig) / gsz; return true;
    }
    __device__ __forceinline__ void a_ready(const Unit&) const {}
    __device__ __forceinline__ void done(const Unit&) const {}
};
__device__ __forceinline__ unsigned cvt_pk_bf16(float lo, float hi) { unsigned r; asm volatile("v_cvt_pk_bf16_f32 %0, %1, %2" : "=v"(r) : "v"(lo), "v"(hi)); return r; }

template <class Epi, class Sched, bool ALIGN_EPI = false, bool SP2 = false>
__device__ __forceinline__ void gemm_phase(LAS unsigned char* lds, const Gemm g, const Sched& S, const Epi& E) {
    const int tid = threadIdx.x, wid = __builtin_amdgcn_readfirstlane(tid >> 6), lane = tid & 63, wr = wid >> 2, wc = wid & 3, fr = lane & 15, fq = lane >> 4;
    const int K = g.K, nt = K / BK;
    unsigned voffA[2], voffB[2];
#pragma unroll
    for (int i = 0; i < 2; ++i) { int R, C; stage_rc(tid * 16 + i * 8192, R, C); const int Rb = Epi::PERM ? ((R & ~31) + perm32(R & 31)) : R;
        voffA[i] = (unsigned)(R * K + C) * 2u; voffB[i] = (unsigned)(Rb * K + C) * 2u; }
    const size_t kstep = (size_t)(BK * 2);
    const size_t hstep = (size_t)HALF * K * 2;
    const size_t tstep = 2 * hstep;
    const unsigned ldsw = (unsigned)wid * 1024u;
    const int aoff = lds_byte(wr * 64 + fr, fq * 8), boff = lds_byte(wc * 32 + fr, fq * 8);
#define PG8_SA(b, h) (((b) * 2 + (h)) * HTB)
#define PG8_SB(b, h) ((4 + (b) * 2 + (h)) * HTB)
#define PG8_STAGE(bufoff, gbase, voff) do { _Pragma("unroll") for (int _i = 0; _i < 2; ++_i) \
        __builtin_amdgcn_global_load_lds((const unsigned*)((const char*)(gbase) + (voff)[_i]), (LAS unsigned*)(lds + (bufoff) + ldsw + _i * 8192), 16, 0, 0); } while (0)
#define PG8_LDA(dst, b, h) do { _Pragma("unroll") for (int m = 0; m < 4; ++m) _Pragma("unroll") for (int k = 0; k < 2; ++k) dst[m][k] = *(const LAS bf16x8*)(lds + PG8_SA(b, h) + aoff + m * 2048 + k * 1024); } while (0)
#define PG8_LDB(dst, b, h) do { _Pragma("unroll") for (int n = 0; n < 2; ++n) _Pragma("unroll") for (int k = 0; k < 2; ++k) dst[n][k] = *(const LAS bf16x8*)(lds + PG8_SB(b, h) + boff + n * 2048 + k * 1024); } while (0)
#define PG8_MMA(ai, bj, At, Bt) do { __builtin_amdgcn_s_setprio(1); _Pragma("unroll") for (int m = 0; m < 4; ++m) _Pragma("unroll") for (int n = 0; n < 2; ++n) _Pragma("unroll") for (int k = 0; k < 2; ++k) \
        acc[ai][bj][m][n] = __builtin_amdgcn_mfma_f32_16x16x32_bf16(Bt[n][k], At[m][k], acc[ai][bj][m][n], 0, 0, 0); __builtin_amdgcn_s_setprio(0); } while (0)
#define PG8_WAIT_V(n) asm volatile("s_waitcnt vmcnt(" #n ")" ::: "memory")
#define PG8_WAIT_L(n) asm volatile("s_waitcnt lgkmcnt(" #n ")" ::: "memory")
#define PG8_BAR __builtin_amdgcn_s_barrier()
#define PG8_SCHED __builtin_amdgcn_sched_barrier(0)
    Unit cur, nxt; int ui = 0;
    if (!S.next(0, cur)) return;
    f32x4 acc[2][2][4][2];
#pragma unroll
    for (int a = 0; a < 2; ++a)
#pragma unroll
        for (int b = 0; b < 2; ++b)
#pragma unroll
            for (int m = 0; m < 4; ++m)
#pragma unroll
                for (int n = 0; n < 2; ++n) acc[a][b][m][n] = (f32x4){0.f, 0.f, 0.f, 0.f};
    bf16x8 At[4][2], B0[2][2], B1[2][2];
    const char* cA = (const char*)g.A + (size_t)cur.pm * tstep; const char* cB = (const char*)g.Bt + (size_t)cur.pn * tstep;
    S.a_ready(cur);
    if constexpr (SP2) {
        PG8_STAGE(PG8_SB(0, 0), cB, voffB); PG8_STAGE(PG8_SB(0, 1), cB + hstep, voffB); PG8_STAGE(PG8_SA(0, 0), cA, voffA); PG8_STAGE(PG8_SA(0, 1), cA + hstep, voffA);
        if (wr == 1) PG8_BAR;
        PG8_WAIT_V(2); PG8_BAR;
        PG8_STAGE(PG8_SB(1, 0), cB + kstep, voffB); PG8_STAGE(PG8_SA(1, 0), cA + kstep, voffA); PG8_STAGE(PG8_SB(1, 1), cB + hstep + kstep, voffB);
        PG8_WAIT_V(6); PG8_BAR;
    } else {
        PG8_STAGE(PG8_SB(0, 0), cB, voffB); PG8_STAGE(PG8_SA(0, 0), cA, voffA); PG8_STAGE(PG8_SB(0, 1), cB + hstep, voffB); PG8_STAGE(PG8_SA(0, 1), cA + hstep, voffA);
        if (wr == 1) PG8_BAR;
        PG8_WAIT_V(4); PG8_BAR;
        PG8_STAGE(PG8_SB(1, 0), cB + kstep, voffB); PG8_STAGE(PG8_SA(1, 0), cA + kstep, voffA); PG8_STAGE(PG8_SB(1, 1), cB + hstep + kstep, voffB);
        PG8_WAIT_V(6); PG8_BAR;
    }
    for (;;) {
        const bool has_next = S.next(ui + 1, nxt);
        const char* nA = has_next ? (const char*)g.A + (size_t)nxt.pm * tstep : cA; const char* nB = has_next ? (const char*)g.Bt + (size_t)nxt.pn * tstep : cB;
        for (int t = 0; t < nt; t += 2) {
            const bool last = (t == nt - 2);
            const char* a1 = cA + (size_t)(t + 1) * kstep;
            const char* a2 = last ? nA : cA + (size_t)(t + 2) * kstep; const char* b2 = last ? nB : cB + (size_t)(t + 2) * kstep;
            const char* a3 = a2 + kstep; const char* b3 = b2 + kstep;
            if (last && has_next) S.a_ready(nxt);
            if constexpr (SP2) {
            PG8_LDB(B0, 0, 0); PG8_LDB(B1, 0, 1); PG8_SCHED; PG8_LDA(At, 0, 0); PG8_STAGE(PG8_SA(1, 1), a1 + hstep, voffA);
            PG8_WAIT_V(8); PG8_WAIT_L(0); PG8_BAR; PG8_MMA(0, 0, At, B0); PG8_MMA(0, 1, At, B1); PG8_BAR; PG8_SCHED;
            PG8_LDA(At, 0, 1); PG8_STAGE(PG8_SB(0, 0), b2, voffB); PG8_STAGE(PG8_SB(0, 1), b2 + hstep, voffB); PG8_STAGE(PG8_SA(0, 0), a2, voffA);
            PG8_WAIT_V(8); PG8_WAIT_L(0); PG8_BAR; PG8_MMA(1, 0, At, B0); PG8_MMA(1, 1, At, B1); PG8_BAR; PG8_SCHED;
            PG8_LDB(B0, 1, 0); PG8_LDB(B1, 1, 1); PG8_SCHED; PG8_LDA(At, 1, 0); PG8_STAGE(PG8_SA(0, 1), a2 + hstep, voffA);
            PG8_WAIT_V(8); PG8_WAIT_L(0); PG8_BAR; PG8_MMA(0, 0, At, B0); PG8_MMA(0, 1, At, B1); PG8_BAR; PG8_SCHED;
            PG8_LDA(At, 1, 1); PG8_STAGE(PG8_SB(1, 0), b3, voffB); PG8_STAGE(PG8_SB(1, 1), b3 + hstep, voffB); PG8_STAGE(PG8_SA(1, 0), a3, voffA);
            PG8_WAIT_V(8); PG8_WAIT_L(0); PG8_BAR; PG8_MMA(1, 0, At, B0); PG8_MMA(1, 1, At, B1); PG8_BAR; PG8_SCHED;
            } else {
            PG8_LDB(B0, 0, 0); PG8_SCHED; PG8_LDA(At, 0, 0); PG8_STAGE(PG8_SA(1, 1), a1 + hstep, voffA);
            PG8_WAIT_L(8); PG8_BAR; PG8_WAIT_L(0); PG8_MMA(0, 0, At, B0); PG8_BAR; PG8_SCHED;
            PG8_LDB(B1, 0, 1); PG8_STAGE(PG8_SB(0, 0), b2, voffB);
            PG8_BAR; PG8_WAIT_L(0); PG8_MMA(0, 1, At, B1); PG8_BAR;
            PG8_LDA(At, 0, 1); PG8_STAGE(PG8_SA(0, 0), a2, voffA);
            PG8_BAR; PG8_WAIT_L(0); PG8_MMA(1, 0, At, B0); PG8_BAR; PG8_SCHED;
            PG8_STAGE(PG8_SB(0, 1), b2 + hstep, voffB);
            PG8_WAIT_V(6); PG8_BAR; PG8_MMA(1, 1, At, B1); PG8_BAR;
            PG8_LDB(B0, 1, 0); PG8_SCHED; PG8_LDA(At, 1, 0); PG8_STAGE(PG8_SA(0, 1), a2 + hstep, voffA);
            PG8_WAIT_L(8); PG8_BAR; PG8_WAIT_L(0); PG8_MMA(0, 0, At, B0); PG8_BAR; PG8_SCHED;
            PG8_LDB(B1, 1, 1); PG8_STAGE(PG8_SB(1, 0), b3, voffB);
            PG8_BAR; PG8_WAIT_L(0); PG8_MMA(0, 1, At, B1); PG8_BAR;
            PG8_LDA(At, 1, 1); PG8_STAGE(PG8_SA(1, 0), a3, voffA);
            PG8_BAR; PG8_WAIT_L(0); PG8_MMA(1, 0, At, B0); PG8_BAR; PG8_SCHED;
            PG8_STAGE(PG8_SB(1, 1), b3 + hstep, voffB);
            PG8_WAIT_V(6); PG8_BAR; PG8_MMA(1, 1, At, B1); PG8_BAR;
            }
        }
        if constexpr (ALIGN_EPI) { if (wr == 0) PG8_BAR; }
        E(acc, cur, wr, wc, fr, fq); S.done(cur);
        if (!has_next) break;
#pragma unroll
        for (int a = 0; a < 2; ++a)
#pragma unroll
            for (int b = 0; b < 2; ++b)
#pragma unroll
                for (int m = 0; m < 4; ++m)
#pragma unroll
                    for (int n = 0; n < 2; ++n) acc[a][b][m][n] = (f32x4){0.f, 0.f, 0.f, 0.f};
        cur = nxt; cA = nA; cB = nB; ++ui;
        if constexpr (ALIGN_EPI) { if (wr == 1) PG8_BAR; }
    }
    PG8_WAIT_V(0);
    if constexpr (!ALIGN_EPI) { if (wr == 0) PG8_BAR; }
    PG8_BAR;
#undef PG8_SA
#undef PG8_SB
#undef PG8_STAGE
#undef PG8_LDA
#undef PG8_LDB
#undef PG8_MMA
#undef PG8_WAIT_V
#undef PG8_WAIT_L
#undef PG8_BAR
#undef PG8_SCHED
}
}

using pg8::cvt_pk_bf16;
__device__ __forceinline__ float bf2f(unsigned short b) { return __builtin_bit_cast(float, (unsigned)b << 16); }
__device__ __forceinline__ float bflo(unsigned w) { return __builtin_bit_cast(float, w << 16); }
__device__ __forceinline__ float bfhi(unsigned w) { return __builtin_bit_cast(float, w & 0xffff0000u); }
__device__ __forceinline__ float fast_exp2(float x) { return __builtin_amdgcn_exp2f(x); }
__device__ __forceinline__ float fast_rcp(float x) { return __builtin_amdgcn_rcpf(x); }
__device__ __forceinline__ float silu_f(float x) { return x * fast_rcp(1.f + fast_exp2(-1.4426950408889634f * x)); }
__device__ __forceinline__ float gelu_tanh_f(float x) {
    const float t = x * (1.f + 0.044715f * x * x) * (-1.5957691216057308f * 1.4426950408889634f);
    return x * fast_rcp(1.f + fast_exp2(t));
}
#define LDS_WAIT() asm volatile("s_waitcnt lgkmcnt(0)" ::: "memory")

struct EpiProj {
    static constexpr bool PERM = true;
    bf16_t* O; const float* cosT; const float* sinT; float* ksum;
    __device__ __forceinline__ void operator()(const f32x4 (&acc)[2][2][4][2], const pg8::Unit& u, int wr, int wc, int fr, int fq) const {
        const int pn = u.pn;
        const int type = pn < 4 ? 0 : pn < 8 ? 1 : pn < 12 ? 2 : pn < 16 ? 3 : pn < 20 ? 4 : pn < 22 ? 3 : pn < 24 ? 5 : 3;
        const int row0 = u.pm * 256 + wr * 64 + fr;
        const int col0 = pn * 256 + wc * 32 + 8 * fq;
        float cs[2][8];
#pragma unroll
        for (int bj = 0; bj < 2; ++bj)
#pragma unroll
            for (int e = 0; e < 8; ++e) cs[bj][e] = 0.f;
#pragma unroll
        for (int ai = 0; ai < 2; ++ai) {
            f32x4 c4v[4], s4v[4];
#pragma unroll
            for (int m = 0; m < 4; ++m) { c4v[m] = (f32x4){1.f, 1.f, 1.f, 1.f}; s4v[m] = (f32x4){0.f, 0.f, 0.f, 0.f}; }
            if (type <= 1) {
#pragma unroll
                for (int m = 0; m < 4; ++m) { const size_t ro = (size_t)(row0 + ai * 128 + m * 16) * 64 + 16 * wc + 4 * fq; c4v[m] = *(const f32x4*)(cosT + ro); s4v[m] = *(const f32x4*)(sinT + ro); }
            }
            __builtin_amdgcn_sched_barrier(0);
#pragma unroll
            for (int m = 0; m < 4; ++m) {
                const int row = row0 + ai * 128 + m * 16;
                const f32x4 c4 = c4v[m], s4 = s4v[m];
                bf16_t* rowp = O + (size_t)row * DIN + col0;
#pragma unroll
                for (int bj = 0; bj < 2; ++bj) {
                    f32x4 v0 = acc[ai][bj][m][0], v1 = acc[ai][bj][m][1];
                    float o[8];
                    if (type <= 1) {
                        o[0] = v0[0] * c4[0] - v0[1] * s4[0]; o[1] = v0[1] * c4[0] + v0[0] * s4[0];
                        o[2] = v0[2] * c4[1] - v0[3] * s4[1]; o[3] = v0[3] * c4[1] + v0[2] * s4[1];
                        o[4] = v1[0] * c4[2] - v1[1] * s4[2]; o[5] = v1[1] * c4[2] + v1[0] * s4[2];
                        o[6] = v1[2] * c4[3] - v1[3] * s4[3]; o[7] = v1[3] * c4[3] + v1[2] * s4[3];
                        if (type == 0) {
#pragma unroll
                            for (int e = 0; e < 8; ++e) o[e] *= QSCALE;
                        } else {
#pragma unroll
                            for (int e = 0; e < 8; ++e) cs[bj][e] += o[e];
                        }
                    } else {
#pragma unroll
                        for (int e = 0; e < 4; ++e) { o[e] = v0[e]; o[4 + e] = v1[e]; }
                        if (type == 3) {
#pragma unroll
                            for (int e = 0; e < 8; ++e) o[e] = silu_f(o[e]);
                        } else if (type == 4) {
#pragma unroll
                            for (int e = 0; e < 8; ++e) o[e] = gelu_tanh_f(o[e]);
                        } else if (type == 5) {
#pragma unroll
                            for (int e = 0; e < 8; ++e) o[e] *= QSCALE;
                        }
                    }
                    u32x4 w; w.x = cvt_pk_bf16(o[0], o[1]); w.y = cvt_pk_bf16(o[2], o[3]); w.z = cvt_pk_bf16(o[4], o[5]); w.w = cvt_pk_bf16(o[6], o[7]);
                    __builtin_nontemporal_store(w, (u32x4*)(rowp + bj * 128));
                }
            }
            __builtin_amdgcn_sched_barrier(0);
        }
        if (type == 1) {
#pragma unroll
            for (int bj = 0; bj < 2; ++bj)
#pragma unroll
                for (int e = 0; e < 8; ++e) {
                    float v = cs[bj][e];
                    v += __shfl_xor(v, 1); v += __shfl_xor(v, 2); v += __shfl_xor(v, 4); v += __shfl_xor(v, 8);
                    cs[bj][e] = v;
                }
            if (fr == 0) {
                float* kp = ksum + (size_t)u.pm * 1024 + (pn - 4) * 256 + wc * 32 + 8 * fq;
#pragma unroll
                for (int bj = 0; bj < 2; ++bj)
#pragma unroll
                    for (int e = 0; e < 8; ++e) atomicAdd(kp + bj * 128 + e, cs[bj][e]);
            }
        }
    }
};
struct EpiPlain {
    static constexpr bool PERM = true;
    bf16_t* O; int ldc;
    __device__ __forceinline__ void operator()(const f32x4 (&acc)[2][2][4][2], const pg8::Unit& u, int wr, int wc, int fr, int fq) const {
        const int row0 = u.pm * 256 + wr * 64 + fr, col0 = u.pn * 256 + wc * 32 + 8 * fq;
#pragma unroll
        for (int ai = 0; ai < 2; ++ai)
#pragma unroll
            for (int m = 0; m < 4; ++m) { bf16_t* rowp = O + (size_t)(row0 + ai * 128 + m * 16) * ldc + col0;
#pragma unroll
                for (int bj = 0; bj < 2; ++bj) { const f32x4 v0 = acc[ai][bj][m][0], v1 = acc[ai][bj][m][1];
                    u32x4 w; w.x = cvt_pk_bf16(v0[0], v0[1]); w.y = cvt_pk_bf16(v0[2], v0[3]); w.z = cvt_pk_bf16(v1[0], v1[1]); w.w = cvt_pk_bf16(v1[2], v1[3]);
                    *(u32x4*)(rowp + bj * 128) = w; } }
    }
};
struct EpiResid {
    static constexpr bool PERM = true;
    const float* __restrict__ x; float* __restrict__ out;
    __device__ __forceinline__ void operator()(const f32x4 (&acc)[2][2][4][2], const pg8::Unit& u, int wr, int wc, int fr, int fq) const {
        const int row0 = u.pm * 256 + wr * 64 + fr, col0 = u.pn * 256 + wc * 32 + 8 * fq;
#pragma unroll
        for (int ai = 0; ai < 2; ++ai) {
            f32x4 xv[4][2][2];
#pragma unroll
            for (int m = 0; m < 4; ++m) { const size_t off = (size_t)(row0 + ai * 128 + m * 16) * DM + col0;
#pragma unroll
                for (int bj = 0; bj < 2; ++bj)
#pragma unroll
                    for (int n = 0; n < 2; ++n) xv[m][bj][n] = *(const f32x4*)(x + off + bj * 128 + 4 * n); }
            __builtin_amdgcn_sched_barrier(0);
#pragma unroll
            for (int m = 0; m < 4; ++m) { const size_t off = (size_t)(row0 + ai * 128 + m * 16) * DM + col0;
#pragma unroll
                for (int bj = 0; bj < 2; ++bj)
#pragma unroll
                    for (int n = 0; n < 2; ++n) *(f32x4*)(out + off + bj * 128 + 4 * n) = xv[m][bj][n] * ALPHA + acc[ai][bj][m][n]; }
            __builtin_amdgcn_sched_barrier(0);
        }
    }
};

struct Args { const float* x; const float* mem; const int* pos; const float* w_in; const float* w_mkv; const float* gln_g; const float* gln_b;
              const float* w_s; const float* b_s; const float* w_out; const float* ln_g; const float* ln_b; float* out; unsigned char* ws; int ph_lo, ph_hi; };

__device__ __forceinline__ void p0_transpose_item(const float* W, int K, int N, bf16_t* WT, bool permute_qk, LAS float* scr, int item, int lane) {
    const int nblk = N / 32, kb = item / nblk, nb = item % nblk, k0 = 64 * kb, n0 = 32 * nb;
    const int ncol = n0 + (lane & 31);
    int src = ncol;
    if (permute_qk && ncol < 2048) { const int p = ncol & 127; src = (ncol & ~127) + ((p & 1) << 6) + (p >> 1); }
#pragma unroll 8
    for (int i = 0; i < 32; ++i) { const int kk = 2 * i + (lane >> 5); scr[kk * 33 + (lane & 31)] = W[(size_t)(k0 + kk) * N + src]; }
    LDS_WAIT();
    const int c = lane & 7;
#pragma unroll
    for (int j = 0; j < 4; ++j) { const int n = (lane >> 3) + 8 * j; const LAS float* s = scr + (8 * c) * 33 + n;
        u32x4 o; o.x = cvt_pk_bf16(s[0 * 33], s[1 * 33]); o.y = cvt_pk_bf16(s[2 * 33], s[3 * 33]); o.z = cvt_pk_bf16(s[4 * 33], s[5 * 33]); o.w = cvt_pk_bf16(s[6 * 33], s[7 * 33]);
        *(u32x4*)(WT + (size_t)(n0 + n) * K + k0 + 8 * c) = o; }
    LDS_WAIT();
}

__device__ __forceinline__ void phase0(const Args& a, LAS unsigned char* lds) {
    unsigned char* ws = a.ws;
    const int tid = threadIdx.x, lane = tid & 63, wave = tid >> 6;
    const int G = gridDim.x;
    const size_t gtid = (size_t)blockIdx.x * 512 + tid, NT = (size_t)G * 512;
    { int* cnt = (int*)(ws + WS_CNT); for (size_t i = gtid; i < 1088; i += NT) cnt[i] = 0;
      float* ks = (float*)(ws + WS_KSUM); for (size_t i = gtid; i < 128 * 1024; i += NT) ks[i] = 0.f; }
    { LAS float* scr = (LAS float*)(lds + wave * 16384);
      const int gw = blockIdx.x * 8 + wave, NGW = G * 8;
      constexpr int I_IN = (DM / 64) * (DIN / 32), I_OUT = (DM / 64) * (DM / 32), I_MKV = (DM / 64) * (1024 / 32);
      for (int it = gw; it < I_IN + I_OUT + I_MKV; it += NGW) {
          int r = it;
          if (r < I_IN) { p0_transpose_item(a.w_in, DM, DIN, (bf16_t*)(ws + WS_WIN), true, scr, r, lane); continue; } r -= I_IN;
          if (r < I_OUT) { p0_transpose_item(a.w_out, DM, DM, (bf16_t*)(ws + WS_WOUT), false, scr, r, lane); continue; } r -= I_OUT;
          p0_transpose_item(a.w_mkv, DM, 1024, (bf16_t*)(ws + WS_WMKV), false, scr, r, lane);
      } }
    { const size_t n8 = (size_t)MROWS * DM / 8; u32x4* xb = (u32x4*)(ws + WS_XB);
      for (size_t i0 = gtid; i0 < n8; i0 += 4 * NT) {
          f32x4 v[4][2];
#pragma unroll
          for (int j = 0; j < 4; ++j) { const size_t i = i0 + j * NT; if (i < n8) { v[j][0] = __builtin_nontemporal_load((const f32x4*)a.x + 2 * i); v[j][1] = __builtin_nontemporal_load((const f32x4*)a.x + 2 * i + 1); } }
          __builtin_amdgcn_sched_barrier(0);
#pragma unroll
          for (int j = 0; j < 4; ++j) { const size_t i = i0 + j * NT; if (i < n8) { const f32x4 v0 = v[j][0], v1 = v[j][1];
              u32x4 o; o.x = cvt_pk_bf16(v0[0], v0[1]); o.y = cvt_pk_bf16(v0[2], v0[3]); o.z = cvt_pk_bf16(v1[0], v1[1]); o.w = cvt_pk_bf16(v1[2], v1[3]); xb[i] = o; } }
          __builtin_amdgcn_sched_barrier(0);
      }
      const size_t m8 = (size_t)BATCH * MEMLEN * DM / 8; u32x4* mb = (u32x4*)(ws + WS_MEMB);
      for (size_t i = gtid; i < m8; i += NT) { const f32x4 v0 = ((const f32x4*)a.mem)[2 * i], v1 = ((const f32x4*)a.mem)[2 * i + 1];
          u32x4 o; o.x = cvt_pk_bf16(v0[0], v0[1]); o.y = cvt_pk_bf16(v0[2], v0[3]); o.z = cvt_pk_bf16(v1[0], v1[1]); o.w = cvt_pk_bf16(v1[2], v1[3]); mb[i] = o; } }
    { bf16_t* wsb = (bf16_t*)(ws + WS_WSB);
      for (size_t i = gtid; i < 4 * 128 * 128; i += NT) { const int t = (int)(i >> 7) & 127, s = (int)i & 127; const float v = s <= t ? a.w_s[i] : 0.f; wsb[i] = (bf16_t)(cvt_pk_bf16(v, 0.f) & 0xffffu); } }
    { float* cT = (float*)(ws + WS_COS); float* sT = (float*)(ws + WS_SIN);
      LAS float* invf = (LAS float*)(lds + 8 * 16384);
      if (tid < 64) invf[tid] = (float)exp2(-(double)tid * (13.287712379549449 / 64.0));
      __syncthreads();
      for (size_t e = gtid; e < (size_t)MROWS * 64; e += NT) { const int row = (int)(e >> 6), i = (int)e & 63;
          const float inv = invf[i];
          const float ang = (float)a.pos[row] * inv;
          const double rev = (double)ang * 0.15915494309189535; const float fr = (float)(rev - rint(rev));
          cT[e] = __builtin_amdgcn_cosf(fr); sT[e] = __builtin_amdgcn_sinf(fr); } }
}

__device__ __forceinline__ int list_base(int n) { return 256 * (64 * n - (n * (n - 1)) / 2); }
__device__ __forceinline__ unsigned long long shfl_xor_u64(unsigned long long v, int m) {
    unsigned lo = (unsigned)v, hi = (unsigned)(v >> 32); lo = __shfl_xor(lo, m); hi = __shfl_xor(hi, m); return ((unsigned long long)hi << 32) | lo; }

__device__ __forceinline__ void phase2(const Args& a, LAS unsigned char* lds) {
    unsigned char* ws = a.ws;
    const int tid = threadIdx.x, lane = tid & 63, wave = __builtin_amdgcn_readfirstlane(tid >> 6), fr = lane & 15, fq = lane >> 4;
    const bf16_t* proj = (const bf16_t*)(ws + WS_PROJ);
    const float* ksum = (const float*)(ws + WS_KSUM);
    int* cnt = (int*)(ws + WS_CNT);
    unsigned* list = (unsigned*)(ws + WS_LIST);
    LAS unsigned char* Kl = lds;
    LAS int* lcnt = (LAS int*)(lds + 16384);
    LAS int* gbase = (LAS int*)(lds + 16384 + 256);
    { const bf16_t* memb = (const bf16_t*)(ws + WS_MEMB); const bf16_t* wt = (const bf16_t*)(ws + WS_WMKV); bf16_t* mkv = (bf16_t*)(ws + WS_MKV);
      for (int t = blockIdx.x; t < 256; t += gridDim.x) {
          const int m0 = (t & 15) * 32 + 16 * (wave & 1), n0 = (t >> 4) * 64 + 16 * (wave >> 1);
          const bf16_t* ap = wt + (size_t)(n0 + fr) * DM + 8 * fq; const bf16_t* bp = memb + (size_t)(m0 + fr) * DM + 8 * fq;
          f32x4 acc = (f32x4){0.f, 0.f, 0.f, 0.f};
          bf16x8 av[8], bv[8], an[8], bn[8];
#pragma unroll
          for (int i = 0; i < 8; ++i) { av[i] = *(const bf16x8*)(ap + 32 * i); bv[i] = *(const bf16x8*)(bp + 32 * i); }
#pragma unroll 1
          for (int kb = 0; kb < 8; ++kb) {
              const int kn = kb < 7 ? kb + 1 : kb;
#pragma unroll
              for (int i = 0; i < 8; ++i) { an[i] = *(const bf16x8*)(ap + 32 * (8 * kn + i)); bn[i] = *(const bf16x8*)(bp + 32 * (8 * kn + i)); }
              __builtin_amdgcn_sched_barrier(0);
#pragma unroll
              for (int i = 0; i < 8; ++i) acc = __builtin_amdgcn_mfma_f32_16x16x32_bf16(av[i], bv[i], acc, 0, 0, 0);
              __builtin_amdgcn_sched_barrier(0);
#pragma unroll
              for (int i = 0; i < 8; ++i) { av[i] = an[i]; bv[i] = bn[i]; }
          }
          u32x2 w; w.x = cvt_pk_bf16(acc[0], acc[1]); w.y = cvt_pk_bf16(acc[2], acc[3]);
          *(u32x2*)(mkv + (size_t)(m0 + fr) * 1024 + n0 + 4 * fq) = w; } }
    LAS int* pend_n = (LAS int*)(lds + 18432);
    LAS int* pend_lp = (LAS int*)(lds + 18432 + 16384);
    LAS int* lcnt4 = (LAS int*)(lds + 16384);
    LAS int* gbase4 = (LAS int*)(lds + 16384 + 1024);
    for (int grp = blockIdx.x; grp < 256; grp += gridDim.x) {
        const int bh = grp >> 4, qb0 = (grp & 15) * 4, b = bh >> 3, h = bh & 7;
        { const int n = tid >> 3, c2 = tid & 7; const float* kp = ksum + (size_t)(b * 64 + n) * 1024 + h * 128 + c2 * 16;
          const f32x4 v0 = *(const f32x4*)kp, v1 = *(const f32x4*)(kp + 4), v2 = *(const f32x4*)(kp + 8), v3 = *(const f32x4*)(kp + 12);
          u32x4 w0, w1; w0.x = cvt_pk_bf16(v0[0], v0[1]); w0.y = cvt_pk_bf16(v0[2], v0[3]); w0.z = cvt_pk_bf16(v1[0], v1[1]); w0.w = cvt_pk_bf16(v1[2], v1[3]);
          w1.x = cvt_pk_bf16(v2[0], v2[1]); w1.y = cvt_pk_bf16(v2[2], v2[3]); w1.z = cvt_pk_bf16(v3[0], v3[1]); w1.w = cvt_pk_bf16(v3[2], v3[3]);
          *(LAS u32x4*)(Kl + n * 256 + (((2 * c2) ^ (n & 15)) << 4)) = w0; *(LAS u32x4*)(Kl + n * 256 + (((2 * c2 + 1) ^ (n & 15)) << 4)) = w1;
          if (tid < 256) lcnt4[tid] = 0; }
        const bf16_t* qbase = proj + (size_t)(b * SEQ + wave * 32 + fr) * DIN + h * 128 + 8 * fq;
        bf16x8 qcur[2][4];
#pragma unroll
        for (int tt = 0; tt < 2; ++tt)
#pragma unroll
            for (int k = 0; k < 4; ++k) qcur[tt][k] = *(const bf16x8*)(qbase + (size_t)(qb0 * 256 + tt * 16) * DIN + 32 * k);
        __syncthreads();
#pragma unroll 1
        for (int kk = 0; kk < 4; ++kk) {
            const int qb = qb0 + kk;
            bf16x8 qnxt[2][4];
            { const int qbn = kk < 3 ? qb + 1 : qb;
#pragma unroll
              for (int tt = 0; tt < 2; ++tt)
#pragma unroll
                  for (int k = 0; k < 4; ++k) qnxt[tt][k] = *(const bf16x8*)(qbase + (size_t)(qbn * 256 + tt * 16) * DIN + 32 * k); }
#pragma unroll
            for (int tt = 0; tt < 2; ++tt) {
                unsigned long long best0 = 0ull, best1 = 0ull, best2 = 0ull;
#pragma unroll
                for (int nt = 0; nt < 4; ++nt) {
                    if (16 * nt < qb) {
                        f32x4 g = (f32x4){0.f, 0.f, 0.f, 0.f};
#pragma unroll
                        for (int k = 0; k < 4; ++k) { const bf16x8 av = *(const LAS bf16x8*)(Kl + (16 * nt + fr) * 256 + (((4 * k + fq) ^ fr) << 4)); g = __builtin_amdgcn_mfma_f32_16x16x32_bf16(av, qcur[tt][k], g, 0, 0, 0); }
#pragma unroll
                        for (int j = 0; j < 4; ++j) { const int n = 16 * nt + 4 * fq + j;
                            const float gj = j == 0 ? g.x : j == 1 ? g.y : j == 2 ? g.z : g.w; const unsigned bits = __float_as_uint(gj); const unsigned ord = (bits & 0x80000000u) ? ~bits : (bits | 0x80000000u);
                            unsigned long long key = n < qb ? (((unsigned long long)ord << 32) | (unsigned)(63 - n)) : 0ull;
                            if (key > best0) { const unsigned long long t = best0; best0 = key; key = t; }
                            if (key > best1) { const unsigned long long t = best1; best1 = key; key = t; }
                            if (key > best2) { best2 = key; } }
                    }
                }
                int ptr = 0; int myn = -1;
#pragma unroll
                for (int r = 0; r < 3; ++r) {
                    const unsigned long long cand = ptr == 0 ? best0 : ptr == 1 ? best1 : ptr == 2 ? best2 : 0ull;
                    unsigned long long g = cand; { const unsigned long long o = shfl_xor_u64(g, 16); g = o > g ? o : g; } { const unsigned long long o = shfl_xor_u64(g, 32); g = o > g ? o : g; }
                    if (g != 0ull && cand == g) ++ptr;
                    if (fq == r && g != 0ull) myn = 63 - (int)(unsigned)(g & 0xffffffffull);
                }
                if (fq == 3) myn = qb;
                int lp = 0;
                if (myn >= 0) lp = __hip_atomic_fetch_add(lcnt4 + kk * 64 + myn, 1, __ATOMIC_RELAXED, __HIP_MEMORY_SCOPE_WORKGROUP);
                pend_n[(kk * 2 + tt) * 512 + tid] = myn; pend_lp[(kk * 2 + tt) * 512 + tid] = lp;
            }
#pragma unroll
            for (int tt = 0; tt < 2; ++tt)
#pragma unroll
                for (int k = 0; k < 4; ++k) qcur[tt][k] = qnxt[tt][k];
        }
        __syncthreads();
        if (tid < 256) { const int c = lcnt4[tid]; gbase4[tid] = c ? atomicAdd(cnt + bh * 64 + (tid & 63), c) : 0; }
        __syncthreads();
#pragma unroll 1
        for (int e = 0; e < 8; ++e) { const int kk = e >> 1, tt = e & 1; const int myn = pend_n[e * 512 + tid];
            if (myn >= 0) { const int s = (qb0 + kk) * 256 + (wave * 2 + tt) * 16 + fr;
                list[(size_t)bh * LIST_PER_BH + list_base(myn) + gbase4[kk * 64 + myn] + pend_lp[e * 512 + tid]] = (unsigned)s | ((unsigned)fq << 14); } }
        __syncthreads();
    }
}

__device__ __forceinline__ float sq8(u32x4 v) {
    const float a = bflo(v.x), b = bfhi(v.x), c = bflo(v.y), d = bfhi(v.y), e = bflo(v.z), f = bfhi(v.z), g = bflo(v.w), h = bfhi(v.w);
    return ((a * a + b * b) + (c * c + d * d)) + ((e * e + f * f) + (g * g + h * h)); }
__device__ __forceinline__ void stage_kv(LAS unsigned char* Kl, LAS unsigned char* Vl, const bf16_t* Kg, const bf16_t* Vg, int stride, int tid, LAS float* kmx) {
    float nmax = 0.f;
#pragma unroll
    for (int it = 0; it < 8; ++it) { const int q = tid + 512 * it, c = q & 15, r = q >> 4;
        const u32x4 v = *(const u32x4*)(Kg + (size_t)r * stride + 8 * c);
        *(LAS u32x4*)(Kl + r * 256 + ((c ^ (r & 15)) << 4)) = v;
        float n2 = sq8(v); n2 += __shfl_xor(n2, 1); n2 += __shfl_xor(n2, 2); n2 += __shfl_xor(n2, 4); n2 += __shfl_xor(n2, 8);
        nmax = fmaxf(nmax, n2); }
    nmax = fmaxf(nmax, __shfl_xor(nmax, 16)); nmax = fmaxf(nmax, __shfl_xor(nmax, 32));
    if ((tid & 63) == 0) kmx[tid >> 6] = nmax;
#pragma unroll
    for (int it = 0; it < 4; ++it) { const int q = tid + 512 * it, c = q & 15, kp = q >> 4, kq = 2 * kp;
        const int key = (kq & 0xE0) | (((kq >> 2) & 1) << 4) | (((kq >> 3) & 3) << 2) | (kq & 3);
        const u32x4 v0 = *(const u32x4*)(Vg + (size_t)key * stride + 8 * c), v1 = *(const u32x4*)(Vg + (size_t)(key + 1) * stride + 8 * c);
        const unsigned a0[4] = {v0.x, v0.y, v0.z, v0.w}, a1[4] = {v1.x, v1.y, v1.z, v1.w};
#pragma unroll
        for (int i = 0; i < 8; ++i) { const int d = 8 * c + i;
            const unsigned lo = (i & 1) ? (a0[i >> 1] >> 16) : (a0[i >> 1] & 0xffffu), hi = (i & 1) ? (a1[i >> 1] & 0xffff0000u) : (a1[i >> 1] << 16);
            *(LAS unsigned*)(Vl + d * 512 + ((((kq >> 3)) ^ (d & 15)) << 4) + (kq & 7) * 2) = lo | hi; } }
}
__device__ __forceinline__ float kmax_of(const LAS float* kmx) {
    float m = kmx[0];
#pragma unroll
    for (int i = 1; i < 8; ++i) m = fmaxf(m, kmx[i]);
    return sqrtf(m) * 1.002f; }

__device__ __forceinline__ float qnorm(const bf16x8 (&qf)[4]) {
    float qq = 0.f;
#pragma unroll
    for (int k = 0; k < 4; ++k) qq += sq8(__builtin_bit_cast(u32x4, qf[k]));
    qq += __shfl_xor(qq, 16); qq += __shfl_xor(qq, 32);
    return sqrtf(qq); }
#define AT_SCHED() __builtin_amdgcn_sched_barrier(0)
#define AT_LOADK(S) do { _Pragma("unroll") for (int k = 0; k < 4; ++k) { kf[2 * k] = *(const LAS bf16x8*)(Kl + kb[k] + (S) * 8192); kf[2 * k + 1] = *(const LAS bf16x8*)(Kl + kb[k] + (S) * 8192 + 4096); } } while (0)
#define AT_LOADV(S) do { const unsigned vb = (unsigned)fr * 512u + ((unsigned)((4 * (S) + fq) ^ fr) << 4); _Pragma("unroll") for (int dt = 0; dt < 8; ++dt) vf[dt] = *(const LAS bf16x8*)(Vl + vb + dt * 8192); } while (0)
__device__ __forceinline__ void attn_core(const LAS unsigned char* Kl, const LAS unsigned char* Vl, const bf16x8 (&qf)[4], int fr, int fq, bool do_mask, int qrel, int smax, float kmax,
                                          f32x4 (&oacc)[8], float& m_out, float& l_out) {
    asm volatile("" : "+v"(fr), "+v"(fq));
    unsigned kb[4];
#pragma unroll
    for (int k = 0; k < 4; ++k) kb[k] = (unsigned)fr * 256u + ((unsigned)((4 * k + fq) ^ fr) << 4);
    bf16x8 kf[8], vf[8];
    AT_LOADK(0); AT_LOADV(0);
    const float m = kmax;
    float l = 0.f;
#pragma unroll
    for (int dt = 0; dt < 8; ++dt) oacc[dt] = (f32x4){0.f, 0.f, 0.f, 0.f};
    f32x4 c0 = (f32x4){-m, -m, -m, -m}, c1 = c0;
    AT_SCHED();
#pragma unroll
    for (int k = 0; k < 4; ++k) { c0 = __builtin_amdgcn_mfma_f32_16x16x32_bf16(kf[2 * k], qf[k], c0, 0, 0, 0); c1 = __builtin_amdgcn_mfma_f32_16x16x32_bf16(kf[2 * k + 1], qf[k], c1, 0, 0, 0); }
    AT_SCHED();
    if (1 < smax) AT_LOADK(1);
#pragma unroll
    for (int s = 0; s < 8; ++s) {
        if (s < smax) {
            AT_SCHED();
            f32x4 n0 = (f32x4){-m, -m, -m, -m}, n1 = n0;
            if (s + 1 < smax) {
#pragma unroll
                for (int k = 0; k < 4; ++k) { n0 = __builtin_amdgcn_mfma_f32_16x16x32_bf16(kf[2 * k], qf[k], n0, 0, 0, 0); n1 = __builtin_amdgcn_mfma_f32_16x16x32_bf16(kf[2 * k + 1], qf[k], n1, 0, 0, 0); }
            }
            AT_SCHED();
            if (s + 2 < smax) AT_LOADK(s + 2);
            AT_SCHED();
            float p[8] = {c0.x, c0.y, c0.z, c0.w, c1.x, c1.y, c1.z, c1.w};
            if (do_mask) {
#pragma unroll
                for (int j = 0; j < 4; ++j) { if (32 * s + 4 * fq + j > qrel) p[j] = -INFINITY; if (32 * s + 16 + 4 * fq + j > qrel) p[4 + j] = -INFINITY; }
            }
#pragma unroll
            for (int j = 0; j < 8; ++j) p[j] = fast_exp2(p[j]);
            l += ((p[0] + p[1]) + (p[2] + p[3])) + ((p[4] + p[5]) + (p[6] + p[7]));
            u32x4 w; w.x = cvt_pk_bf16(p[0], p[1]); w.y = cvt_pk_bf16(p[2], p[3]); w.z = cvt_pk_bf16(p[4], p[5]); w.w = cvt_pk_bf16(p[6], p[7]);
            const bf16x8 pb = __builtin_bit_cast(bf16x8, w);
            AT_SCHED();
#pragma unroll
            for (int dt = 0; dt < 8; ++dt) oacc[dt] = __builtin_amdgcn_mfma_f32_16x16x32_bf16(vf[dt], pb, oacc[dt], 0, 0, 0);
            AT_SCHED();
            if (s + 1 < smax) AT_LOADV(s + 1);
            c0 = n0; c1 = n1;
        }
    }
    AT_SCHED();
    l += __shfl_xor(l, 16); l += __shfl_xor(l, 32);
    m_out = m; l_out = l;
}

__device__ __forceinline__ void phase3(const Args& a, LAS unsigned char* lds) {
    unsigned char* ws = a.ws;
    const int tid = threadIdx.x, lane = tid & 63, wave = __builtin_amdgcn_readfirstlane(tid >> 6), fr = lane & 15, fq = lane >> 4;
    const int fr_ = fr, fq_ = fq, lane_ = lane, tid_ = tid;
    const bf16_t* proj = (const bf16_t*)(ws + WS_PROJ);
    const int* cnt = (const int*)(ws + WS_CNT);
    const unsigned* list = (const unsigned*)(ws + WS_LIST);
    bf16_t* PO = (bf16_t*)(ws + WS_PO); f32x2* PML = (f32x2*)(ws + WS_PML);
    bf16_t* Y = (bf16_t*)(ws + WS_Y);
    LAS unsigned char* Kl = lds; LAS unsigned char* Vl = lds + 65536;
    LAS int* pre = (LAS int*)(lds + 131072);
    LAS float* kmx = (LAS float*)(lds + 131072 + 12288);
    LAS int* prp = (LAS int*)(lds + 131072 + 4352);
    LAS int* nxt = (LAS int*)(lds + 131072 + 12288 + 64);
    if (wave == 0) {
        int locf[16], locp[16]; int sumf = 0, sump = 0;
#pragma unroll
        for (int i = 0; i < 16; ++i) { const int c = cnt[lane * 16 + i]; locf[i] = c / QCH; locp[i] = (c % QCH) ? 1 : 0; sumf += locf[i]; sump += locp[i]; }
        int incf = sumf, incp = sump;
#pragma unroll
        for (int o = 1; o < 64; o <<= 1) { const int vf_ = __shfl_up(incf, o), vp_ = __shfl_up(incp, o); if (lane >= o) { incf += vf_; incp += vp_; } }
        int runf = incf - sumf, runp = incp - sump;
#pragma unroll
        for (int i = 0; i < 16; ++i) { pre[lane * 16 + i] = runf; prp[lane * 16 + i] = runp; runf += locf[i]; runp += locp[i]; }
        if (lane == 63) { pre[1024] = runf; prp[1024] = runp; }
    }
    __syncthreads();
    const int nfull = pre[1024], npart = prp[1024];
    int* ticket = (int*)(ws + WS_CNT) + 1024;
    int it_static = blockIdx.x; bool dyn = false;
    for (;;) {
        int idx = 0;
        if (!dyn) { if (it_static < nfull) { idx = it_static; it_static += gridDim.x; } else dyn = true; }
        if (dyn) {
            __syncthreads();
            if (tid == 0) nxt[0] = atomicAdd(ticket, 1);
            __syncthreads();
            idx = nxt[0];
            if (idx >= npart) break;
            idx += nfull;
        }
        int u, c;
        if (idx < nfull) { int lo = 0, hi = 1024; while (hi - lo > 1) { const int mid = (lo + hi) >> 1; if (pre[mid] <= idx) lo = mid; else hi = mid; } u = lo; c = idx - pre[u]; }
        else { const int j = idx - nfull; int lo = 0, hi = 1024; while (hi - lo > 1) { const int mid = (lo + hi) >> 1; if (prp[mid] <= j) lo = mid; else hi = mid; } u = lo; c = cnt[u] / QCH; }
        const int bh = u >> 6, n = u & 63, b = bh >> 3, h = bh & 7;
        int tid = tid_, fr = fr_, fq = fq_; asm volatile("" : "+v"(tid), "+v"(fr), "+v"(fq));
        const int count = cnt[u], qbase = c * QCH;
        const int ntile = min(QCH / 16, (count - qbase + 15) >> 4);
        const unsigned* lp = list + (size_t)bh * LIST_PER_BH + list_base(n);
        const bf16_t* qb0 = proj + (size_t)(b * SEQ) * DIN + h * 128 + 8 * fq;
        int tile = wave;
        unsigned ent_c = 0u, ent_n = 0u;
        if (tile < ntile) ent_c = lp[min(qbase + tile * 16 + fr, count - 1)];
        if (tile + 8 < ntile) ent_n = lp[min(qbase + (tile + 8) * 16 + fr, count - 1)];
        __syncthreads();
        const bf16_t* Kg = proj + (size_t)(b * SEQ + n * 256) * DIN + C_K + h * 128;
        stage_kv(Kl, Vl, Kg, Kg + (C_V - C_K), DIN, tid, kmx);
        bf16x8 qc[4];
        { const bf16_t* qp = qb0 + (size_t)(ent_c & 0x3fffu) * DIN;
#pragma unroll
          for (int k = 0; k < 4; ++k) qc[k] = *(const bf16x8*)(qp + 32 * k); }
        float qn_c = qnorm(qc);
        __syncthreads();
        const float kmax = kmax_of(kmx);
        for (; tile < ntile; tile += 8) {
            bf16x8 qn[4]; unsigned ent_nn = 0u;
#pragma unroll
            for (int k = 0; k < 4; ++k) qn[k] = qc[k];
            if (tile + 8 < ntile) {
                const bf16_t* qp = qb0 + (size_t)(ent_n & 0x3fffu) * DIN;
#pragma unroll
                for (int k = 0; k < 4; ++k) qn[k] = *(const bf16x8*)(qp + 32 * k);
                if (tile + 16 < ntile) ent_nn = lp[min(qbase + (tile + 16) * 16 + fr, count - 1)];
            }
            const bool valid = qbase + tile * 16 + fr < count;
            const int sq = (int)(ent_c & 0x3fffu), slot = (int)(ent_c >> 14);
            const bool do_mask = __any(slot == 3);
            const int qrel = sq - n * 256;
            int smax = 8;
            if (do_mask) { int qm = qrel;
#pragma unroll
                for (int o = 1; o < 64; o <<= 1) qm = max(qm, __shfl_xor(qm, o));
                smax = min(8, (qm >> 5) + 1); }
            smax = __builtin_amdgcn_readfirstlane(smax);
            f32x4 oacc[8]; float mx, l;
            attn_core(Kl, Vl, qc, fr, fq, do_mask, qrel, smax, qn_c * kmax, oacc, mx, l);
            qn_c = qnorm(qn);
            __builtin_amdgcn_sched_barrier(0);
            if (valid) {
                const size_t pidx = ((size_t)bh * SEQ + sq) * 4 + slot;
                bf16_t* op = PO + pidx * 128 + 4 * fq;
#pragma unroll
                for (int dt = 0; dt < 8; ++dt) { u32x2 w; w.x = cvt_pk_bf16(oacc[dt][0], oacc[dt][1]); w.y = cvt_pk_bf16(oacc[dt][2], oacc[dt][3]); *(u32x2*)(op + 16 * dt) = w; }
                if (fq == 0) PML[pidx] = (f32x2){mx, l};
            }
            ent_c = ent_n; ent_n = ent_nn;
#pragma unroll
            for (int k = 0; k < 4; ++k) qc[k] = qn[k];
        }
    }
    const bf16_t* mkv = (const bf16_t*)(ws + WS_MKV);
    for (int item = blockIdx.x; item < BATCH * 4 * (SEQ / MQCH); item += gridDim.x) {
        const int c = item & 31, hm = (item >> 5) & 3, b = item >> 7;
        int tid = tid_, fr = fr_, fq = fq_; asm volatile("" : "+v"(tid), "+v"(fr), "+v"(fq));
        __syncthreads();
        const bf16_t* Kg = mkv + (size_t)(b * MEMLEN) * 1024 + hm * 128;
        stage_kv(Kl, Vl, Kg, Kg + 512, 1024, tid, kmx);
        const bf16_t* qb0 = proj + (size_t)(b * SEQ + c * MQCH + fr) * DIN + C_QME + hm * 128 + 8 * fq;
        bf16x8 qc[4];
#pragma unroll
        for (int k = 0; k < 4; ++k) qc[k] = *(const bf16x8*)(qb0 + (size_t)(wave * 16) * DIN + 32 * k);
        float qn_c = qnorm(qc);
        __syncthreads();
        const float kmax = kmax_of(kmx);
        for (int tile = wave; tile < MQCH / 16; tile += 8) {
            bf16x8 qn[4];
#pragma unroll
            for (int k = 0; k < 4; ++k) qn[k] = qc[k];
            if (tile + 8 < MQCH / 16) {
#pragma unroll
                for (int k = 0; k < 4; ++k) qn[k] = *(const bf16x8*)(qb0 + (size_t)((tile + 8) * 16) * DIN + 32 * k); }
            const int sq = c * MQCH + tile * 16 + fr; const size_t row = (size_t)(b * SEQ + sq);
            f32x4 oacc[8]; float mx, l;
            attn_core(Kl, Vl, qc, fr, fq, false, 0, 8, qn_c * kmax, oacc, mx, l);
            qn_c = qnorm(qn);
            __builtin_amdgcn_sched_barrier(0);
            const float rl = 1.f / l;
            const bf16_t* gp = proj + row * DIN + C_GME + hm * 128 + 4 * fq;
            bf16_t* yp = Y + row * DM + 1536 + hm * 128 + 4 * fq;
            u32x2 gv[8];
#pragma unroll
            for (int dt = 0; dt < 8; ++dt) gv[dt] = *(const u32x2*)(gp + 16 * dt);
            __builtin_amdgcn_sched_barrier(0);
#pragma unroll
            for (int dt = 0; dt < 8; ++dt) { const u32x2 g = gv[dt];
                u32x2 w; w.x = cvt_pk_bf16(oacc[dt][0] * rl * bflo(g.x), oacc[dt][1] * rl * bfhi(g.x)); w.y = cvt_pk_bf16(oacc[dt][2] * rl * bflo(g.y), oacc[dt][3] * rl * bfhi(g.y));
                *(u32x2*)(yp + 16 * dt) = w; }
#pragma unroll
            for (int k = 0; k < 4; ++k) qc[k] = qn[k];
        }
    }
    const bf16_t* wsb = (const bf16_t*)(ws + WS_WSB);
    for (int item = blockIdx.x; item < BATCH * (SEQ / 128); item += gridDim.x) {
        const size_t row0 = (size_t)item * 128;
        int fr = fr_, fq = fq_, lane = lane_; asm volatile("" : "+v"(fr), "+v"(fq), "+v"(lane));
        __syncthreads();
        {
            const f32x4 g0 = *(const f32x4*)(a.gln_g + 8 * lane), g1 = *(const f32x4*)(a.gln_g + 8 * lane + 4), b0 = *(const f32x4*)(a.gln_b + 8 * lane), b1 = *(const f32x4*)(a.gln_b + 8 * lane + 4);
            u32x4 raw[16];
#pragma unroll
            for (int i = 0; i < 16; ++i) raw[i] = *(const u32x4*)(proj + (row0 + wave + 8 * i) * DIN + C_VG + 8 * lane);
#pragma unroll
            for (int i = 0; i < 16; ++i) {
                const int tk = wave + 8 * i;
                float v[8] = {bflo(raw[i].x), bfhi(raw[i].x), bflo(raw[i].y), bfhi(raw[i].y), bflo(raw[i].z), bfhi(raw[i].z), bflo(raw[i].w), bfhi(raw[i].w)};
                float sm = 0.f;
#pragma unroll
                for (int e = 0; e < 8; ++e) sm += v[e];
#pragma unroll
                for (int o = 1; o < 64; o <<= 1) sm += __shfl_xor(sm, o);
                const float mu = sm * (1.f / 512.f); float q = 0.f;
#pragma unroll
                for (int e = 0; e < 8; ++e) { v[e] -= mu; q += v[e] * v[e]; }
#pragma unroll
                for (int o = 1; o < 64; o <<= 1) q += __shfl_xor(q, o);
                const float rstd = 1.f / sqrtf(q * (1.f / 512.f) + LN_EPS);
#pragma unroll
                for (int e = 0; e < 8; ++e) { const float o = v[e] * rstd * (e < 4 ? g0[e] : g1[e - 4]) + (e < 4 ? b0[e] : b1[e - 4]);
                    *(LAS bf16_t*)(lds + (8 * lane + e) * 272 + tk * 2) = (bf16_t)(cvt_pk_bf16(o, 0.f) & 0xffffu); }
            }
        }
        __syncthreads();
        const int g = wave >> 1, th = wave & 1;
        f32x4 acc[8][4];
#pragma unroll
        for (int ct = 0; ct < 8; ++ct)
#pragma unroll
            for (int tt = 0; tt < 4; ++tt) acc[ct][tt] = (f32x4){0.f, 0.f, 0.f, 0.f};
#pragma unroll
        for (int k = 0; k < 4; ++k) {
            bf16x8 wf[4];
#pragma unroll
            for (int tt = 0; tt < 4; ++tt) wf[tt] = *(const bf16x8*)(wsb + (size_t)(g * 128 + 64 * th + 16 * tt + fr) * 128 + 32 * k + 8 * fq);
#pragma unroll
            for (int ct = 0; ct < 8; ++ct) { const bf16x8 av = *(const LAS bf16x8*)(lds + (128 * g + 16 * ct + fr) * 272 + (32 * k + 8 * fq) * 2);
#pragma unroll
                for (int tt = 0; tt < 4; ++tt) acc[ct][tt] = __builtin_amdgcn_mfma_f32_16x16x32_bf16(av, wf[tt], acc[ct][tt], 0, 0, 0); }
        }
#pragma unroll
        for (int tt = 0; tt < 4; ++tt) { const int t = 64 * th + 16 * tt + fr; const float bs = a.b_s[g * 128 + t]; const size_t row = row0 + t;
            u32x2 uuv[8], ggv[8];
#pragma unroll
            for (int ct = 0; ct < 8; ++ct) { const int ch = 128 * g + 16 * ct + 4 * fq; uuv[ct] = *(const u32x2*)(proj + row * DIN + C_U + ch); ggv[ct] = *(const u32x2*)(proj + row * DIN + C_GG + ch); }
            __builtin_amdgcn_sched_barrier(0);
#pragma unroll
            for (int ct = 0; ct < 8; ++ct) { const int ch = 128 * g + 16 * ct + 4 * fq;
                const u32x2 uu = uuv[ct], gg = ggv[ct];
                const f32x4 m = acc[ct][tt] + bs;
                u32x2 w; w.x = cvt_pk_bf16(bflo(uu.x) * m[0] * bflo(gg.x), bfhi(uu.x) * m[1] * bfhi(gg.x)); w.y = cvt_pk_bf16(bflo(uu.y) * m[2] * bflo(gg.y), bfhi(uu.y) * m[3] * bfhi(gg.y));
                *(u32x2*)(Y + row * DM + 1024 + ch) = w; } }
    }
}

__device__ __forceinline__ void phase4(const Args& a) {
    unsigned char* ws = a.ws;
    const int tid = threadIdx.x, lane = tid & 63, wave = tid >> 6;
    const bf16_t* proj = (const bf16_t*)(ws + WS_PROJ);
    const bf16_t* PO = (const bf16_t*)(ws + WS_PO); const f32x2* PML = (const f32x2*)(ws + WS_PML);
    bf16_t* Y = (bf16_t*)(ws + WS_Y);
    const int rl_ = lane >> 3, d0 = (lane & 7) * 16;
    const int nw = gridDim.x * 8;
    for (int t0 = blockIdx.x * 8 + wave; t0 < 16 * (SEQ / 8); t0 += 2 * nw) {
        f32x2 ml[2][4]; u32x4 pp[2][4][2]; u32x4 gg[2][2];
#pragma unroll
        for (int r = 0; r < 2; ++r) {
            const int t = (t0 + r * nw < 16 * (SEQ / 8)) ? t0 + r * nw : t0;
            const int bh = 15 - t / (SEQ / 8), s = (t % (SEQ / 8)) * 8 + rl_, b = bh >> 3, h = bh & 7, qb = s >> 8, nv = qb < 3 ? qb : 3;
            const size_t pbase = ((size_t)bh * SEQ + s) * 4; const size_t row = (size_t)b * SEQ + s;
#pragma unroll
            for (int j = 0; j < 4; ++j) { const bool ok = (j == 3) || (j < nv);
                ml[r][j] = ok ? PML[pbase + j] : (f32x2){-INFINITY, 0.f};
                if (ok) { pp[r][j][0] = *(const u32x4*)(PO + (pbase + j) * 128 + d0); pp[r][j][1] = *(const u32x4*)(PO + (pbase + j) * 128 + d0 + 8); }
                else { pp[r][j][0] = (u32x4){0u, 0u, 0u, 0u}; pp[r][j][1] = pp[r][j][0]; } }
            gg[r][0] = *(const u32x4*)(proj + row * DIN + C_GMO + h * 128 + d0); gg[r][1] = *(const u32x4*)(proj + row * DIN + C_GMO + h * 128 + d0 + 8);
        }
        __builtin_amdgcn_sched_barrier(0);
#pragma unroll
        for (int r = 0; r < 2; ++r) {
            const int t = t0 + r * nw;
            if (t < 16 * (SEQ / 8)) {
                const int bh = 15 - t / (SEQ / 8), s = (t % (SEQ / 8)) * 8 + rl_, b = bh >> 3, h = bh & 7; const size_t row = (size_t)b * SEQ + s;
                float M = -INFINITY;
#pragma unroll
                for (int j = 0; j < 4; ++j) M = fmaxf(M, ml[r][j].x);
                float o[16]; float L = 0.f;
#pragma unroll
                for (int e = 0; e < 16; ++e) o[e] = 0.f;
#pragma unroll
                for (int j = 0; j < 4; ++j) { const float w = fast_exp2(ml[r][j].x - M); L += w * ml[r][j].y;
                    const u32x4 p0 = pp[r][j][0], p1 = pp[r][j][1];
                    o[0] += w * bflo(p0.x); o[1] += w * bfhi(p0.x); o[2] += w * bflo(p0.y); o[3] += w * bfhi(p0.y); o[4] += w * bflo(p0.z); o[5] += w * bfhi(p0.z); o[6] += w * bflo(p0.w); o[7] += w * bfhi(p0.w);
                    o[8] += w * bflo(p1.x); o[9] += w * bfhi(p1.x); o[10] += w * bflo(p1.y); o[11] += w * bfhi(p1.y); o[12] += w * bflo(p1.z); o[13] += w * bfhi(p1.z); o[14] += w * bflo(p1.w); o[15] += w * bfhi(p1.w); }
                const float rl = 1.f / L;
                const u32x4 g0 = gg[r][0], g1 = gg[r][1];
                u32x4 w0, w1;
                w0.x = cvt_pk_bf16(o[0] * rl * bflo(g0.x), o[1] * rl * bfhi(g0.x)); w0.y = cvt_pk_bf16(o[2] * rl * bflo(g0.y), o[3] * rl * bfhi(g0.y));
                w0.z = cvt_pk_bf16(o[4] * rl * bflo(g0.z), o[5] * rl * bfhi(g0.z)); w0.w = cvt_pk_bf16(o[6] * rl * bflo(g0.w), o[7] * rl * bfhi(g0.w));
                w1.x = cvt_pk_bf16(o[8] * rl * bflo(g1.x), o[9] * rl * bfhi(g1.x)); w1.y = cvt_pk_bf16(o[10] * rl * bflo(g1.y), o[11] * rl * bfhi(g1.y));
                w1.z = cvt_pk_bf16(o[12] * rl * bflo(g1.z), o[13] * rl * bfhi(g1.z)); w1.w = cvt_pk_bf16(o[14] * rl * bflo(g1.w), o[15] * rl * bfhi(g1.w));
                *(u32x4*)(Y + row * DM + h * 128 + d0) = w0; *(u32x4*)(Y + row * DM + h * 128 + d0 + 8) = w1;
            }
        }
        __builtin_amdgcn_sched_barrier(0);
    }
}

__device__ __forceinline__ void phase6(const Args& a) {
    const int tid = threadIdx.x, lane = tid & 63, wave = tid >> 6;
    const bf16_t* sub = (const bf16_t*)(a.ws + WS_SUB);
    for (int row = blockIdx.x * 8 + wave; row < MROWS; row += gridDim.x * 8) {
        const f32x4* xp = (const f32x4*)(a.x + (size_t)row * DM) + lane;
        const u32x2* sp = (const u32x2*)(sub + (size_t)row * DM) + lane;
        f32x4* rp = (f32x4*)(a.out + (size_t)row * DM) + lane;
        f32x4 v[8]; u32x2 sv[8]; float s = 0.f;
#pragma unroll
        for (int j = 0; j < 8; ++j) { v[j] = __builtin_nontemporal_load(xp + 64 * j); sv[j] = sp[64 * j]; }
#pragma unroll
        for (int j = 0; j < 8; ++j) { v[j] = v[j] * ALPHA + (f32x4){bflo(sv[j].x), bfhi(sv[j].x), bflo(sv[j].y), bfhi(sv[j].y)}; s += (v[j][0] + v[j][1]) + (v[j][2] + v[j][3]); }
#pragma unroll
        for (int o = 1; o < 64; o <<= 1) s += __shfl_xor(s, o);
        const float mu = s * (1.f / DM); float q = 0.f;
#pragma unroll
        for (int j = 0; j < 8; ++j) { v[j] = v[j] - mu; q += (v[j][0] * v[j][0] + v[j][1] * v[j][1]) + (v[j][2] * v[j][2] + v[j][3] * v[j][3]); }
#pragma unroll
        for (int o = 1; o < 64; o <<= 1) q += __shfl_xor(q, o);
        const float rstd = 1.f / sqrtf(q * (1.f / DM) + LN_EPS);
#pragma unroll
        for (int j = 0; j < 8; ++j) { const f32x4 g = ((const f32x4*)a.ln_g)[lane + 64 * j], bb = ((const f32x4*)a.ln_b)[lane + 64 * j]; __builtin_nontemporal_store(v[j] * rstd * g + bb, rp + 64 * j); }
    }
}

#define XB_TMO      128
#define XB_XCNT(j)  (256  + 64 * (j))
#define XB_XSUB(j)  (1280 + 64 * (j))
#define XB_XGEN(j)  (2304 + 64 * (j))
#define XB_TOP      3328
#define XB_TOPGEN   3392
#define XCD_BAR_WORDS 3456
#define XB_SPIN_CAP (1u << 18)
__device__ __forceinline__ unsigned xb_ld(unsigned* p)              { return __hip_atomic_load(p, __ATOMIC_RELAXED, __HIP_MEMORY_SCOPE_AGENT); }
__device__ __forceinline__ unsigned xb_add(unsigned* p, unsigned v) { return __hip_atomic_fetch_add(p, v, __ATOMIC_RELAXED, __HIP_MEMORY_SCOPE_AGENT); }
__device__ __forceinline__ unsigned xb_xcc_id() { return (unsigned)__builtin_amdgcn_s_getreg((3 << 11) | 20) & 0xFu; }
#define XB_SPIN(cond, bar) do { unsigned _sp = 0; while (cond) { __builtin_amdgcn_s_sleep(1); \
    if ((++_sp & 255u) == 0u) { if (xb_ld(&(bar)[XB_TMO])) break; if (_sp > XB_SPIN_CAP) { atomicAdd(&(bar)[XB_TMO], 1u); break; } } } } while (0)
struct XcdBarrier { unsigned* bar; unsigned x; volatile LAS unsigned* st; };
__device__ __forceinline__ XcdBarrier xcd_barrier_post(unsigned* bar, volatile LAS unsigned* st) {
    XcdBarrier b; b.bar = bar; b.x = xb_xcc_id(); b.st = st;
    if (threadIdx.x == 0) (void)xb_add(&bar[XB_XCNT(b.x)], 1u);
    return b;
}
__device__ __forceinline__ void xcd_barrier_complete(unsigned* bar, unsigned x, unsigned& nloc, unsigned& nx) {
    const unsigned G = gridDim.x * gridDim.y * gridDim.z;
    unsigned sum, cnt, mine, sp = 0u;
    for (;;) {
        sum = 0u; cnt = 0u; mine = 0u;
#pragma unroll
        for (unsigned j = 0; j < 16; ++j) { const unsigned c = xb_ld(&bar[XB_XCNT(j)]); sum += c; cnt += (c > 0u) ? 1u : 0u; mine = (j == x) ? c : mine; }
        if (sum == G) break;
        __builtin_amdgcn_s_sleep(1);
        if ((++sp & 255u) == 0u) { if (xb_ld(&bar[XB_TMO])) break; if (sp > XB_SPIN_CAP) { atomicAdd(&bar[XB_TMO], 1u); break; } }
    }
    nloc = mine > 0u ? mine : 1u; nx = cnt > 0u ? cnt : 1u;
}
__device__ __forceinline__ void xcd_barrier(const XcdBarrier& b) {
    asm volatile("s_waitcnt vmcnt(0)" ::: "memory");
    __syncthreads();
    if (threadIdx.x == 0) {
        unsigned* bar = b.bar;
        __builtin_amdgcn_s_waitcnt(0);
        unsigned nloc = b.st[0], nx = b.st[1];
        if (nloc == 0u) { xcd_barrier_complete(bar, b.x, nloc, nx); b.st[0] = nloc; b.st[1] = nx; }
        const unsigned old = xb_add(&bar[XB_XSUB(b.x)], 1u);
        const unsigned gen = old / nloc;
        if (old + 1u == (gen + 1u) * nloc) {
            __builtin_amdgcn_fence(__ATOMIC_RELEASE, "agent");
            asm volatile("s_waitcnt vmcnt(0)" ::: "memory");
            const unsigned og = xb_add(&bar[XB_TOP], 1u);
            const unsigned tg = og / nx;
            if (og + 1u == (tg + 1u) * nx) xb_add(&bar[XB_TOPGEN], 1u);
            else XB_SPIN(xb_ld(&bar[XB_TOPGEN]) == tg, bar);
            __builtin_amdgcn_fence(__ATOMIC_ACQUIRE, "agent");
            xb_add(&bar[XB_XGEN(b.x)], 1u);
            asm volatile("s_waitcnt vmcnt(0)" ::: "memory");
        } else {
            XB_SPIN(xb_ld(&bar[XB_XGEN(b.x)]) == gen, bar);
            __builtin_amdgcn_fence(__ATOMIC_ACQUIRE, "agent");
            asm volatile("s_waitcnt vmcnt(0)" ::: "memory");
        }
    }
    __syncthreads();
}

__global__ void __launch_bounds__(512, 2) hymba_fwd(Args a) {
    extern __shared__ __attribute__((aligned(16))) unsigned char lds_raw[];
    LAS unsigned char* lds = (LAS unsigned char*)lds_raw;
    unsigned char* ws = a.ws;
    const int lo = a.ph_lo, hi = a.ph_hi, G = gridDim.x;
#define IN(k) (lo <= (k) && (k) < hi)
#define SEAM(k) do { if (IN(k) && IN((k) + 1)) xcd_barrier(xbar); } while (0)
    volatile LAS unsigned* xst = (volatile LAS unsigned*)(lds + LDS_BYTES - 64);
    if (threadIdx.x < 2) xst[threadIdx.x] = 0u;
    __syncthreads();
    XcdBarrier xbar; xbar.bar = (unsigned*)(ws + WS_BAR); xbar.x = 0; xbar.st = xst;
    if (IN(0) && IN(1)) xbar = xcd_barrier_post((unsigned*)(ws + WS_BAR), xst);
    if (IN(0)) phase0(a, lds);
    SEAM(0);
    if (IN(1)) {
        { pg8::Gemm g{(const bf16_t*)(ws + WS_XB), (const bf16_t*)(ws + WS_WIN), MROWS, DIN, DM}; pg8::StaticOrder S; S.init(g.M, g.N, G, (int)blockIdx.x);
          EpiProj E{(bf16_t*)(ws + WS_PROJ), (const float*)(ws + WS_COS), (const float*)(ws + WS_SIN), (float*)(ws + WS_KSUM)};
          pg8::gemm_phase<EpiProj, pg8::StaticOrder, true, true>(lds, g, S, E); }
    }
    SEAM(1);
    if (IN(2)) phase2(a, lds);
    SEAM(2);
    if (IN(3)) phase3(a, lds);
    SEAM(3);
    if (IN(4)) phase4(a);
    SEAM(4);
    if (IN(5)) {
        pg8::Gemm g{(const bf16_t*)(ws + WS_Y), (const bf16_t*)(ws + WS_WOUT), MROWS, DM, DM}; pg8::StaticOrder S; S.init(g.M, g.N, G, (int)blockIdx.x);
        EpiPlain E{(bf16_t*)(ws + WS_SUB), DM};
        pg8::gemm_phase<EpiPlain, pg8::StaticOrder, true, true>(lds, g, S, E);
    }
    SEAM(5);
    if (IN(6)) phase6(a);
#undef IN
#undef SEAM
}

extern "C" void kernel_launch(void* const* d_in, const int* in_sizes, int n_in, void* d_out, int out_size, void* d_ws, size_t ws_size, hipStream_t stream) {
    static int grid = 0;
    if (grid == 0) {
        if (n_in != 12 || ws_size < WS_END) { fprintf(stderr, "kernel_launch: unexpected inputs (n_in %d, ws %zu)\n", n_in, ws_size); grid = -1; return; }
        int dev = 0, cus = 0, per_cu = 0;
        hipGetDevice(&dev); hipDeviceGetAttribute(&cus, hipDeviceAttributeMultiprocessorCount, dev);
        hipFuncSetAttribute((const void*)hymba_fwd, hipFuncAttributeMaxDynamicSharedMemorySize, LDS_BYTES);
        hipOccupancyMaxActiveBlocksPerMultiprocessor(&per_cu, (const void*)hymba_fwd, 512, LDS_BYTES);
        if (per_cu < 1) { fprintf(stderr, "kernel_launch: occupancy query reports %d blocks per CU\n", per_cu); per_cu = 1; }
        grid = cus * per_cu;
        (void)hipGetLastError();
    }
    if (grid < 0) return;
    Args a{};
    a.x = (const float*)d_in[0]; a.mem = (const float*)d_in[1]; a.pos = (const int*)d_in[2]; a.w_in = (const float*)d_in[3]; a.w_mkv = (const float*)d_in[4];
    a.gln_g = (const float*)d_in[5]; a.gln_b = (const float*)d_in[6]; a.w_s = (const float*)d_in[7]; a.b_s = (const float*)d_in[8]; a.w_out = (const float*)d_in[9];
    a.ln_g = (const float*)d_in[10]; a.ln_b = (const float*)d_in[11]; a.out = (float*)d_out; a.ws = (unsigned char*)d_ws;
#if MK_MULTI
    for (int p = 0; p < 7; ++p) { a.ph_lo = p; a.ph_hi = p + 1; hipLaunchKernelGGL(hymba_fwd, dim3(grid), dim3(512), LDS_BYTES, stream, a); }
#else
    a.ph_lo = 0; a.ph_hi = 7;
    (void)hipMemsetAsync((char*)d_ws + WS_BAR, 0, BAR_WORDS_N * 4, stream);
    void* args[] = {&a};
    hipError_t e = hipLaunchCooperativeKernel((const void*)hymba_fwd, dim3(grid), dim3(512), args, LDS_BYTES, stream);
    if (e != hipSuccess) fprintf(stderr, "cooperative launch failed: %s (grid %d)\n", hipGetErrorString(e), grid);
#endif
}
```

```cpp
#include <hip/hip_runtime.h>
#include <hip/hip_cooperative_groups.h>
#include <cstdio>
#include <cstdint>
namespace cg = cooperative_groups;

#ifndef MK_MULTI
#define MK_MULTI 0
#endif

#define LAS __attribute__((address_space(3)))
typedef unsigned short bf16_t;
typedef short bf16x8 __attribute__((ext_vector_type(8)));
typedef float f32x4 __attribute__((ext_vector_type(4)));
typedef float f32x2 __attribute__((ext_vector_type(2)));
typedef unsigned u32x4 __attribute__((ext_vector_type(4)));
typedef unsigned u32x2 __attribute__((ext_vector_type(2)));

constexpr int BATCH = 2, SEQ = 16384, DM = 2048, DIN = 6656, MROWS = BATCH * SEQ, NBLK = 64, MEMLEN = 256;
constexpr int C_K = 1024, C_V = 2048, C_GMO = 3072, C_U = 4096, C_VG = 4608, C_GG = 5120, C_QME = 5632, C_GME = 6144;
constexpr float QSCALE = 0.08838834764831845f * 1.4426950408889634f;
constexpr float ALPHA = 1.189207115002721f;
constexpr float LN_EPS = 1e-5f;
constexpr int LIST_PER_BH = 256 * 2080;
constexpr int QCH = 2048;
constexpr int MQCH = 512;

constexpr size_t MiB = 1u << 20;
constexpr size_t WS_CNT = 0;
constexpr size_t WS_BAR = 8192;
constexpr size_t WS_KSUM = 64 * 1024;
constexpr size_t WS_WIN = 1 * MiB;
constexpr size_t WS_WOUT = 28 * MiB;
constexpr size_t WS_WMKV = 36 * MiB;
constexpr size_t WS_WSB = 40 * MiB;
constexpr size_t WS_MEMB = 41 * MiB;
constexpr size_t WS_MKV = 43 * MiB;
constexpr size_t WS_COS = 44 * MiB;
constexpr size_t WS_SIN = 52 * MiB;
constexpr size_t WS_LIST = 60 * MiB;
constexpr size_t WS_PML = 96 * MiB;
constexpr size_t WS_Y = 104 * MiB;
constexpr size_t WS_PROJ = 232 * MiB;
constexpr size_t WS_PO = 648 * MiB;
constexpr size_t WS_SUB = 648 * MiB;
constexpr size_t WS_XB = 648 * MiB;
constexpr size_t WS_END = 904 * MiB;
constexpr int LDS_BYTES = 152 * 1024;
constexpr int BAR_WORDS_N = 3456;

namespace pg8 {
constexpr int BM = 256, BK = 64, HALF = 128, HTB = HALF * BK * 2, STAGE_BYTES = 8 * HTB, NXCD = 8, WGM = 8;
__host__ __device__ __forceinline__ int lds_byte(int r, int c) { const int st = (r >> 4) * 2 + (c >> 5), rr = r & 15, cc = c & 31, ob = rr * 64 + cc * 2; return st * 1024 + (ob ^ (((ob >> 9) & 1) << 5)); }
__host__ __device__ __forceinline__ void stage_rc(int b, int& R, int& C) { const int st = b / 1024, sb = b % 1024, swz = sb ^ (((sb >> 9) & 1) << 5); R = (st >> 1) * 16 + swz / 64; C = (st & 1) * 32 + (swz % 64) / 2; }
__host__ __device__ __forceinline__ int perm32(int rho) { const int n = rho >> 4, i = rho & 15; return 8 * (i >> 2) + 4 * n + (i & 3); }
struct Unit { int pm, pn; };
struct Gemm { const bf16_t* A; const bf16_t* Bt; int M, N, K; };
struct StaticOrder {
    int nM, nN, nwg, G, c;
    __host__ __device__ void init(int M, int N, int G_, int c_) { nM = M / BM; nN = N / BM; nwg = nM * nN; G = G_; c = c_; }
    __host__ __device__ bool next(int i, Unit& u) const {
        const long L = (long)i * G + c; if (L >= nwg) return false;
        int wgid = (int)L; { const int q = nwg / NXCD, r = nwg % NXCD, xcd = wgid % NXCD, off = wgid / NXCD; wgid = (xcd < r ? xcd * (q + 1) : r * (q + 1) + (xcd - r) * q) + off; }
        const int nig = WGM * nN, gid = wgid / nig, fm = gid * WGM, gsz = (nM - fm) < WGM ? (nM - fm) : WGM;
        u.pm = fm + ((wgid % nig) % gsz); u.pn = (wgid % nig) / gsz; return true;
    }
    __device__ __forceinline__ void a_ready(const Unit&) const {}
    __device__ __forceinline__ void done(const Unit&) const {}
};
__device__ __forceinline__ unsigned cvt_pk_bf16(float lo, float hi) { unsigned r; asm volatile("v_cvt_pk_bf16_f32 %0, %1, %2" : "=v"(r) : "v"(lo), "v"(hi)); return r; }

template <class Epi, class Sched, bool ALIGN_EPI = false, bool SP2 = false>
__device__ __forceinline__ void gemm_phase(LAS unsigned char* lds, const Gemm g, const Sched& S, const Epi& E) {
    const int tid = threadIdx.x, wid = __builtin_amdgcn_readfirstlane(tid >> 6), lane = tid & 63, wr = wid >> 2, wc = wid & 3, fr = lane & 15, fq = lane >> 4;
    const int K = g.K, nt = K / BK;
    unsigned voffA[2], voffB[2];
#pragma unroll
    for (int i = 0; i < 2; ++i) { int R, C; stage_rc(tid * 16 + i * 8192, R, C); const int Rb = Epi::PERM ? ((R & ~31) + perm32(R & 31)) : R;
        voffA[i] = (unsigned)(R * K + C) * 2u; voffB[i] = (unsigned)(Rb * K + C) * 2u; }
    const size_t kstep = (size_t)(BK * 2);
    const size_t hstep = (size_t)HALF * K * 2;
    const size_t tstep = 2 * hstep;
    const unsigned ldsw = (unsigned)wid * 1024u;
    const int aoff = lds_byte(wr * 64 + fr, fq * 8), boff = lds_byte(wc * 32 + fr, fq * 8);
#define PG8_SA(b, h) (((b) * 2 + (h)) * HTB)
#define PG8_SB(b, h) ((4 + (b) * 2 + (h)) * HTB)
#define PG8_STAGE(bufoff, gbase, voff) do { _Pragma("unroll") for (int _i = 0; _i < 2; ++_i) \
        __builtin_amdgcn_global_load_lds((const unsigned*)((const char*)(gbase) + (voff)[_i]), (LAS unsigned*)(lds + (bufoff) + ldsw + _i * 8192), 16, 0, 0); } while (0)
#define PG8_LDA(dst, b, h) do { _Pragma("unroll") for (int m = 0; m < 4; ++m) _Pragma("unroll") for (int k = 0; k < 2; ++k) dst[m][k] = *(const LAS bf16x8*)(lds + PG8_SA(b, h) + aoff + m * 2048 + k * 1024); } while (0)
#define PG8_LDB(dst, b, h) do { _Pragma("unroll") for (int n = 0; n < 2; ++n) _Pragma("unroll") for (int k = 0; k < 2; ++k) dst[n][k] = *(const LAS bf16x8*)(lds + PG8_SB(b, h) + boff + n * 2048 + k * 1024); } while (0)
#define PG8_MMA(ai, bj, At, Bt) do { __builtin_amdgcn_s_setprio(1); _Pragma("unroll") for (int m = 0; m < 4; ++m) _Pragma("unroll") for (int n = 0; n < 2; ++n) _Pragma("unroll") for (int k = 0; k < 2; ++k) \
        acc[ai][bj][m][n] = __builtin_amdgcn_mfma_f32_16x16x32_bf16(Bt[n][k], At[m][k], acc[ai][bj][m][n], 0, 0, 0); __builtin_amdgcn_s_setprio(0); } while (0)
#define PG8_WAIT_V(n) asm volatile("s_waitcnt vmcnt(" #n ")" ::: "memory")
#define PG8_WAIT_L(n) asm volatile("s_waitcnt lgkmcnt(" #n ")" ::: "memory")
#define PG8_BAR __builtin_amdgcn_s_barrier()
#define PG8_SCHED __builtin_amdgcn_sched_barrier(0)
    Unit cur, nxt; int ui = 0;
    if (!S.next(0, cur)) return;
    f32x4 acc[2][2][4][2];
#pragma unroll
    for (int a = 0; a < 2; ++a)
#pragma unroll
        for (int b = 0; b < 2; ++b)
#pragma unroll
            for (int m = 0; m < 4; ++m)
#pragma unroll
                for (int n = 0; n < 2; ++n) acc[a][b][m][n] = (f32x4){0.f, 0.f, 0.f, 0.f};
    bf16x8 At[4][2], B0[2][2], B1[2][2];
    const char* cA = (const char*)g.A + (size_t)cur.pm * tstep; const char* cB = (const char*)g.Bt + (size_t)cur.pn * tstep;
    S.a_ready(cur);
    if constexpr (SP2) {
        PG8_STAGE(PG8_SB(0, 0), cB, voffB); PG8_STAGE(PG8_SB(0, 1), cB + hstep, voffB); PG8_STAGE(PG8_SA(0, 0), cA, voffA); PG8_STAGE(PG8_SA(0, 1), cA + hstep, voffA);
        if (wr == 1) PG8_BAR;
        PG8_WAIT_V(2); PG8_BAR;
        PG8_STAGE(PG8_SB(1, 0), cB + kstep, voffB); PG8_STAGE(PG8_SA(1, 0), cA + kstep, voffA); PG8_STAGE(PG8_SB(1, 1), cB + hstep + kstep, voffB);
        PG8_WAIT_V(6); PG8_BAR;
    } else {
        PG8_STAGE(PG8_SB(0, 0), cB, voffB); PG8_STAGE(PG8_SA(0, 0), cA, voffA); PG8_STAGE(PG8_SB(0, 1), cB + hstep, voffB); PG8_STAGE(PG8_SA(0, 1), cA + hstep, voffA);
        if (wr == 1) PG8_BAR;
        PG8_WAIT_V(4); PG8_BAR;
        PG8_STAGE(PG8_SB(1, 0), cB + kstep, voffB); PG8_STAGE(PG8_SA(1, 0), cA + kstep, voffA); PG8_STAGE(PG8_SB(1, 1), cB + hstep + kstep, voffB);
        PG8_WAIT_V(6); PG8_BAR;
    }
    for (;;) {
        const bool has_next = S.next(ui + 1, nxt);
        const char* nA = has_next ? (const char*)g.A + (size_t)nxt.pm * tstep : cA; const char* nB = has_next ? (const char*)g.Bt + (size_t)nxt.pn * tstep : cB;
        for (int t = 0; t < nt; t += 2) {
            const bool last = (t == nt - 2);
            const char* a1 = cA + (size_t)(t + 1) * kstep;
            const char* a2 = last ? nA : cA + (size_t)(t + 2) * kstep; const char* b2 = last ? nB : cB + (size_t)(t + 2) * kstep;
            const char* a3 = a2 + kstep; const char* b3 = b2 + kstep;
            if (last && has_next) S.a_ready(nxt);
            if constexpr (SP2) {
            PG8_LDB(B0, 0, 0); PG8_LDB(B1, 0, 1); PG8_SCHED; PG8_LDA(At, 0, 0); PG8_STAGE(PG8_SA(1, 1), a1 + hstep, voffA);
            PG8_WAIT_V(8); PG8_WAIT_L(0); PG8_BAR; PG8_MMA(0, 0, At, B0); PG8_MMA(0, 1, At, B1); PG8_BAR; PG8_SCHED;
            PG8_LDA(At, 0, 1); PG8_STAGE(PG8_SB(0, 0), b2, voffB); PG8_STAGE(PG8_SB(0, 1), b2 + hstep, voffB); PG8_STAGE(PG8_SA(0, 0), a2, voffA);
            PG8_WAIT_V(8); PG8_WAIT_L(0); PG8_BAR; PG8_MMA(1, 0, At, B0); PG8_MMA(1, 1, At, B1); PG8_BAR; PG8_SCHED;
            PG8_LDB(B0, 1, 0); PG8_LDB(B1, 1, 1); PG8_SCHED; PG8_LDA(At, 1, 0); PG8_STAGE(PG8_SA(0, 1), a2 + hstep, voffA);
            PG8_WAIT_V(8); PG8_WAIT_L(0); PG8_BAR; PG8_MMA(0, 0, At, B0); PG8_MMA(0, 1, At, B1); PG8_BAR; PG8_SCHED;
            PG8_LDA(At, 1, 1); PG8_STAGE(PG8_SB(1, 0), b3, voffB); PG8_STAGE(PG8_SB(1, 1), b3 + hstep, voffB); PG8_STAGE(PG8_SA(1, 0), a3, voffA);
            PG8_WAIT_V(8); PG8_WAIT_L(0); PG8_BAR; PG8_MMA(1, 0, At, B0); PG8_MMA(1, 1, At, B1); PG8_BAR; PG8_SCHED;
            } else {
            PG8_LDB(B0, 0, 0); PG8_SCHED; PG8_LDA(At, 0, 0); PG8_STAGE(PG8_SA(1, 1), a1 + hstep, voffA);
            PG8_WAIT_L(8); PG8_BAR; PG8_WAIT_L(0); PG8_MMA(0, 0, At, B0); PG8_BAR; PG8_SCHED;
            PG8_LDB(B1, 0, 1); PG8_STAGE(PG8_SB(0, 0), b2, voffB);
            PG8_BAR; PG8_WAIT_L(0); PG8_MMA(0, 1, At, B1); PG8_BAR;
            PG8_LDA(At, 0, 1); PG8_STAGE(PG8_SA(0, 0), a2, voffA);
            PG8_BAR; PG8_WAIT_L(0); PG8_MMA(1, 0, At, B0); PG8_BAR; PG8_SCHED;
            PG8_STAGE(PG8_SB(0, 1), b2 + hstep, voffB);
            PG8_WAIT_V(6); PG8_BAR; PG8_MMA(1, 1, At, B1); PG8_BAR;
            PG8_LDB(B0, 1, 0); PG8_SCHED; PG8_LDA(At, 1, 0); PG8_STAGE(PG8_SA(0, 1), a2 + hstep, voffA);
            PG8_WAIT_L(8); PG8_BAR; PG8_WAIT_L(0); PG8_MMA(0, 0, At, B0); PG8_BAR; PG8_SCHED;
            PG8_LDB(B1, 1, 1); PG8_STAGE(PG8_SB(1, 0), b3, voffB);
            PG8_BAR; PG8_WAIT_L(0); PG8_MMA(0, 1, At, B1); PG8_BAR;
            PG8_LDA(At, 1, 1); PG8_STAGE(PG8_SA(1, 0), a3, voffA);
            PG8_BAR; PG8_WAIT_L(0); PG8_MMA(1, 0, At, B0); PG8_BAR; PG8_SCHED;
            PG8_STAGE(PG8_SB(1, 1), b3 + hstep, voffB);
            PG8_WAIT_V(6); PG8_BAR; PG8_MMA(1, 1, At, B1); PG8_BAR;
            }
        }
        if constexpr (ALIGN_EPI) { if (wr == 0) PG8_BAR; }
        E(acc, cur, wr, wc, fr, fq); S.done(cur);
        if (!has_next) break;
#pragma unroll
        for (int a = 0; a < 2; ++a)
#pragma unroll
            for (int b = 0; b < 2; ++b)
#pragma unroll
                for (int m = 0; m < 4; ++m)
#pragma unroll
                    for (int n = 0; n < 2; ++n) acc[a][b][m][n] = (f32x4){0.f, 0.f, 0.f, 0.f};
        cur = nxt; cA = nA; cB = nB; ++ui;
        if constexpr (ALIGN_EPI) { if (wr == 1) PG8_BAR; }
    }
    PG8_WAIT_V(0);
    if constexpr (!ALIGN_EPI) { if (wr == 0) PG8_BAR; }
    PG8_BAR;
#undef PG8_SA
#undef PG8_SB
#undef PG8_STAGE
#undef PG8_LDA
#undef PG8_LDB
#undef PG8_MMA
#undef PG8_WAIT_V
#undef PG8_WAIT_L
#undef PG8_BAR
#undef PG8_SCHED
}
}

using pg8::cvt_pk_bf16;
__device__ __forceinline__ float bf2f(unsigned short b) { return __builtin_bit_cast(float, (unsigned)b << 16); }
__device__ __forceinline__ float bflo(unsigned w) { return __builtin_bit_cast(float, w << 16); }
__device__ __forceinline__ float bfhi(unsigned w) { return __builtin_bit_cast(float, w & 0xffff0000u); }
__device__ __forceinline__ float fast_exp2(float x) { return __builtin_amdgcn_exp2f(x); }
__device__ __forceinline__ float fast_rcp(float x) { return __builtin_amdgcn_rcpf(x); }
__device__ __forceinline__ float silu_f(float x) { return x * fast_rcp(1.f + fast_exp2(-1.4426950408889634f * x)); }
__device__ __forceinline__ float gelu_tanh_f(float x) {
    const float t = x * (1.f + 0.044715f * x * x) * (-1.5957691216057308f * 1.4426950408889634f);
    return x * fast_rcp(1.f + fast_exp2(t));
}
#define LDS_WAIT() asm volatile("s_waitcnt lgkmcnt(0)" ::: "memory")

struct EpiProj {
    static constexpr bool PERM = true;
    bf16_t* O; const float* cosT; const float* sinT; float* ksum;
    __device__ __forceinline__ void operator()(const f32x4 (&acc)[2][2][4][2], const pg8::Unit& u, int wr, int wc, int fr, int fq) const {
        const int pn = u.pn;
        const int type = pn < 4 ? 0 : pn < 8 ? 1 : pn < 12 ? 2 : pn < 16 ? 3 : pn < 20 ? 4 : pn < 22 ? 3 : pn < 24 ? 5 : 3;
        const int row0 = u.pm * 256 + wr * 64 + fr;
        const int col0 = pn * 256 + wc * 32 + 8 * fq;
        float cs[2][8];
#pragma unroll
        for (int bj = 0; bj < 2; ++bj)
#pragma unroll
            for (int e = 0; e < 8; ++e) cs[bj][e] = 0.f;
#pragma unroll
        for (int ai = 0; ai < 2; ++ai) {
            f32x4 c4v[4], s4v[4];
#pragma unroll
            for (int m = 0; m < 4; ++m) { c4v[m] = (f32x4){1.f, 1.f, 1.f, 1.f}; s4v[m] = (f32x4){0.f, 0.f, 0.f, 0.f}; }
            if (type <= 1) {
#pragma unroll
                for (int m = 0; m < 4; ++m) { const size_t ro = (size_t)(row0 + ai * 128 + m * 16) * 64 + 16 * wc + 4 * fq; c4v[m] = *(const f32x4*)(cosT + ro); s4v[m] = *(const f32x4*)(sinT + ro); }
            }
            __builtin_amdgcn_sched_barrier(0);
#pragma unroll
            for (int m = 0; m < 4; ++m) {
                const int row = row0 + ai * 128 + m * 16;
                const f32x4 c4 = c4v[m], s4 = s4v[m];
                bf16_t* rowp = O + (size_t)row * DIN + col0;
#pragma unroll
                for (int bj = 0; bj < 2; ++bj) {
                    f32x4 v0 = acc[ai][bj][m][0], v1 = acc[ai][bj][m][1];
                    float o[8];
                    if (type <= 1) {
                        o[0] = v0[0] * c4[0] - v0[1] * s4[0]; o[1] = v0[1] * c4[0] + v0[0] * s4[0];
                        o[2] = v0[2] * c4[1] - v0[3] * s4[1]; o[3] = v0[3] * c4[1] + v0[2] * s4[1];
                        o[4] = v1[0] * c4[2] - v1[1] * s4[2]; o[5] = v1[1] * c4[2] + v1[0] * s4[2];
                        o[6] = v1[2] * c4[3] - v1[3] * s4[3]; o[7] = v1[3] * c4[3] + v1[2] * s4[3];
                        if (type == 0) {
#pragma unroll
                            for (int e = 0; e < 8; ++e) o[e] *= QSCALE;
                        } else {
#pragma unroll
                            for (int e = 0; e < 8; ++e) cs[bj][e] += o[e];
                        }
                    } else {
#pragma unroll
                        for (int e = 0; e < 4; ++e) { o[e] = v0[e]; o[4 + e] = v1[e]; }
                        if (type == 3) {
#pragma unroll
                            for (int e = 0; e < 8; ++e) o[e] = silu_f(o[e]);
                        } else if (type == 4) {
#pragma unroll
                            for (int e = 0; e < 8; ++e) o[e] = gelu_tanh_f(o[e]);
                        } else if (type == 5) {
#pragma unroll
                            for (int e = 0; e < 8; ++e) o[e] *= QSCALE;
                        }
                    }
                    u32x4 w; w.x = cvt_pk_bf16(o[0], o[1]); w.y = cvt_pk_bf16(o[2], o[3]); w.z = cvt_pk_bf16(o[4], o[5]); w.w = cvt_pk_bf16(o[6], o[7]);
                    __builtin_nontemporal_store(w, (u32x4*)(rowp + bj * 128));
                }
            }
            __builtin_amdgcn_sched_barrier(0);
        }
        if (type == 1) {
#pragma unroll
            for (int bj = 0; bj < 2; ++bj)
#pragma unroll
                for (int e = 0; e < 8; ++e) {
                    float v = cs[bj][e];
                    v += __shfl_xor(v, 1); v += __shfl_xor(v, 2); v += __shfl_xor(v, 4); v += __shfl_xor(v, 8);
                    cs[bj][e] = v;
                }
            if (fr == 0) {
                float* kp = ksum + (size_t)u.pm * 1024 + (pn - 4) * 256 + wc * 32 + 8 * fq;
#pragma unroll
                for (int bj = 0; bj < 2; ++bj)
#pragma unroll
                    for (int e = 0; e < 8; ++e) atomicAdd(kp + bj * 128 + e, cs[bj][e]);
            }
        }
    }
};
struct EpiPlain {
    static constexpr bool PERM = true;
    bf16_t* O; int ldc;
    __device__ __forceinline__ void operator()(const f32x4 (&acc)[2][2][4][2], const pg8::Unit& u, int wr, int wc, int fr, int fq) const {
        const int row0 = u.pm * 256 + wr * 64 + fr, col0 = u.pn * 256 + wc * 32 + 8 * fq;
#pragma unroll
        for (int ai = 0; ai < 2; ++ai)
#pragma unroll
            for (int m = 0; m < 4; ++m) { bf16_t* rowp = O + (size_t)(row0 + ai * 128 + m * 16) * ldc + col0;
#pragma unroll
                for (int bj = 0; bj < 2; ++bj) { const f32x4 v0 = acc[ai][bj][m][0], v1 = acc[ai][bj][m][1];
                    u32x4 w; w.x = cvt_pk_bf16(v0[0], v0[1]); w.y = cvt_pk_bf16(v0[2], v0[3]); w.z = cvt_pk_bf16(v1[0], v1[1]); w.w = cvt_pk_bf16(v1[2], v1[3]);
                    *(u32x4*)(rowp + bj * 128) = w; } }
    }
};
struct EpiResid {
    static constexpr bool PERM = true;
    const float* __restrict__ x; float* __restrict__ out;
    __device__ __forceinline__ void operator()(const f32x4 (&acc)[2][2][4][2], const pg8::Unit& u, int wr, int wc, int fr, int fq) const {
        const int row0 = u.pm * 256 + wr * 64 + fr, col0 = u.pn * 256 + wc * 32 + 8 * fq;
#pragma unroll
        for (int ai = 0; ai < 2; ++ai) {
            f32x4 xv[4][2][2];
#pragma unroll
            for (int m = 0; m < 4; ++m) { const size_t off = (size_t)(row0 + ai * 128 + m * 16) * DM + col0;
#pragma unroll
                for (int bj = 0; bj < 2; ++bj)
#pragma unroll
                    for (int n = 0; n < 2; ++n) xv[m][bj][n] = *(const f32x4*)(x + off + bj * 128 + 4 * n); }
            __builtin_amdgcn_sched_barrier(0);
#pragma unroll
            for (int m = 0; m < 4; ++m) { const size_t off = (size_t)(row0 + ai * 128 + m * 16) * DM + col0;
#pragma unroll
                for (int bj = 0; bj < 2; ++bj)
#pragma unroll
                    for (int n = 0; n < 2; ++n) *(f32x4*)(out + off + bj * 128 + 4 * n) = xv[m][bj][n] * ALPHA + acc[ai][bj][m][n]; }
            __builtin_amdgcn_sched_barrier(0);
        }
    }
};

struct Args { const float* x; const float* mem; const int* pos; const float* w_in; const float* w_mkv; const float* gln_g; const float* gln_b;
              const float* w_s; const float* b_s; const float* w_out; const float* ln_g; const float* ln_b; float* out; unsigned char* ws; int ph_lo, ph_hi; };

__device__ __forceinline__ void p0_transpose_item(const float* W, int K, int N, bf16_t* WT, bool permute_qk, LAS float* scr, int item, int lane) {
    const int nblk = N / 32, kb = item / nblk, nb = item % nblk, k0 = 64 * kb, n0 = 32 * nb;
    const int ncol = n0 + (lane & 31);
    int src = ncol;
    if (permute_qk && ncol < 2048) { const int p = ncol & 127; src = (ncol & ~127) + ((p & 1) << 6) + (p >> 1); }
#pragma unroll 8
    for (int i = 0; i < 32; ++i) { const int kk = 2 * i + (lane >> 5); scr[kk * 33 + (lane & 31)] = W[(size_t)(k0 + kk) * N + src]; }
    LDS_WAIT();
    const int c = lane & 7;
#pragma unroll
    for (int j = 0; j < 4; ++j) { const int n = (lane >> 3) + 8 * j; const LAS float* s = scr + (8 * c) * 33 + n;
        u32x4 o; o.x = cvt_pk_bf16(s[0 * 33], s[1 * 33]); o.y = cvt_pk_bf16(s[2 * 33], s[3 * 33]); o.z = cvt_pk_bf16(s[4 * 33], s[5 * 33]); o.w = cvt_pk_bf16(s[6 * 33], s[7 * 33]);
        *(u32x4*)(WT + (size_t)(n0 + n) * K + k0 + 8 * c) = o; }
    LDS_WAIT();
}

__device__ __forceinline__ void phase0(const Args& a, LAS unsigned char* lds) {
    unsigned char* ws = a.ws;
    const int tid = threadIdx.x, lane = tid & 63, wave = tid >> 6;
    const int G = gridDim.x;
    const size_t gtid = (size_t)blockIdx.x * 512 + tid, NT = (size_t)G * 512;
    { int* cnt = (int*)(ws + WS_CNT); for (size_t i = gtid; i < 1088; i += NT) cnt[i] = 0;
      float* ks = (float*)(ws + WS_KSUM); for (size_t i = gtid; i < 128 * 1024; i += NT) ks[i] = 0.f; }
    { LAS float* scr = (LAS float*)(lds + wave * 16384);
      const int gw = blockIdx.x * 8 + wave, NGW = G * 8;
      constexpr int I_IN = (DM / 64) * (DIN / 32), I_OUT = (DM / 64) * (DM / 32), I_MKV = (DM / 64) * (1024 / 32);
      for (int it = gw; it < I_IN + I_OUT + I_MKV; it += NGW) {
          int r = it;
          if (r < I_IN) { p0_transpose_item(a.w_in, DM, DIN, (bf16_t*)(ws + WS_WIN), true, scr, r, lane); continue; } r -= I_IN;
          if (r < I_OUT) { p0_transpose_item(a.w_out, DM, DM, (bf16_t*)(ws + WS_WOUT), false, scr, r, lane); continue; } r -= I_OUT;
          p0_transpose_item(a.w_mkv, DM, 1024, (bf16_t*)(ws + WS_WMKV), false, scr, r, lane);
      } }
    { const size_t n8 = (size_t)MROWS * DM / 8; u32x4* xb = (u32x4*)(ws + WS_XB);
      for (size_t i0 = gtid; i0 < n8; i0 += 4 * NT) {
          f32x4 v[4][2];
#pragma unroll
          for (int j = 0; j < 4; ++j) { const size_t i = i0 + j * NT; if (i < n8) { v[j][0] = __builtin_nontemporal_load((const f32x4*)a.x + 2 * i); v[j][1] = __builtin_nontemporal_load((const f32x4*)a.x + 2 * i + 1); } }
          __builtin_amdgcn_sched_barrier(0);
#pragma unroll
          for (int j = 0; j < 4; ++j) { const size_t i = i0 + j * NT; if (i < n8) { const f32x4 v0 = v[j][0], v1 = v[j][1];
              u32x4 o; o.x = cvt_pk_bf16(v0[0], v0[1]); o.y = cvt_pk_bf16(v0[2], v0[3]); o.z = cvt_pk_bf16(v1[0], v1[1]); o.w = cvt_pk_bf16(v1[2], v1[3]); xb[i] = o; } }
          __builtin_amdgcn_sched_barrier(0);
      }
      const size_t m8 = (size_t)BATCH * MEMLEN * DM / 8; u32x4* mb = (u32x4*)(ws + WS_MEMB);
      for (size_t i = gtid; i < m8; i += NT) { const f32x4 v0 = ((const f32x4*)a.mem)[2 * i], v1 = ((const f32x4*)a.mem)[2 * i + 1];
          u32x4 o; o.x = cvt_pk_bf16(v0[0], v0[1]); o.y = cvt_pk_bf16(v0[2], v0[3]); o.z = cvt_pk_bf16(v1[0], v1[1]); o.w = cvt_pk_bf16(v1[2], v1[3]); mb[i] = o; } }
    { bf16_t* wsb = (bf16_t*)(ws + WS_WSB);
      for (size_t i = gtid; i < 4 * 128 * 128; i += NT) { const int t = (int)(i >> 7) & 127, s = (int)i & 127; const float v = s <= t ? a.w_s[i] : 0.f; wsb[i] = (bf16_t)(cvt_pk_bf16(v, 0.f) & 0xffffu); } }
    { float* cT = (float*)(ws + WS_COS); float* sT = (float*)(ws + WS_SIN);
      LAS float* invf = (LAS float*)(lds + 8 * 16384);
      if (tid < 64) invf[tid] = (float)exp2(-(double)tid * (13.287712379549449 / 64.0));
      __syncthreads();
      for (size_t e = gtid; e < (size_t)MROWS * 64; e += NT) { const int row = (int)(e >> 6), i = (int)e & 63;
          const float inv = invf[i];
          const float ang = (float)a.pos[row] * inv;
          const double rev = (double)ang * 0.15915494309189535; const float fr = (float)(rev - rint(rev));
          cT[e] = __builtin_amdgcn_cosf(fr); sT[e] = __builtin_amdgcn_sinf(fr); } }
}

__device__ __forceinline__ int list_base(int n) { return 256 * (64 * n - (n * (n - 1)) / 2); }
__device__ __forceinline__ unsigned long long shfl_xor_u64(unsigned long long v, int m) {
    unsigned lo = (unsigned)v, hi = (unsigned)(v >> 32); lo = __shfl_xor(lo, m); hi = __shfl_xor(hi, m); return ((unsigned long long)hi << 32) | lo; }

__device__ __forceinline__ void phase2(const Args& a, LAS unsigned char* lds) {
    unsigned char* ws = a.ws;
    const int tid = threadIdx.x, lane = tid & 63, wave = __builtin_amdgcn_readfirstlane(tid >> 6), fr = lane & 15, fq = lane >> 4;
    const bf16_t* proj = (const bf16_t*)(ws + WS_PROJ);
    const float* ksum = (const float*)(ws + WS_KSUM);
    int* cnt = (int*)(ws + WS_CNT);
    unsigned* list = (unsigned*)(ws + WS_LIST);
    LAS unsigned char* Kl = lds;
    LAS int* lcnt = (LAS int*)(lds + 16384);
    LAS int* gbase = (LAS int*)(lds + 16384 + 256);
    { const bf16_t* memb = (const bf16_t*)(ws + WS_MEMB); const bf16_t* wt = (const bf16_t*)(ws + WS_WMKV); bf16_t* mkv = (bf16_t*)(ws + WS_MKV);
      for (int t = blockIdx.x; t < 256; t += gridDim.x) {
          const int m0 = (t & 15) * 32 + 16 * (wave & 1), n0 = (t >> 4) * 64 + 16 * (wave >> 1);
          const bf16_t* ap = wt + (size_t)(n0 + fr) * DM + 8 * fq; const bf16_t* bp = memb + (size_t)(m0 + fr) * DM + 8 * fq;
          f32x4 acc = (f32x4){0.f, 0.f, 0.f, 0.f};
          bf16x8 av[8], bv[8], an[8], bn[8];
#pragma unroll
          for (int i = 0; i < 8; ++i) { av[i] = *(const bf16x8*)(ap + 32 * i); bv[i] = *(const bf16x8*)(bp + 32 * i); }
#pragma unroll 1
          for (int kb = 0; kb < 8; ++kb) {
              const int kn = kb < 7 ? kb + 1 : kb;
#pragma unroll
              for (int i = 0; i < 8; ++i) { an[i] = *(const bf16x8*)(ap + 32 * (8 * kn + i)); bn[i] = *(const bf16x8*)(bp + 32 * (8 * kn + i)); }
              __builtin_amdgcn_sched_barrier(0);
#pragma unroll
              for (int i = 0; i < 8; ++i) acc = __builtin_amdgcn_mfma_f32_16x16x32_bf16(av[i], bv[i], acc, 0, 0, 0);
              __builtin_amdgcn_sched_barrier(0);
#pragma unroll
              for (int i = 0; i < 8; ++i) { av[i] = an[i]; bv[i] = bn[i]; }
          }
          u32x2 w; w.x = cvt_pk_bf16(acc[0], acc[1]); w.y = cvt_pk_bf16(acc[2], acc[3]);
          *(u32x2*)(mkv + (size_t)(m0 + fr) * 1024 + n0 + 4 * fq) = w; } }
    LAS int* pend_n = (LAS int*)(lds + 18432);
    LAS int* pend_lp = (LAS int*)(lds + 18432 + 16384);
    LAS int* lcnt4 = (LAS int*)(lds + 16384);
    LAS int* gbase4 = (LAS int*)(lds + 16384 + 1024);
    for (int grp = blockIdx.x; grp < 256; grp += gridDim.x) {
        const int bh = grp >> 4, qb0 = (grp & 15) * 4, b = bh >> 3, h = bh & 7;
        { const int n = tid >> 3, c2 = tid & 7; const float* kp = ksum + (size_t)(b * 64 + n) * 1024 + h * 128 + c2 * 16;
          const f32x4 v0 = *(const f32x4*)kp, v1 = *(const f32x4*)(kp + 4), v2 = *(const f32x4*)(kp + 8), v3 = *(const f32x4*)(kp + 12);
          u32x4 w0, w1; w0.x = cvt_pk_bf16(v0[0], v0[1]); w0.y = cvt_pk_bf16(v0[2], v0[3]); w0.z = cvt_pk_bf16(v1[0], v1[1]); w0.w = cvt_pk_bf16(v1[2], v1[3]);
          w1.x = cvt_pk_bf16(v2[0], v2[1]); w1.y = cvt_pk_bf16(v2[2], v2[3]); w1.z = cvt_pk_bf16(v3[0], v3[1]); w1.w = cvt_pk_bf16(v3[2], v3[3]);
          *(LAS u32x4*)(Kl + n * 256 + (((2 * c2) ^ (n & 15)) << 4)) = w0; *(LAS u32x4*)(Kl + n * 256 + (((2 * c2 + 1) ^ (n & 15)) << 4)) = w1;
          if (tid < 256) lcnt4[tid] = 0; }
        const bf16_t* qbase = proj + (size_t)(b * SEQ + wave * 32 + fr) * DIN + h * 128 + 8 * fq;
        bf16x8 qcur[2][4];
#pragma unroll
        for (int tt = 0; tt < 2; ++tt)
#pragma unroll
            for (int k = 0; k < 4; ++k) qcur[tt][k] = *(const bf16x8*)(qbase + (size_t)(qb0 * 256 + tt * 16) * DIN + 32 * k);
        __syncthreads();
#pragma unroll 1
        for (int kk = 0; kk < 4; ++kk) {
            const int qb = qb0 + kk;
            bf16x8 qnxt[2][4];
            { const int qbn = kk < 3 ? qb + 1 : qb;
#pragma unroll
              for (int tt = 0; tt < 2; ++tt)
#pragma unroll
                  for (int k = 0; k < 4; ++k) qnxt[tt][k] = *(const bf16x8*)(qbase + (size_t)(qbn * 256 + tt * 16) * DIN + 32 * k); }
#pragma unroll
            for (int tt = 0; tt < 2; ++tt) {
                unsigned long long best0 = 0ull, best1 = 0ull, best2 = 0ull;
#pragma unroll
                for (int nt = 0; nt < 4; ++nt) {
                    if (16 * nt < qb) {
                        f32x4 g = (f32x4){0.f, 0.f, 0.f, 0.f};
#pragma unroll
                        for (int k = 0; k < 4; ++k) { const bf16x8 av = *(const LAS bf16x8*)(Kl + (16 * nt + fr) * 256 + (((4 * k + fq) ^ fr) << 4)); g = __builtin_amdgcn_mfma_f32_16x16x32_bf16(av, qcur[tt][k], g, 0, 0, 0); }
#pragma unroll
                        for (int j = 0; j < 4; ++j) { const int n = 16 * nt + 4 * fq + j;
                            const float gj = j == 0 ? g.x : j == 1 ? g.y : j == 2 ? g.z : g.w; const unsigned bits = __float_as_uint(gj); const unsigned ord = (bits & 0x80000000u) ? ~bits : (bits | 0x80000000u);
                            unsigned long long key = n < qb ? (((unsigned long long)ord << 32) | (unsigned)(63 - n)) : 0ull;
                            if (key > best0) { const unsigned long long t = best0; best0 = key; key = t; }
                            if (key > best1) { const unsigned long long t = best1; best1 = key; key = t; }
                            if (key > best2) { best2 = key; } }
                    }
                }
                int ptr = 0; int myn = -1;
#pragma unroll
                for (int r = 0; r < 3; ++r) {
                    const unsigned long long cand = ptr == 0 ? best0 : ptr == 1 ? best1 : ptr == 2 ? best2 : 0ull;
                    unsigned long long g = cand; { const unsigned long long o = shfl_xor_u64(g, 16); g = o > g ? o : g; } { const unsigned long long o = shfl_xor_u64(g, 32); g = o > g ? o : g; }
                    if (g != 0ull && cand == g) ++ptr;
                    if (fq == r && g != 0ull) myn = 63 - (int)(unsigned)(g & 0xffffffffull);
                }
                if (fq == 3) myn = qb;
                int lp = 0;
                if (myn >= 0) lp = __hip_atomic_fetch_add(lcnt4 + kk * 64 + myn, 1, __ATOMIC_RELAXED, __HIP_MEMORY_SCOPE_WORKGROUP);
                pend_n[(kk * 2 + tt) * 512 + tid] = myn; pend_lp[(kk * 2 + tt) * 512 + tid] = lp;
            }
#pragma unroll
            for (int tt = 0; tt < 2; ++tt)
#pragma unroll
                for (int k = 0; k < 4; ++k) qcur[tt][k] = qnxt[tt][k];
        }
        __syncthreads();
        if (tid < 256) { const int c = lcnt4[tid]; gbase4[tid] = c ? atomicAdd(cnt + bh * 64 + (tid & 63), c) : 0; }
        __syncthreads();
#pragma unroll 1
        for (int e = 0; e < 8; ++e) { const int kk = e >> 1, tt = e & 1; const int myn = pend_n[e * 512 + tid];
            if (myn >= 0) { const int s = (qb0 + kk) * 256 + (wave * 2 + tt) * 16 + fr;
                list[(size_t)bh * LIST_PER_BH + list_base(myn) + gbase4[kk * 64 + myn] + pend_lp[e * 512 + tid]] = (unsigned)s | ((unsigned)fq << 14); } }
        __syncthreads();
    }
}

__device__ __forceinline__ float sq8(u32x4 v) {
    const float a = bflo(v.x), b = bfhi(v.x), c = bflo(v.y), d = bfhi(v.y), e = bflo(v.z), f = bfhi(v.z), g = bflo(v.w), h = bfhi(v.w);
    return ((a * a + b * b) + (c * c + d * d)) + ((e * e + f * f) + (g * g + h * h)); }
__device__ __forceinline__ void stage_kv(LAS unsigned char* Kl, LAS unsigned char* Vl, const bf16_t* Kg, const bf16_t* Vg, int stride, int tid, LAS float* kmx) {
    float nmax = 0.f;
#pragma unroll
    for (int it = 0; it < 8; ++it) { const int q = tid + 512 * it, c = q & 15, r = q >> 4;
        const u32x4 v = *(const u32x4*)(Kg + (size_t)r * stride + 8 * c);
        *(LAS u32x4*)(Kl + r * 256 + ((c ^ (r & 15)) << 4)) = v;
        float n2 = sq8(v); n2 += __shfl_xor(n2, 1); n2 += __shfl_xor(n2, 2); n2 += __shfl_xor(n2, 4); n2 += __shfl_xor(n2, 8);
        nmax = fmaxf(nmax, n2); }
    nmax = fmaxf(nmax, __shfl_xor(nmax, 16)); nmax = fmaxf(nmax, __shfl_xor(nmax, 32));
    if ((tid & 63) == 0) kmx[tid >> 6] = nmax;
#pragma unroll
    for (int it = 0; it < 4; ++it) { const int q = tid + 512 * it, c = q & 15, kp = q >> 4, kq = 2 * kp;
        const int key = (kq & 0xE0) | (((kq >> 2) & 1) << 4) | (((kq >> 3) & 3) << 2) | (kq & 3);
        const u32x4 v0 = *(const u32x4*)(Vg + (size_t)key * stride + 8 * c), v1 = *(const u32x4*)(Vg + (size_t)(key + 1) * stride + 8 * c);
        const unsigned a0[4] = {v0.x, v0.y, v0.z, v0.w}, a1[4] = {v1.x, v1.y, v1.z, v1.w};
#pragma unroll
        for (int i = 0; i < 8; ++i) { const int d = 8 * c + i;
            const unsigned lo = (i & 1) ? (a0[i >> 1] >> 16) : (a0[i >> 1] & 0xffffu), hi = (i & 1) ? (a1[i >> 1] & 0xffff0000u) : (a1[i >> 1] << 16);
            *(LAS unsigned*)(Vl + d * 512 + ((((kq >> 3)) ^ (d & 15)) << 4) + (kq & 7) * 2) = lo | hi; } }
}
__device__ __forceinline__ float kmax_of(const LAS float* kmx) {
    float m = kmx[0];
#pragma unroll
    for (int i = 1; i < 8; ++i) m = fmaxf(m, kmx[i]);
    return sqrtf(m) * 1.002f; }

__device__ __forceinline__ float qnorm(const bf16x8 (&qf)[4]) {
    float qq = 0.f;
#pragma unroll
    for (int k = 0; k < 4; ++k) qq += sq8(__builtin_bit_cast(u32x4, qf[k]));
    qq += __shfl_xor(qq, 16); qq += __shfl_xor(qq, 32);
    return sqrtf(qq); }
#define AT_SCHED() __builtin_amdgcn_sched_barrier(0)
#define AT_LOADK(S) do { _Pragma("unroll") for (int k = 0; k < 4; ++k) { kf[2 * k] = *(const LAS bf16x8*)(Kl + kb[k] + (S) * 8192); kf[2 * k + 1] = *(const LAS bf16x8*)(Kl + kb[k] + (S) * 8192 + 4096); } } while (0)
#define AT_LOADV(S) do { const unsigned vb = (unsigned)fr * 512u + ((unsigned)((4 * (S) + fq) ^ fr) << 4); _Pragma("unroll") for (int dt = 0; dt < 8; ++dt) vf[dt] = *(const LAS bf16x8*)(Vl + vb + dt * 8192); } while (0)
__device__ __forceinline__ void attn_core(const LAS unsigned char* Kl, const LAS unsigned char* Vl, const bf16x8 (&qf)[4], int fr, int fq, bool do_mask, int qrel, int smax, float kmax,
                                          f32x4 (&oacc)[8], float& m_out, float& l_out) {
    asm volatile("" : "+v"(fr), "+v"(fq));
    unsigned kb[4];
#pragma unroll
    for (int k = 0; k < 4; ++k) kb[k] = (unsigned)fr * 256u + ((unsigned)((4 * k + fq) ^ fr) << 4);
    bf16x8 kf[8], vf[8];
    AT_LOADK(0); AT_LOADV(0);
    const float m = kmax;
    float l = 0.f;
#pragma unroll
    for (int dt = 0; dt < 8; ++dt) oacc[dt] = (f32x4){0.f, 0.f, 0.f, 0.f};
    f32x4 c0 = (f32x4){-m, -m, -m, -m}, c1 = c0;
    AT_SCHED();
#pragma unroll
    for (int k = 0; k < 4; ++k) { c0 = __builtin_amdgcn_mfma_f32_16x16x32_bf16(kf[2 * k], qf[k], c0, 0, 0, 0); c1 = __builtin_amdgcn_mfma_f32_16x16x32_bf16(kf[2 * k + 1], qf[k], c1, 0, 0, 0); }
    AT_SCHED();
    if (1 < smax) AT_LOADK(1);
#pragma unroll
    for (int s = 0; s < 8; ++s) {
        if (s < smax) {
            AT_SCHED();
            f32x4 n0 = (f32x4){-m, -m, -m, -m}, n1 = n0;
            if (s + 1 < smax) {
#pragma unroll
                for (int k = 0; k < 4; ++k) { n0 = __builtin_amdgcn_mfma_f32_16x16x32_bf16(kf[2 * k], qf[k], n0, 0, 0, 0); n1 = __builtin_amdgcn_mfma_f32_16x16x32_bf16(kf[2 * k + 1], qf[k], n1, 0, 0, 0); }
            }
            AT_SCHED();
            if (s + 2 < smax) AT_LOADK(s + 2);
            AT_SCHED();
            float p[8] = {c0.x, c0.y, c0.z, c0.w, c1.x, c1.y, c1.z, c1.w};
            if (do_mask) {
#pragma unroll
                for (int j = 0; j < 4; ++j) { if (32 * s + 4 * fq + j > qrel) p[j] = -INFINITY; if (32 * s + 16 + 4 * fq + j > qrel) p[4 + j] = -INFINITY; }
            }
#pragma unroll
            for (int j = 0; j < 8; ++j) p[j] = fast_exp2(p[j]);
            l += ((p[0] + p[1]) + (p[2] + p[3])) + ((p[4] + p[5]) + (p[6] + p[7]));
            u32x4 w; w.x = cvt_pk_bf16(p[0], p[1]); w.y = cvt_pk_bf16(p[2], p[3]); w.z = cvt_pk_bf16(p[4], p[5]); w.w = cvt_pk_bf16(p[6], p[7]);
            const bf16x8 pb = __builtin_bit_cast(bf16x8, w);
            AT_SCHED();
#pragma unroll
            for (int dt = 0; dt < 8; ++dt) oacc[dt] = __builtin_amdgcn_mfma_f32_16x16x32_bf16(vf[dt], pb, oacc[dt], 0, 0, 0);
            AT_SCHED();
            if (s + 1 < smax) AT_LOADV(s + 1);
            c0 = n0; c1 = n1;
        }
    }
    AT_SCHED();
    l += __shfl_xor(l, 16); l += __shfl_xor(l, 32);
    m_out = m; l_out = l;
}

__device__ __forceinline__ void phase3(const Args& a, LAS unsigned char* lds) {
    unsigned char* ws = a.ws;
    const int tid = threadIdx.x, lane = tid & 63, wave = __builtin_amdgcn_readfirstlane(tid >> 6), fr = lane & 15, fq = lane >> 4;
    const int fr_ = fr, fq_ = fq, lane_ = lane, tid_ = tid;
    const bf16_t* proj = (const bf16_t*)(ws + WS_PROJ);
    const int* cnt = (const int*)(ws + WS_CNT);
    const unsigned* list = (const unsigned*)(ws + WS_LIST);
    bf16_t* PO = (bf16_t*)(ws + WS_PO); f32x2* PML = (f32x2*)(ws + WS_PML);
    bf16_t* Y = (bf16_t*)(ws + WS_Y);
    LAS unsigned char* Kl = lds; LAS unsigned char* Vl = lds + 65536;
    LAS int* pre = (LAS int*)(lds + 131072);
    LAS float* kmx = (LAS float*)(lds + 131072 + 12288);
    LAS int* prp = (LAS int*)(lds + 131072 + 4352);
    LAS int* nxt = (LAS int*)(lds + 131072 + 12288 + 64);
    if (wave == 0) {
        int locf[16], locp[16]; int sumf = 0, sump = 0;
#pragma unroll
        for (int i = 0; i < 16; ++i) { const int v_ = lane * 16 + i; const int c = cnt[(v_ & 15) * 64 + (v_ >> 4)]; locf[i] = c / QCH; locp[i] = (c % QCH) ? 1 : 0; sumf += locf[i]; sump += locp[i]; }
        int incf = sumf, incp = sump;
#pragma unroll
        for (int o = 1; o < 64; o <<= 1) { const int vf_ = __shfl_up(incf, o), vp_ = __shfl_up(incp, o); if (lane >= o) { incf += vf_; incp += vp_; } }
        int runf = incf - sumf, runp = incp - sump;
#pragma unroll
        for (int i = 0; i < 16; ++i) { pre[lane * 16 + i] = runf; prp[lane * 16 + i] = runp; runf += locf[i]; runp += locp[i]; }
        if (lane == 63) { pre[1024] = runf; prp[1024] = runp; }
    }
    __syncthreads();
    const int nfull = pre[1024], npart = prp[1024];
    int* ticket = (int*)(ws + WS_CNT) + 1024;
    int it_static = blockIdx.x; bool dyn = false;
    for (;;) {
        int idx = 0;
        if (!dyn) { if (it_static < nfull) { idx = it_static; it_static += gridDim.x; } else dyn = true; }
        if (dyn) {
            __syncthreads();
            if (tid == 0) nxt[0] = atomicAdd(ticket, 1);
            __syncthreads();
            idx = nxt[0];
            if (idx >= npart) break;
            idx += nfull;
        }
        int u, c;
        if (idx < nfull) { int lo = 0, hi = 1024; while (hi - lo > 1) { const int mid = (lo + hi) >> 1; if (pre[mid] <= idx) lo = mid; else hi = mid; } c = idx - pre[lo]; u = (lo & 15) * 64 + (lo >> 4); }
        else { const int j = idx - nfull; int lo = 0, hi = 1024; while (hi - lo > 1) { const int mid = (lo + hi) >> 1; if (prp[mid] <= j) lo = mid; else hi = mid; } u = (lo & 15) * 64 + (lo >> 4); c = cnt[u] / QCH; }
        const int bh = u >> 6, n = u & 63, b = bh >> 3, h = bh & 7;
        int tid = tid_, fr = fr_, fq = fq_; asm volatile("" : "+v"(tid), "+v"(fr), "+v"(fq));
        const int count = cnt[u], qbase = c * QCH;
        const int ntile = min(QCH / 16, (count - qbase + 15) >> 4);
        const unsigned* lp = list + (size_t)bh * LIST_PER_BH + list_base(n);
        const bf16_t* qb0 = proj + (size_t)(b * SEQ) * DIN + h * 128 + 8 * fq;
        int tile = wave;
        unsigned ent_c = 0u, ent_n = 0u;
        if (tile < ntile) ent_c = lp[min(qbase + tile * 16 + fr, count - 1)];
        if (tile + 8 < ntile) ent_n = lp[min(qbase + (tile + 8) * 16 + fr, count - 1)];
        __syncthreads();
        const bf16_t* Kg = proj + (size_t)(b * SEQ + n * 256) * DIN + C_K + h * 128;
        stage_kv(Kl, Vl, Kg, Kg + (C_V - C_K), DIN, tid, kmx);
        bf16x8 qc[4];
        { const bf16_t* qp = qb0 + (size_t)(ent_c & 0x3fffu) * DIN;
#pragma unroll
          for (int k = 0; k < 4; ++k) qc[k] = *(const bf16x8*)(qp + 32 * k); }
        float qn_c = qnorm(qc);
        __syncthreads();
        const float kmax = kmax_of(kmx);
        for (; tile < ntile; tile += 8) {
            bf16x8 qn[4]; unsigned ent_nn = 0u;
#pragma unroll
            for (int k = 0; k < 4; ++k) qn[k] = qc[k];
            if (tile + 8 < ntile) {
                const bf16_t* qp = qb0 + (size_t)(ent_n & 0x3fffu) * DIN;
#pragma unroll
                for (int k = 0; k < 4; ++k) qn[k] = *(const bf16x8*)(qp + 32 * k);
                if (tile + 16 < ntile) ent_nn = lp[min(qbase + (tile + 16) * 16 + fr, count - 1)];
            }
            const bool valid = qbase + tile * 16 + fr < count;
            const int sq = (int)(ent_c & 0x3fffu), slot = (int)(ent_c >> 14);
            const bool do_mask = __any(slot == 3);
            const int qrel = sq - n * 256;
            int smax = 8;
            if (do_mask) { int qm = qrel;
#pragma unroll
                for (int o = 1; o < 64; o <<= 1) qm = max(qm, __shfl_xor(qm, o));
                smax = min(8, (qm >> 5) + 1); }
            smax = __builtin_amdgcn_readfirstlane(smax);
            f32x4 oacc[8]; float mx, l;
            attn_core(Kl, Vl, qc, fr, fq, do_mask, qrel, smax, qn_c * kmax, oacc, mx, l);
            qn_c = qnorm(qn);
            __builtin_amdgcn_sched_barrier(0);
            if (valid) {
                const size_t pidx = ((size_t)bh * SEQ + sq) * 4 + slot;
                bf16_t* op = PO + pidx * 128 + 4 * fq;
#pragma unroll
                for (int dt = 0; dt < 8; ++dt) { u32x2 w; w.x = cvt_pk_bf16(oacc[dt][0], oacc[dt][1]); w.y = cvt_pk_bf16(oacc[dt][2], oacc[dt][3]); *(u32x2*)(op + 16 * dt) = w; }
                if (fq == 0) PML[pidx] = (f32x2){mx, l};
            }
            ent_c = ent_n; ent_n = ent_nn;
#pragma unroll
            for (int k = 0; k < 4; ++k) qc[k] = qn[k];
        }
    }
    const bf16_t* mkv = (const bf16_t*)(ws + WS_MKV);
    for (int item = blockIdx.x; item < BATCH * 4 * (SEQ / MQCH); item += gridDim.x) {
        const int c = item & 31, hm = (item >> 5) & 3, b = item >> 7;
        int tid = tid_, fr = fr_, fq = fq_; asm volatile("" : "+v"(tid), "+v"(fr), "+v"(fq));
        __syncthreads();
        const bf16_t* Kg = mkv + (size_t)(b * MEMLEN) * 1024 + hm * 128;
        stage_kv(Kl, Vl, Kg, Kg + 512, 1024, tid, kmx);
        const bf16_t* qb0 = proj + (size_t)(b * SEQ + c * MQCH + fr) * DIN + C_QME + hm * 128 + 8 * fq;
        bf16x8 qc[4];
#pragma unroll
        for (int k = 0; k < 4; ++k) qc[k] = *(const bf16x8*)(qb0 + (size_t)(wave * 16) * DIN + 32 * k);
        float qn_c = qnorm(qc);
        __syncthreads();
        const float kmax = kmax_of(kmx);
        for (int tile = wave; tile < MQCH / 16; tile += 8) {
            bf16x8 qn[4];
#pragma unroll
            for (int k = 0; k < 4; ++k) qn[k] = qc[k];
            if (tile + 8 < MQCH / 16) {
#pragma unroll
                for (int k = 0; k < 4; ++k) qn[k] = *(const bf16x8*)(qb0 + (size_t)((tile + 8) * 16) * DIN + 32 * k); }
            const int sq = c * MQCH + tile * 16 + fr; const size_t row = (size_t)(b * SEQ + sq);
            f32x4 oacc[8]; float mx, l;
            attn_core(Kl, Vl, qc, fr, fq, false, 0, 8, qn_c * kmax, oacc, mx, l);
            qn_c = qnorm(qn);
            __builtin_amdgcn_sched_barrier(0);
            const float rl = 1.f / l;
            const bf16_t* gp = proj + row * DIN + C_GME + hm * 128 + 4 * fq;
            bf16_t* yp = Y + row * DM + 1536 + hm * 128 + 4 * fq;
            u32x2 gv[8];
#pragma unroll
            for (int dt = 0; dt < 8; ++dt) gv[dt] = *(const u32x2*)(gp + 16 * dt);
            __builtin_amdgcn_sched_barrier(0);
#pragma unroll
            for (int dt = 0; dt < 8; ++dt) { const u32x2 g = gv[dt];
                u32x2 w; w.x = cvt_pk_bf16(oacc[dt][0] * rl * bflo(g.x), oacc[dt][1] * rl * bfhi(g.x)); w.y = cvt_pk_bf16(oacc[dt][2] * rl * bflo(g.y), oacc[dt][3] * rl * bfhi(g.y));
                *(u32x2*)(yp + 16 * dt) = w; }
#pragma unroll
            for (int k = 0; k < 4; ++k) qc[k] = qn[k];
        }
    }
    const bf16_t* wsb = (const bf16_t*)(ws + WS_WSB);
    for (int item = blockIdx.x; item < BATCH * (SEQ / 128); item += gridDim.x) {
        const size_t row0 = (size_t)item * 128;
        int fr = fr_, fq = fq_, lane = lane_; asm volatile("" : "+v"(fr), "+v"(fq), "+v"(lane));
        __syncthreads();
        {
            const f32x4 g0 = *(const f32x4*)(a.gln_g + 8 * lane), g1 = *(const f32x4*)(a.gln_g + 8 * lane + 4), b0 = *(const f32x4*)(a.gln_b + 8 * lane), b1 = *(const f32x4*)(a.gln_b + 8 * lane + 4);
            u32x4 raw[16];
#pragma unroll
            for (int i = 0; i < 16; ++i) raw[i] = *(const u32x4*)(proj + (row0 + wave + 8 * i) * DIN + C_VG + 8 * lane);
#pragma unroll
            for (int i = 0; i < 16; ++i) {
                const int tk = wave + 8 * i;
                float v[8] = {bflo(raw[i].x), bfhi(raw[i].x), bflo(raw[i].y), bfhi(raw[i].y), bflo(raw[i].z), bfhi(raw[i].z), bflo(raw[i].w), bfhi(raw[i].w)};
                float sm = 0.f;
#pragma unroll
                for (int e = 0; e < 8; ++e) sm += v[e];
#pragma unroll
                for (int o = 1; o < 64; o <<= 1) sm += __shfl_xor(sm, o);
                const float mu = sm * (1.f / 512.f); float q = 0.f;
#pragma unroll
                for (int e = 0; e < 8; ++e) { v[e] -= mu; q += v[e] * v[e]; }
#pragma unroll
                for (int o = 1; o < 64; o <<= 1) q += __shfl_xor(q, o);
                const float rstd = 1.f / sqrtf(q * (1.f / 512.f) + LN_EPS);
#pragma unroll
                for (int e = 0; e < 8; ++e) { const float o = v[e] * rstd * (e < 4 ? g0[e] : g1[e - 4]) + (e < 4 ? b0[e] : b1[e - 4]);
                    *(LAS bf16_t*)(lds + (8 * lane + e) * 272 + tk * 2) = (bf16_t)(cvt_pk_bf16(o, 0.f) & 0xffffu); }
            }
        }
        __syncthreads();
        const int g = wave >> 1, th = wave & 1;
        f32x4 acc[8][4];
#pragma unroll
        for (int ct = 0; ct < 8; ++ct)
#pragma unroll
            for (int tt = 0; tt < 4; ++tt) acc[ct][tt] = (f32x4){0.f, 0.f, 0.f, 0.f};
#pragma unroll
        for (int k = 0; k < 4; ++k) {
            bf16x8 wf[4];
#pragma unroll
            for (int tt = 0; tt < 4; ++tt) wf[tt] = *(const bf16x8*)(wsb + (size_t)(g * 128 + 64 * th + 16 * tt + fr) * 128 + 32 * k + 8 * fq);
#pragma unroll
            for (int ct = 0; ct < 8; ++ct) { const bf16x8 av = *(const LAS bf16x8*)(lds + (128 * g + 16 * ct + fr) * 272 + (32 * k + 8 * fq) * 2);
#pragma unroll
                for (int tt = 0; tt < 4; ++tt) acc[ct][tt] = __builtin_amdgcn_mfma_f32_16x16x32_bf16(av, wf[tt], acc[ct][tt], 0, 0, 0); }
        }
#pragma unroll
        for (int tt = 0; tt < 4; ++tt) { const int t = 64 * th + 16 * tt + fr; const float bs = a.b_s[g * 128 + t]; const size_t row = row0 + t;
            u32x2 uuv[8], ggv[8];
#pragma unroll
            for (int ct = 0; ct < 8; ++ct) { const int ch = 128 * g + 16 * ct + 4 * fq; uuv[ct] = *(const u32x2*)(proj + row * DIN + C_U + ch); ggv[ct] = *(const u32x2*)(proj + row * DIN + C_GG + ch); }
            __builtin_amdgcn_sched_barrier(0);
#pragma unroll
            for (int ct = 0; ct < 8; ++ct) { const int ch = 128 * g + 16 * ct + 4 * fq;
                const u32x2 uu = uuv[ct], gg = ggv[ct];
                const f32x4 m = acc[ct][tt] + bs;
                u32x2 w; w.x = cvt_pk_bf16(bflo(uu.x) * m[0] * bflo(gg.x), bfhi(uu.x) * m[1] * bfhi(gg.x)); w.y = cvt_pk_bf16(bflo(uu.y) * m[2] * bflo(gg.y), bfhi(uu.y) * m[3] * bfhi(gg.y));
                *(u32x2*)(Y + row * DM + 1024 + ch) = w; } }
    }
}

__device__ __forceinline__ void phase4(const Args& a) {
    unsigned char* ws = a.ws;
    const int tid = threadIdx.x, lane = tid & 63, wave = tid >> 6;
    const bf16_t* proj = (const bf16_t*)(ws + WS_PROJ);
    const bf16_t* PO = (const bf16_t*)(ws + WS_PO); const f32x2* PML = (const f32x2*)(ws + WS_PML);
    bf16_t* Y = (bf16_t*)(ws + WS_Y);
    const int rl_ = lane >> 3, d0 = (lane & 7) * 16;
    const int nw = gridDim.x * 8;
    for (int t0 = blockIdx.x * 8 + wave; t0 < 16 * (SEQ / 8); t0 += 2 * nw) {
        f32x2 ml[2][4]; u32x4 pp[2][4][2]; u32x4 gg[2][2];
#pragma unroll
        for (int r = 0; r < 2; ++r) {
            const int t = (t0 + r * nw < 16 * (SEQ / 8)) ? t0 + r * nw : t0;
            const int bh = 15 - t / (SEQ / 8), s = (t % (SEQ / 8)) * 8 + rl_, b = bh >> 3, h = bh & 7, qb = s >> 8, nv = qb < 3 ? qb : 3;
            const size_t pbase = ((size_t)bh * SEQ + s) * 4; const size_t row = (size_t)b * SEQ + s;
#pragma unroll
            for (int j = 0; j < 4; ++j) { const bool ok = (j == 3) || (j < nv);
                ml[r][j] = ok ? PML[pbase + j] : (f32x2){-INFINITY, 0.f};
                if (ok) { pp[r][j][0] = *(const u32x4*)(PO + (pbase + j) * 128 + d0); pp[r][j][1] = *(const u32x4*)(PO + (pbase + j) * 128 + d0 + 8); }
                else { pp[r][j][0] = (u32x4){0u, 0u, 0u, 0u}; pp[r][j][1] = pp[r][j][0]; } }
            gg[r][0] = *(const u32x4*)(proj + row * DIN + C_GMO + h * 128 + d0); gg[r][1] = *(const u32x4*)(proj + row * DIN + C_GMO + h * 128 + d0 + 8);
        }
        __builtin_amdgcn_sched_barrier(0);
#pragma unroll
        for (int r = 0; r < 2; ++r) {
            const int t = t0 + r * nw;
            if (t < 16 * (SEQ / 8)) {
                const int bh = 15 - t / (SEQ / 8), s = (t % (SEQ / 8)) * 8 + rl_, b = bh >> 3, h = bh & 7; const size_t row = (size_t)b * SEQ + s;
                float M = -INFINITY;
#pragma unroll
                for (int j = 0; j < 4; ++j) M = fmaxf(M, ml[r][j].x);
                float o[16]; float L = 0.f;
#pragma unroll
                for (int e = 0; e < 16; ++e) o[e] = 0.f;
#pragma unroll
                for (int j = 0; j < 4; ++j) { const float w = fast_exp2(ml[r][j].x - M); L += w * ml[r][j].y;
                    const u32x4 p0 = pp[r][j][0], p1 = pp[r][j][1];
                    o[0] += w * bflo(p0.x); o[1] += w * bfhi(p0.x); o[2] += w * bflo(p0.y); o[3] += w * bfhi(p0.y); o[4] += w * bflo(p0.z); o[5] += w * bfhi(p0.z); o[6] += w * bflo(p0.w); o[7] += w * bfhi(p0.w);
                    o[8] += w * bflo(p1.x); o[9] += w * bfhi(p1.x); o[10] += w * bflo(p1.y); o[11] += w * bfhi(p1.y); o[12] += w * bflo(p1.z); o[13] += w * bfhi(p1.z); o[14] += w * bflo(p1.w); o[15] += w * bfhi(p1.w); }
                const float rl = 1.f / L;
                const u32x4 g0 = gg[r][0], g1 = gg[r][1];
                u32x4 w0, w1;
                w0.x = cvt_pk_bf16(o[0] * rl * bflo(g0.x), o[1] * rl * bfhi(g0.x)); w0.y = cvt_pk_bf16(o[2] * rl * bflo(g0.y), o[3] * rl * bfhi(g0.y));
                w0.z = cvt_pk_bf16(o[4] * rl * bflo(g0.z), o[5] * rl * bfhi(g0.z)); w0.w = cvt_pk_bf16(o[6] * rl * bflo(g0.w), o[7] * rl * bfhi(g0.w));
                w1.x = cvt_pk_bf16(o[8] * rl * bflo(g1.x), o[9] * rl * bfhi(g1.x)); w1.y = cvt_pk_bf16(o[10] * rl * bflo(g1.y), o[11] * rl * bfhi(g1.y));
                w1.z = cvt_pk_bf16(o[12] * rl * bflo(g1.z), o[13] * rl * bfhi(g1.z)); w1.w = cvt_pk_bf16(o[14] * rl * bflo(g1.w), o[15] * rl * bfhi(g1.w));
                *(u32x4*)(Y + row * DM + h * 128 + d0) = w0; *(u32x4*)(Y + row * DM + h * 128 + d0 + 8) = w1;
            }
        }
        __builtin_amdgcn_sched_barrier(0);
    }
}

__device__ __forceinline__ void phase6(const Args& a) {
    const int tid = threadIdx.x, lane = tid & 63, wave = tid >> 6;
    const bf16_t* sub = (const bf16_t*)(a.ws + WS_SUB);
    for (int row = blockIdx.x * 8 + wave; row < MROWS; row += gridDim.x * 8) {
        const f32x4* xp = (const f32x4*)(a.x + (size_t)row * DM) + lane;
        const u32x2* sp = (const u32x2*)(sub + (size_t)row * DM) + lane;
        f32x4* rp = (f32x4*)(a.out + (size_t)row * DM) + lane;
        f32x4 v[8]; u32x2 sv[8]; float s = 0.f;
#pragma unroll
        for (int j = 0; j < 8; ++j) { v[j] = __builtin_nontemporal_load(xp + 64 * j); sv[j] = sp[64 * j]; }
#pragma unroll
        for (int j = 0; j < 8; ++j) { v[j] = v[j] * ALPHA + (f32x4){bflo(sv[j].x), bfhi(sv[j].x), bflo(sv[j].y), bfhi(sv[j].y)}; s += (v[j][0] + v[j][1]) + (v[j][2] + v[j][3]); }
#pragma unroll
        for (int o = 1; o < 64; o <<= 1) s += __shfl_xor(s, o);
        const float mu = s * (1.f / DM); float q = 0.f;
#pragma unroll
        for (int j = 0; j < 8; ++j) { v[j] = v[j] - mu; q += (v[j][0] * v[j][0] + v[j][1] * v[j][1]) + (v[j][2] * v[j][2] + v[j][3] * v[j][3]); }
#pragma unroll
        for (int o = 1; o < 64; o <<= 1) q += __shfl_xor(q, o);
        const float rstd = 1.f / sqrtf(q * (1.f / DM) + LN_EPS);
#pragma unroll
        for (int j = 0; j < 8; ++j) { const f32x4 g = ((const f32x4*)a.ln_g)[lane + 64 * j], bb = ((const f32x4*)a.ln_b)[lane + 64 * j]; __builtin_nontemporal_store(v[j] * rstd * g + bb, rp + 64 * j); }
    }
}

#define XB_TMO      128
#define XB_XCNT(j)  (256  + 64 * (j))
#define XB_XSUB(j)  (1280 + 64 * (j))
#define XB_XGEN(j)  (2304 + 64 * (j))
#define XB_TOP      3328
#define XB_TOPGEN   3392
#define XCD_BAR_WORDS 3456
#define XB_SPIN_CAP (1u << 18)
__device__ __forceinline__ unsigned xb_ld(unsigned* p)              { return __hip_atomic_load(p, __ATOMIC_RELAXED, __HIP_MEMORY_SCOPE_AGENT); }
__device__ __forceinline__ unsigned xb_add(unsigned* p, unsigned v) { return __hip_atomic_fetch_add(p, v, __ATOMIC_RELAXED, __HIP_MEMORY_SCOPE_AGENT); }
__device__ __forceinline__ unsigned xb_xcc_id() { return (unsigned)__builtin_amdgcn_s_getreg((3 << 11) | 20) & 0xFu; }
#define XB_SPIN(cond, bar) do { unsigned _sp = 0; while (cond) { __builtin_amdgcn_s_sleep(1); \
    if ((++_sp & 255u) == 0u) { if (xb_ld(&(bar)[XB_TMO])) break; if (_sp > XB_SPIN_CAP) { atomicAdd(&(bar)[XB_TMO], 1u); break; } } } } while (0)
struct XcdBarrier { unsigned* bar; unsigned x; volatile LAS unsigned* st; };
__device__ __forceinline__ XcdBarrier xcd_barrier_post(unsigned* bar, volatile LAS unsigned* st) {
    XcdBarrier b; b.bar = bar; b.x = xb_xcc_id(); b.st = st;
    if (threadIdx.x == 0) (void)xb_add(&bar[XB_XCNT(b.x)], 1u);
    return b;
}
__device__ __forceinline__ void xcd_barrier_complete(unsigned* bar, unsigned x, unsigned& nloc, unsigned& nx) {
    const unsigned G = gridDim.x * gridDim.y * gridDim.z;
    unsigned sum, cnt, mine, sp = 0u;
    for (;;) {
        sum = 0u; cnt = 0u; mine = 0u;
#pragma unroll
        for (unsigned j = 0; j < 16; ++j) { const unsigned c = xb_ld(&bar[XB_XCNT(j)]); sum += c; cnt += (c > 0u) ? 1u : 0u; mine = (j == x) ? c : mine; }
        if (sum == G) break;
        __builtin_amdgcn_s_sleep(1);
        if ((++sp & 255u) == 0u) { if (xb_ld(&bar[XB_TMO])) break; if (sp > XB_SPIN_CAP) { atomicAdd(&bar[XB_TMO], 1u); break; } }
    }
    nloc = mine > 0u ? mine : 1u; nx = cnt > 0u ? cnt : 1u;
}
__device__ __forceinline__ void xcd_barrier(const XcdBarrier& b) {
    asm volatile("s_waitcnt vmcnt(0)" ::: "memory");
    __syncthreads();
    if (threadIdx.x == 0) {
        unsigned* bar = b.bar;
        __builtin_amdgcn_s_waitcnt(0);
        unsigned nloc = b.st[0], nx = b.st[1];
        if (nloc == 0u) { xcd_barrier_complete(bar, b.x, nloc, nx); b.st[0] = nloc; b.st[1] = nx; }
        const unsigned old = xb_add(&bar[XB_XSUB(b.x)], 1u);
        const unsigned gen = old / nloc;
        if (old + 1u == (gen + 1u) * nloc) {
            __builtin_amdgcn_fence(__ATOMIC_RELEASE, "agent");
            asm volatile("s_waitcnt vmcnt(0)" ::: "memory");
            const unsigned og = xb_add(&bar[XB_TOP], 1u);
            const unsigned tg = og / nx;
            if (og + 1u == (tg + 1u) * nx) xb_add(&bar[XB_TOPGEN], 1u);
            else XB_SPIN(xb_ld(&bar[XB_TOPGEN]) == tg, bar);
            __builtin_amdgcn_fence(__ATOMIC_ACQUIRE, "agent");
            xb_add(&bar[XB_XGEN(b.x)], 1u);
            asm volatile("s_waitcnt vmcnt(0)" ::: "memory");
        } else {
            XB_SPIN(xb_ld(&bar[XB_XGEN(b.x)]) == gen, bar);
            __builtin_amdgcn_fence(__ATOMIC_ACQUIRE, "agent");
            asm volatile("s_waitcnt vmcnt(0)" ::: "memory");
        }
    }
    __syncthreads();
}

__global__ void __launch_bounds__(512, 2) hymba_fwd(Args a) {
    extern __shared__ __attribute__((aligned(16))) unsigned char lds_raw[];
    LAS unsigned char* lds = (LAS unsigned char*)lds_raw;
    unsigned char* ws = a.ws;
    const int lo = a.ph_lo, hi = a.ph_hi, G = gridDim.x;
#define IN(k) (lo <= (k) && (k) < hi)
#define SEAM(k) do { if (IN(k) && IN((k) + 1)) xcd_barrier(xbar); } while (0)
    volatile LAS unsigned* xst = (volatile LAS unsigned*)(lds + LDS_BYTES - 64);
    if (threadIdx.x < 2) xst[threadIdx.x] = 0u;
    __syncthreads();
    XcdBarrier xbar; xbar.bar = (unsigned*)(ws + WS_BAR); xbar.x = 0; xbar.st = xst;
    if (IN(0) && IN(1)) xbar = xcd_barrier_post((unsigned*)(ws + WS_BAR), xst);
    if (IN(0)) phase0(a, lds);
    SEAM(0);
    if (IN(1)) {
        { pg8::Gemm g{(const bf16_t*)(ws + WS_XB), (const bf16_t*)(ws + WS_WIN), MROWS, DIN, DM}; pg8::StaticOrder S; S.init(g.M, g.N, G, (int)blockIdx.x);
          EpiProj E{(bf16_t*)(ws + WS_PROJ), (const float*)(ws + WS_COS), (const float*)(ws + WS_SIN), (float*)(ws + WS_KSUM)};
          pg8::gemm_phase<EpiProj, pg8::StaticOrder, true, true>(lds, g, S, E); }
    }
    SEAM(1);
    if (IN(2)) phase2(a, lds);
    SEAM(2);
    if (IN(3)) phase3(a, lds);
    SEAM(3);
    if (IN(4)) phase4(a);
    SEAM(4);
    if (IN(5)) {
        pg8::Gemm g{(const bf16_t*)(ws + WS_Y), (const bf16_t*)(ws + WS_WOUT), MROWS, DM, DM}; pg8::StaticOrder S; S.init(g.M, g.N, G, (int)blockIdx.x);
        EpiPlain E{(bf16_t*)(ws + WS_SUB), DM};
        pg8::gemm_phase<EpiPlain, pg8::StaticOrder, true, true>(lds, g, S, E);
    }
    SEAM(5);
    if (IN(6)) phase6(a);
#undef IN
#undef SEAM
}

extern "C" void kernel_launch(void* const* d_in, const int* in_sizes, int n_in, void* d_out, int out_size, void* d_ws, size_t ws_size, hipStream_t stream) {
    static int grid = 0;
    if (grid == 0) {
        if (n_in != 12 || ws_size < WS_END) { fprintf(stderr, "kernel_launch: unexpected inputs (n_in %d, ws %zu)\n", n_in, ws_size); grid = -1; return; }
        int dev = 0, cus = 0, per_cu = 0;
        hipGetDevice(&dev); hipDeviceGetAttribute(&cus, hipDeviceAttributeMultiprocessorCount, dev);
        hipFuncSetAttribute((const void*)hymba_fwd, hipFuncAttributeMaxDynamicSharedMemorySize, LDS_BYTES);
        hipOccupancyMaxActiveBlocksPerMultiprocessor(&per_cu, (const void*)hymba_fwd, 512, LDS_BYTES);
        if (per_cu < 1) { fprintf(stderr, "kernel_launch: occupancy query reports %d blocks per CU\n", per_cu); per_cu = 1; }
        grid = cus * per_cu;
        (void)hipGetLastError();
    }
    if (grid < 0) return;
    Args a{};
    a.x = (const float*)d_in[0]; a.mem = (const float*)d_in[1]; a.pos = (const int*)d_in[2]; a.w_in = (const float*)d_in[3]; a.w_mkv = (const float*)d_in[4];
    a.gln_g = (const float*)d_in[5]; a.gln_b = (const float*)d_in[6]; a.w_s = (const float*)d_in[7]; a.b_s = (const float*)d_in[8]; a.w_out = (const float*)d_in[9];
    a.ln_g = (const float*)d_in[10]; a.ln_b = (const float*)d_in[11]; a.out = (float*)d_out; a.ws = (unsigned char*)d_ws;
#if MK_MULTI
    for (int p = 0; p < 7; ++p) { a.ph_lo = p; a.ph_hi = p + 1; hipLaunchKernelGGL(hymba_fwd, dim3(grid), dim3(512), LDS_BYTES, stream, a); }
#else
    a.ph_lo = 0; a.ph_hi = 7;
    (void)hipMemsetAsync((char*)d_ws + WS_BAR, 0, BAR_WORDS_N * 4, stream);
    void* args[] = {&a};
    hipError_t e = hipLaunchCooperativeKernel((const void*)hymba_fwd, dim3(grid), dim3(512), args, LDS_BYTES, stream);
    if (e != hipSuccess) fprintf(stderr, "cooperative launch failed: %s (grid %d)\n", hipGetErrorString(e), grid);
#endif
}
```

```cpp
#include <hip/hip_runtime.h>
#include <hip/hip_cooperative_groups.h>
#include <cstdio>
#include <cstdint>
namespace cg = cooperative_groups;

#ifndef MK_MULTI
#define MK_MULTI 0
#endif

#define LAS __attribute__((address_space(3)))
typedef unsigned short bf16_t;
typedef short bf16x8 __attribute__((ext_vector_type(8)));
typedef float f32x4 __attribute__((ext_vector_type(4)));
typedef float f32x2 __attribute__((ext_vector_type(2)));
typedef unsigned u32x4 __attribute__((ext_vector_type(4)));
typedef unsigned u32x2 __attribute__((ext_vector_type(2)));

constexpr int BATCH = 2, SEQ = 16384, DM = 2048, DIN = 6656, MROWS = BATCH * SEQ, NBLK = 64, MEMLEN = 256;
constexpr int C_K = 1024, C_V = 2048, C_GMO = 3072, C_U = 4096, C_VG = 4608, C_GG = 5120, C_QME = 5632, C_GME = 6144;
constexpr float QSCALE = 0.08838834764831845f * 1.4426950408889634f;
constexpr float ALPHA = 1.189207115002721f;
constexpr float LN_EPS = 1e-5f;
constexpr int LIST_PER_BH = 256 * 2080;
constexpr int QCH = 2048;
constexpr int MQCH = 512;

constexpr size_t MiB = 1u << 20;
constexpr size_t WS_CNT = 0;
constexpr size_t WS_BAR = 8192;
constexpr size_t WS_KSUM = 64 * 1024;
constexpr size_t WS_WIN = 1 * MiB;
constexpr size_t WS_WOUT = 28 * MiB;
constexpr size_t WS_WMKV = 36 * MiB;
constexpr size_t WS_WSB = 40 * MiB;
constexpr size_t WS_MEMB = 41 * MiB;
constexpr size_t WS_MKV = 43 * MiB;
constexpr size_t WS_COS = 44 * MiB;
constexpr size_t WS_SIN = 52 * MiB;
constexpr size_t WS_LIST = 60 * MiB;
constexpr size_t WS_PML = 96 * MiB;
constexpr size_t WS_Y = 104 * MiB;
constexpr size_t WS_PROJ = 232 * MiB;
constexpr size_t WS_PO = 648 * MiB;
constexpr size_t WS_SUB = 648 * MiB;
constexpr size_t WS_XB = 648 * MiB;
constexpr size_t WS_END = 904 * MiB;
constexpr int LDS_BYTES = 152 * 1024;
constexpr int BAR_WORDS_N = 3456;

namespace pg8 {
constexpr int BM = 256, BK = 64, HALF = 128, HTB = HALF * BK * 2, STAGE_BYTES = 8 * HTB, NXCD = 8, WGM = 8;
__host__ __device__ __forceinline__ int lds_byte(int r, int c) { const int st = (r >> 4) * 2 + (c >> 5), rr = r & 15, cc = c & 31, ob = rr * 64 + cc * 2; return st * 1024 + (ob ^ (((ob >> 9) & 1) << 5)); }
__host__ __device__ __forceinline__ void stage_rc(int b, int& R, int& C) { const int st = b / 1024, sb = b % 1024, swz = sb ^ (((sb >> 9) & 1) << 5); R = (st >> 1) * 16 + swz / 64; C = (st & 1) * 32 + (swz % 64) / 2; }
__host__ __device__ __forceinline__ int perm32(int rho) { const int n = rho >> 4, i = rho & 15; return 8 * (i >> 2) + 4 * n + (i & 3); }
struct Unit { int pm, pn; };
struct Gemm { const bf16_t* A; const bf16_t* Bt; int M, N, K; };
struct StaticOrder {
    int nM, nN, nwg, G, c;
    __host__ __device__ void init(int M, int N, int G_, int c_) { nM = M / BM; nN = N / BM; nwg = nM * nN; G = G_; c = c_; }
    __host__ __device__ bool next(int i, Unit& u) const {
        const long L = (long)i * G + c; if (L >= nwg) return false;
        int wgid = (int)L; { const int q = nwg / NXCD, r = nwg % NXCD, xcd = wgid % NXCD, off = wgid / NXCD; wgid = (xcd < r ? xcd * (q + 1) : r * (q + 1) + (xcd - r) * q) + off; }
        const int nig = WGM * nN, gid = wgid / nig, fm = gid * WGM, gsz = (nM - fm) < WGM ? (nM - fm) : WGM;
        u.pm = fm + ((wgid % nig) % gsz); u.pn = (wgid % nig) / gsz; return true;
    }
    __device__ __forceinline__ void a_ready(const Unit&) const {}
    __device__ __forceinline__ void done(const Unit&) const {}
};
__device__ __forceinline__ unsigned cvt_pk_bf16(float lo, float hi) { unsigned r; asm volatile("v_cvt_pk_bf16_f32 %0, %1, %2" : "=v"(r) : "v"(lo), "v"(hi)); return r; }

template <class Epi, class Sched, bool ALIGN_EPI = false, bool SP2 = false>
__device__ __forceinline__ void gemm_phase(LAS unsigned char* lds, const Gemm g, const Sched& S, const Epi& E) {
    const int tid = threadIdx.x, wid = __builtin_amdgcn_readfirstlane(tid >> 6), lane = tid & 63, wr = wid >> 2, wc = wid & 3, fr = lane & 15, fq = lane >> 4;
    const int K = g.K, nt = K / BK;
    unsigned voffA[2], voffB[2];
#pragma unroll
    for (int i = 0; i < 2; ++i) { int R, C; stage_rc(tid * 16 + i * 8192, R, C); const int Rb = Epi::PERM ? ((R & ~31) + perm32(R & 31)) : R;
        voffA[i] = (unsigned)(R * K + C) * 2u; voffB[i] = (unsigned)(Rb * K + C) * 2u; }
    const size_t kstep = (size_t)(BK * 2);
    const size_t hstep = (size_t)HALF * K * 2;
    const size_t tstep = 2 * hstep;
    const unsigned ldsw = (unsigned)wid * 1024u;
    const int aoff = lds_byte(wr * 64 + fr, fq * 8), boff = lds_byte(wc * 32 + fr, fq * 8);
#define PG8_SA(b, h) (((b) * 2 + (h)) * HTB)
#define PG8_SB(b, h) ((4 + (b) * 2 + (h)) * HTB)
#define PG8_STAGE(bufoff, gbase, voff) do { _Pragma("unroll") for (int _i = 0; _i < 2; ++_i) \
        __builtin_amdgcn_global_load_lds((const unsigned*)((const char*)(gbase) + (voff)[_i]), (LAS unsigned*)(lds + (bufoff) + ldsw + _i * 8192), 16, 0, 0); } while (0)
#define PG8_LDA(dst, b, h) do { _Pragma("unroll") for (int m = 0; m < 4; ++m) _Pragma("unroll") for (int k = 0; k < 2; ++k) dst[m][k] = *(const LAS bf16x8*)(lds + PG8_SA(b, h) + aoff + m * 2048 + k * 1024); } while (0)
#define PG8_LDB(dst, b, h) do { _Pragma("unroll") for (int n = 0; n < 2; ++n) _Pragma("unroll") for (int k = 0; k < 2; ++k) dst[n][k] = *(const LAS bf16x8*)(lds + PG8_SB(b, h) + boff + n * 2048 + k * 1024); } while (0)
#define PG8_MMA(ai, bj, At, Bt) do { __builtin_amdgcn_s_setprio(1); _Pragma("unroll") for (int m = 0; m < 4; ++m) _Pragma("unroll") for (int n = 0; n < 2; ++n) _Pragma("unroll") for (int k = 0; k < 2; ++k) \
        acc[ai][bj][m][n] = __builtin_amdgcn_mfma_f32_16x16x32_bf16(Bt[n][k], At[m][k], acc[ai][bj][m][n], 0, 0, 0); __builtin_amdgcn_s_setprio(0); } while (0)
#define PG8_WAIT_V(n) asm volatile("s_waitcnt vmcnt(" #n ")" ::: "memory")
#define PG8_WAIT_L(n) asm volatile("s_waitcnt lgkmcnt(" #n ")" ::: "memory")
#define PG8_BAR __builtin_amdgcn_s_barrier()
#define PG8_SCHED __builtin_amdgcn_sched_barrier(0)
    Unit cur, nxt; int ui = 0;
    if (!S.next(0, cur)) return;
    f32x4 acc[2][2][4][2];
#pragma unroll
    for (int a = 0; a < 2; ++a)
#pragma unroll
        for (int b = 0; b < 2; ++b)
#pragma unroll
            for (int m = 0; m < 4; ++m)
#pragma unroll
                for (int n = 0; n < 2; ++n) acc[a][b][m][n] = (f32x4){0.f, 0.f, 0.f, 0.f};
    bf16x8 At[4][2], B0[2][2], B1[2][2];
    const char* cA = (const char*)g.A + (size_t)cur.pm * tstep; const char* cB = (const char*)g.Bt + (size_t)cur.pn * tstep;
    S.a_ready(cur);
    if constexpr (SP2) {
        PG8_STAGE(PG8_SB(0, 0), cB, voffB); PG8_STAGE(PG8_SB(0, 1), cB + hstep, voffB); PG8_STAGE(PG8_SA(0, 0), cA, voffA); PG8_STAGE(PG8_SA(0, 1), cA + hstep, voffA);
        if (wr == 1) PG8_BAR;
        PG8_WAIT_V(2); PG8_BAR;
        PG8_STAGE(PG8_SB(1, 0), cB + kstep, voffB); PG8_STAGE(PG8_SA(1, 0), cA + kstep, voffA); PG8_STAGE(PG8_SB(1, 1), cB + hstep + kstep, voffB);
        PG8_WAIT_V(6); PG8_BAR;
    } else {
        PG8_STAGE(PG8_SB(0, 0), cB, voffB); PG8_STAGE(PG8_SA(0, 0), cA, voffA); PG8_STAGE(PG8_SB(0, 1), cB + hstep, voffB); PG8_STAGE(PG8_SA(0, 1), cA + hstep, voffA);
        if (wr == 1) PG8_BAR;
        PG8_WAIT_V(4); PG8_BAR;
        PG8_STAGE(PG8_SB(1, 0), cB + kstep, voffB); PG8_STAGE(PG8_SA(1, 0), cA + kstep, voffA); PG8_STAGE(PG8_SB(1, 1), cB + hstep + kstep, voffB);
        PG8_WAIT_V(6); PG8_BAR;
    }
    for (;;) {
        const bool has_next = S.next(ui + 1, nxt);
        const char* nA = has_next ? (const char*)g.A + (size_t)nxt.pm * tstep : cA; const char* nB = has_next ? (const char*)g.Bt + (size_t)nxt.pn * tstep : cB;
        for (int t = 0; t < nt; t += 2) {
            const bool last = (t == nt - 2);
            const char* a1 = cA + (size_t)(t + 1) * kstep;
            const char* a2 = last ? nA : cA + (size_t)(t + 2) * kstep; const char* b2 = last ? nB : cB + (size_t)(t + 2) * kstep;
            const char* a3 = a2 + kstep; const char* b3 = b2 + kstep;
            if (last && has_next) S.a_ready(nxt);
            if constexpr (SP2) {
            PG8_LDB(B0, 0, 0); PG8_LDB(B1, 0, 1); PG8_SCHED; PG8_LDA(At, 0, 0); PG8_STAGE(PG8_SA(1, 1), a1 + hstep, voffA);
            PG8_WAIT_V(8); PG8_WAIT_L(0); PG8_BAR; PG8_MMA(0, 0, At, B0); PG8_MMA(0, 1, At, B1); PG8_BAR; PG8_SCHED;
            PG8_LDA(At, 0, 1); PG8_STAGE(PG8_SB(0, 0), b2, voffB); PG8_STAGE(PG8_SB(0, 1), b2 + hstep, voffB); PG8_STAGE(PG8_SA(0, 0), a2, voffA);
            PG8_WAIT_V(8); PG8_WAIT_L(0); PG8_BAR; PG8_MMA(1, 0, At, B0); PG8_MMA(1, 1, At, B1); PG8_BAR; PG8_SCHED;
            PG8_LDB(B0, 1, 0); PG8_LDB(B1, 1, 1); PG8_SCHED; PG8_LDA(At, 1, 0); PG8_STAGE(PG8_SA(0, 1), a2 + hstep, voffA);
            PG8_WAIT_V(8); PG8_WAIT_L(0); PG8_BAR; PG8_MMA(0, 0, At, B0); PG8_MMA(0, 1, At, B1); PG8_BAR; PG8_SCHED;
            PG8_LDA(At, 1, 1); PG8_STAGE(PG8_SB(1, 0), b3, voffB); PG8_STAGE(PG8_SB(1, 1), b3 + hstep, voffB); PG8_STAGE(PG8_SA(1, 0), a3, voffA);
            PG8_WAIT_V(8); PG8_WAIT_L(0); PG8_BAR; PG8_MMA(1, 0, At, B0); PG8_MMA(1, 1, At, B1); PG8_BAR; PG8_SCHED;
            } else {
            PG8_LDB(B0, 0, 0); PG8_SCHED; PG8_LDA(At, 0, 0); PG8_STAGE(PG8_SA(1, 1), a1 + hstep, voffA);
            PG8_WAIT_L(8); PG8_BAR; PG8_WAIT_L(0); PG8_MMA(0, 0, At, B0); PG8_BAR; PG8_SCHED;
            PG8_LDB(B1, 0, 1); PG8_STAGE(PG8_SB(0, 0), b2, voffB);
            PG8_BAR; PG8_WAIT_L(0); PG8_MMA(0, 1, At, B1); PG8_BAR;
            PG8_LDA(At, 0, 1); PG8_STAGE(PG8_SA(0, 0), a2, voffA);
            PG8_BAR; PG8_WAIT_L(0); PG8_MMA(1, 0, At, B0); PG8_BAR; PG8_SCHED;
            PG8_STAGE(PG8_SB(0, 1), b2 + hstep, voffB);
            PG8_WAIT_V(6); PG8_BAR; PG8_MMA(1, 1, At, B1); PG8_BAR;
            PG8_LDB(B0, 1, 0); PG8_SCHED; PG8_LDA(At, 1, 0); PG8_STAGE(PG8_SA(0, 1), a2 + hstep, voffA);
            PG8_WAIT_L(8); PG8_BAR; PG8_WAIT_L(0); PG8_MMA(0, 0, At, B0); PG8_BAR; PG8_SCHED;
            PG8_LDB(B1, 1, 1); PG8_STAGE(PG8_SB(1, 0), b3, voffB);
            PG8_BAR; PG8_WAIT_L(0); PG8_MMA(0, 1, At, B1); PG8_BAR;
            PG8_LDA(At, 1, 1); PG8_STAGE(PG8_SA(1, 0), a3, voffA);
            PG8_BAR; PG8_WAIT_L(0); PG8_MMA(1, 0, At, B0); PG8_BAR; PG8_SCHED;
            PG8_STAGE(PG8_SB(1, 1), b3 + hstep, voffB);
            PG8_WAIT_V(6); PG8_BAR; PG8_MMA(1, 1, At, B1); PG8_BAR;
            }
        }
        if constexpr (ALIGN_EPI) { if (wr == 0) PG8_BAR; }
        E(acc, cur, wr, wc, fr, fq); S.done(cur);
        if (!has_next) break;
#pragma unroll
        for (int a = 0; a < 2; ++a)
#pragma unroll
            for (int b = 0; b < 2; ++b)
#pragma unroll
                for (int m = 0; m < 4; ++m)
#pragma unroll
                    for (int n = 0; n < 2; ++n) acc[a][b][m][n] = (f32x4){0.f, 0.f, 0.f, 0.f};
        cur = nxt; cA = nA; cB = nB; ++ui;
        if constexpr (ALIGN_EPI) { if (wr == 1) PG8_BAR; }
    }
    PG8_WAIT_V(0);
    if constexpr (!ALIGN_EPI) { if (wr == 0) PG8_BAR; }
    PG8_BAR;
#undef PG8_SA
#undef PG8_SB
#undef PG8_STAGE
#undef PG8_LDA
#undef PG8_LDB
#undef PG8_MMA
#undef PG8_WAIT_V
#undef PG8_WAIT_L
#undef PG8_BAR
#undef PG8_SCHED
}
}

using pg8::cvt_pk_bf16;
__device__ __forceinline__ float bf2f(unsigned short b) { return __builtin_bit_cast(float, (unsigned)b << 16); }
__device__ __forceinline__ float bflo(unsigned w) { return __builtin_bit_cast(float, w << 16); }
__device__ __forceinline__ float bfhi(unsigned w) { return __builtin_bit_cast(float, w & 0xffff0000u); }
__device__ __forceinline__ float fast_exp2(float x) { return __builtin_amdgcn_exp2f(x); }
__device__ __forceinline__ float fast_rcp(float x) { return __builtin_amdgcn_rcpf(x); }
__device__ __forceinline__ float silu_f(float x) { return x * fast_rcp(1.f + fast_exp2(-1.4426950408889634f * x)); }
__device__ __forceinline__ float gelu_tanh_f(float x) {
    const float t = x * (1.f + 0.044715f * x * x) * (-1.5957691216057308f * 1.4426950408889634f);
    return x * fast_rcp(1.f + fast_exp2(t));
}
#define LDS_WAIT() asm volatile("s_waitcnt lgkmcnt(0)" ::: "memory")

struct EpiProj {
    static constexpr bool PERM = true;
    bf16_t* O; const float* cosT; const float* sinT; float* ksum;
    __device__ __forceinline__ void operator()(const f32x4 (&acc)[2][2][4][2], const pg8::Unit& u, int wr, int wc, int fr, int fq) const {
        const int pn = u.pn;
        const int type = pn < 4 ? 0 : pn < 8 ? 1 : pn < 12 ? 2 : pn < 16 ? 3 : pn < 20 ? 4 : pn < 22 ? 3 : pn < 24 ? 5 : 3;
        const int row0 = u.pm * 256 + wr * 64 + fr;
        const int col0 = pn * 256 + wc * 32 + 8 * fq;
        float cs[2][8];
#pragma unroll
        for (int bj = 0; bj < 2; ++bj)
#pragma unroll
            for (int e = 0; e < 8; ++e) cs[bj][e] = 0.f;
#pragma unroll
        for (int ai = 0; ai < 2; ++ai) {
            f32x4 c4v[4], s4v[4];
#pragma unroll
            for (int m = 0; m < 4; ++m) { c4v[m] = (f32x4){1.f, 1.f, 1.f, 1.f}; s4v[m] = (f32x4){0.f, 0.f, 0.f, 0.f}; }
            if (type <= 1) {
#pragma unroll
                for (int m = 0; m < 4; ++m) { const size_t ro = (size_t)(row0 + ai * 128 + m * 16) * 64 + 16 * wc + 4 * fq; c4v[m] = *(const f32x4*)(cosT + ro); s4v[m] = *(const f32x4*)(sinT + ro); }
            }
            __builtin_amdgcn_sched_barrier(0);
#pragma unroll
            for (int m = 0; m < 4; ++m) {
                const int row = row0 + ai * 128 + m * 16;
                const f32x4 c4 = c4v[m], s4 = s4v[m];
                bf16_t* rowp = O + (size_t)row * DIN + col0;
#pragma unroll
                for (int bj = 0; bj < 2; ++bj) {
                    f32x4 v0 = acc[ai][bj][m][0], v1 = acc[ai][bj][m][1];
                    float o[8];
                    if (type <= 1) {
                        o[0] = v0[0] * c4[0] - v0[1] * s4[0]; o[1] = v0[1] * c4[0] + v0[0] * s4[0];
                        o[2] = v0[2] * c4[1] - v0[3] * s4[1]; o[3] = v0[3] * c4[1] + v0[2] * s4[1];
                        o[4] = v1[0] * c4[2] - v1[1] * s4[2]; o[5] = v1[1] * c4[2] + v1[0] * s4[2];
                        o[6] = v1[2] * c4[3] - v1[3] * s4[3]; o[7] = v1[3] * c4[3] + v1[2] * s4[3];
                        if (type == 0) {
#pragma unroll
                            for (int e = 0; e < 8; ++e) o[e] *= QSCALE;
                        } else {
#pragma unroll
                            for (int e = 0; e < 8; ++e) cs[bj][e] += o[e];
                        }
                    } else {
#pragma unroll
                        for (int e = 0; e < 4; ++e) { o[e] = v0[e]; o[4 + e] = v1[e]; }
                        if (type == 3) {
#pragma unroll
                            for (int e = 0; e < 8; ++e) o[e] = silu_f(o[e]);
                        } else if (type == 4) {
#pragma unroll
                            for (int e = 0; e < 8; ++e) o[e] = gelu_tanh_f(o[e]);
                        } else if (type == 5) {
#pragma unroll
                            for (int e = 0; e < 8; ++e) o[e] *= QSCALE;
                        }
                    }
                    u32x4 w; w.x = cvt_pk_bf16(o[0], o[1]); w.y = cvt_pk_bf16(o[2], o[3]); w.z = cvt_pk_bf16(o[4], o[5]); w.w = cvt_pk_bf16(o[6], o[7]);
                    __builtin_nontemporal_store(w, (u32x4*)(rowp + bj * 128));
                }
            }
            __builtin_amdgcn_sched_barrier(0);
        }
        if (type == 1) {
#pragma unroll
            for (int bj = 0; bj < 2; ++bj)
#pragma unroll
                for (int e = 0; e < 8; ++e) {
                    float v = cs[bj][e];
                    v += __shfl_xor(v, 1); v += __shfl_xor(v, 2); v += __shfl_xor(v, 4); v += __shfl_xor(v, 8);
                    cs[bj][e] = v;
                }
            if (fr == 0) {
                float* kp = ksum + (size_t)u.pm * 1024 + (pn - 4) * 256 + wc * 32 + 8 * fq;
#pragma unroll
                for (int bj = 0; bj < 2; ++bj)
#pragma unroll
                    for (int e = 0; e < 8; ++e) atomicAdd(kp + bj * 128 + e, cs[bj][e]);
            }
        }
    }
};
struct EpiPlain {
    static constexpr bool PERM = true;
    bf16_t* O; int ldc;
    __device__ __forceinline__ void operator()(const f32x4 (&acc)[2][2][4][2], const pg8::Unit& u, int wr, int wc, int fr, int fq) const {
        const int row0 = u.pm * 256 + wr * 64 + fr, col0 = u.pn * 256 + wc * 32 + 8 * fq;
#pragma unroll
        for (int ai = 0; ai < 2; ++ai)
#pragma unroll
            for (int m = 0; m < 4; ++m) { bf16_t* rowp = O + (size_t)(row0 + ai * 128 + m * 16) * ldc + col0;
#pragma unroll
                for (int bj = 0; bj < 2; ++bj) { const f32x4 v0 = acc[ai][bj][m][0], v1 = acc[ai][bj][m][1];
                    u32x4 w; w.x = cvt_pk_bf16(v0[0], v0[1]); w.y = cvt_pk_bf16(v0[2], v0[3]); w.z = cvt_pk_bf16(v1[0], v1[1]); w.w = cvt_pk_bf16(v1[2], v1[3]);
                    *(u32x4*)(rowp + bj * 128) = w; } }
    }
};
struct EpiResid {
    static constexpr bool PERM = true;
    const float* __restrict__ x; float* __restrict__ out;
    __device__ __forceinline__ void operator()(const f32x4 (&acc)[2][2][4][2], const pg8::Unit& u, int wr, int wc, int fr, int fq) const {
        const int row0 = u.pm * 256 + wr * 64 + fr, col0 = u.pn * 256 + wc * 32 + 8 * fq;
#pragma unroll
        for (int ai = 0; ai < 2; ++ai) {
            f32x4 xv[4][2][2];
#pragma unroll
            for (int m = 0; m < 4; ++m) { const size_t off = (size_t)(row0 + ai * 128 + m * 16) * DM + col0;
#pragma unroll
                for (int bj = 0; bj < 2; ++bj)
#pragma unroll
                    for (int n = 0; n < 2; ++n) xv[m][bj][n] = *(const f32x4*)(x + off + bj * 128 + 4 * n); }
            __builtin_amdgcn_sched_barrier(0);
#pragma unroll
            for (int m = 0; m < 4; ++m) { const size_t off = (size_t)(row0 + ai * 128 + m * 16) * DM + col0;
#pragma unroll
                for (int bj = 0; bj < 2; ++bj)
#pragma unroll
                    for (int n = 0; n < 2; ++n) *(f32x4*)(out + off + bj * 128 + 4 * n) = xv[m][bj][n] * ALPHA + acc[ai][bj][m][n]; }
            __builtin_amdgcn_sched_barrier(0);
        }
    }
};

struct Args { const float* x; const float* mem; const int* pos; const float* w_in; const float* w_mkv; const float* gln_g; const float* gln_b;
              const float* w_s; const float* b_s; const float* w_out; const float* ln_g; const float* ln_b; float* out; unsigned char* ws; int ph_lo, ph_hi; };

__device__ __forceinline__ void p0_transpose_item(const float* W, int K, int N, bf16_t* WT, bool permute_qk, LAS float* scr, int item, int lane) {
    const int nblk = N / 32, kb = item / nblk, nb = item % nblk, k0 = 64 * kb, n0 = 32 * nb;
    const int ncol = n0 + (lane & 31);
    int src = ncol;
    if (permute_qk && ncol < 2048) { const int p = ncol & 127; src = (ncol & ~127) + ((p & 1) << 6) + (p >> 1); }
#pragma unroll 8
    for (int i = 0; i < 32; ++i) { const int kk = 2 * i + (lane >> 5); scr[kk * 33 + (lane & 31)] = W[(size_t)(k0 + kk) * N + src]; }
    LDS_WAIT();
    const int c = lane & 7;
#pragma unroll
    for (int j = 0; j < 4; ++j) { const int n = (lane >> 3) + 8 * j; const LAS float* s = scr + (8 * c) * 33 + n;
        u32x4 o; o.x = cvt_pk_bf16(s[0 * 33], s[1 * 33]); o.y = cvt_pk_bf16(s[2 * 33], s[3 * 33]); o.z = cvt_pk_bf16(s[4 * 33], s[5 * 33]); o.w = cvt_pk_bf16(s[6 * 33], s[7 * 33]);
        *(u32x4*)(WT + (size_t)(n0 + n) * K + k0 + 8 * c) = o; }
    LDS_WAIT();
}

__device__ __forceinline__ void phase0(const Args& a, LAS unsigned char* lds) {
    unsigned char* ws = a.ws;
    const int tid = threadIdx.x, lane = tid & 63, wave = tid >> 6;
    const int G = gridDim.x;
    const size_t gtid = (size_t)blockIdx.x * 512 + tid, NT = (size_t)G * 512;
    { int* cnt = (int*)(ws + WS_CNT); for (size_t i = gtid; i < 1088; i += NT) cnt[i] = 0;
      float* ks = (float*)(ws + WS_KSUM); for (size_t i = gtid; i < 128 * 1024; i += NT) ks[i] = 0.f; }
    { LAS float* scr = (LAS float*)(lds + wave * 16384);
      const int gw = blockIdx.x * 8 + wave, NGW = G * 8;
      constexpr int I_IN = (DM / 64) * (DIN / 32), I_OUT = (DM / 64) * (DM / 32), I_MKV = (DM / 64) * (1024 / 32);
      for (int it = gw; it < I_IN + I_OUT + I_MKV; it += NGW) {
          int r = it;
          if (r < I_IN) { p0_transpose_item(a.w_in, DM, DIN, (bf16_t*)(ws + WS_WIN), true, scr, r, lane); continue; } r -= I_IN;
          if (r < I_OUT) { p0_transpose_item(a.w_out, DM, DM, (bf16_t*)(ws + WS_WOUT), false, scr, r, lane); continue; } r -= I_OUT;
          p0_transpose_item(a.w_mkv, DM, 1024, (bf16_t*)(ws + WS_WMKV), false, scr, r, lane);
      } }
    { const size_t n8 = (size_t)MROWS * DM / 8; u32x4* xb = (u32x4*)(ws + WS_XB);
      for (size_t i0 = gtid; i0 < n8; i0 += 4 * NT) {
          f32x4 v[4][2];
#pragma unroll
          for (int j = 0; j < 4; ++j) { const size_t i = i0 + j * NT; if (i < n8) { v[j][0] = __builtin_nontemporal_load((const f32x4*)a.x + 2 * i); v[j][1] = __builtin_nontemporal_load((const f32x4*)a.x + 2 * i + 1); } }
          __builtin_amdgcn_sched_barrier(0);
#pragma unroll
          for (int j = 0; j < 4; ++j) { const size_t i = i0 + j * NT; if (i < n8) { const f32x4 v0 = v[j][0], v1 = v[j][1];
              u32x4 o; o.x = cvt_pk_bf16(v0[0], v0[1]); o.y = cvt_pk_bf16(v0[2], v0[3]); o.z = cvt_pk_bf16(v1[0], v1[1]); o.w = cvt_pk_bf16(v1[2], v1[3]); xb[i] = o; } }
          __builtin_amdgcn_sched_barrier(0);
      }
      const size_t m8 = (size_t)BATCH * MEMLEN * DM / 8; u32x4* mb = (u32x4*)(ws + WS_MEMB);
      for (size_t i = gtid; i < m8; i += NT) { const f32x4 v0 = ((const f32x4*)a.mem)[2 * i], v1 = ((const f32x4*)a.mem)[2 * i + 1];
          u32x4 o; o.x = cvt_pk_bf16(v0[0], v0[1]); o.y = cvt_pk_bf16(v0[2], v0[3]); o.z = cvt_pk_bf16(v1[0], v1[1]); o.w = cvt_pk_bf16(v1[2], v1[3]); mb[i] = o; } }
    { bf16_t* wsb = (bf16_t*)(ws + WS_WSB);
      for (size_t i = gtid; i < 4 * 128 * 128; i += NT) { const int t = (int)(i >> 7) & 127, s = (int)i & 127; const float v = s <= t ? a.w_s[i] : 0.f; wsb[i] = (bf16_t)(cvt_pk_bf16(v, 0.f) & 0xffffu); } }
    { float* cT = (float*)(ws + WS_COS); float* sT = (float*)(ws + WS_SIN);
      LAS float* invf = (LAS float*)(lds + 8 * 16384);
      if (tid < 64) invf[tid] = (float)exp2(-(double)tid * (13.287712379549449 / 64.0));
      __syncthreads();
      for (size_t e = gtid; e < (size_t)MROWS * 64; e += NT) { const int row = (int)(e >> 6), i = (int)e & 63;
          const float inv = invf[i];
          const float ang = (float)a.pos[row] * inv;
          const double rev = (double)ang * 0.15915494309189535; const float fr = (float)(rev - rint(rev));
          cT[e] = __builtin_amdgcn_cosf(fr); sT[e] = __builtin_amdgcn_sinf(fr); } }
}

__device__ __forceinline__ int list_base(int n) { return 256 * (64 * n - (n * (n - 1)) / 2); }
__device__ __forceinline__ unsigned long long shfl_xor_u64(unsigned long long v, int m) {
    unsigned lo = (unsigned)v, hi = (unsigned)(v >> 32); lo = __shfl_xor(lo, m); hi = __shfl_xor(hi, m); return ((unsigned long long)hi << 32) | lo; }

__device__ __forceinline__ void phase2(const Args& a, LAS unsigned char* lds) {
    unsigned char* ws = a.ws;
    const int tid = threadIdx.x, lane = tid & 63, wave = __builtin_amdgcn_readfirstlane(tid >> 6), fr = lane & 15, fq = lane >> 4;
    const bf16_t* proj = (const bf16_t*)(ws + WS_PROJ);
    const float* ksum = (const float*)(ws + WS_KSUM);
    int* cnt = (int*)(ws + WS_CNT);
    unsigned* list = (unsigned*)(ws + WS_LIST);
    LAS unsigned char* Kl = lds;
    LAS int* lcnt = (LAS int*)(lds + 16384);
    LAS int* gbase = (LAS int*)(lds + 16384 + 256);
    { const bf16_t* memb = (const bf16_t*)(ws + WS_MEMB); const bf16_t* wt = (const bf16_t*)(ws + WS_WMKV); bf16_t* mkv = (bf16_t*)(ws + WS_MKV);
      for (int t = blockIdx.x; t < 256; t += gridDim.x) {
          const int m0 = (t & 15) * 32 + 16 * (wave & 1), n0 = (t >> 4) * 64 + 16 * (wave >> 1);
          const bf16_t* ap = wt + (size_t)(n0 + fr) * DM + 8 * fq; const bf16_t* bp = memb + (size_t)(m0 + fr) * DM + 8 * fq;
          f32x4 acc = (f32x4){0.f, 0.f, 0.f, 0.f};
          bf16x8 av[8], bv[8], an[8], bn[8];
#pragma unroll
          for (int i = 0; i < 8; ++i) { av[i] = *(const bf16x8*)(ap + 32 * i); bv[i] = *(const bf16x8*)(bp + 32 * i); }
#pragma unroll 1
          for (int kb = 0; kb < 8; ++kb) {
              const int kn = kb < 7 ? kb + 1 : kb;
#pragma unroll
              for (int i = 0; i < 8; ++i) { an[i] = *(const bf16x8*)(ap + 32 * (8 * kn + i)); bn[i] = *(const bf16x8*)(bp + 32 * (8 * kn + i)); }
              __builtin_amdgcn_sched_barrier(0);
#pragma unroll
              for (int i = 0; i < 8; ++i) acc = __builtin_amdgcn_mfma_f32_16x16x32_bf16(av[i], bv[i], acc, 0, 0, 0);
              __builtin_amdgcn_sched_barrier(0);
#pragma unroll
              for (int i = 0; i < 8; ++i) { av[i] = an[i]; bv[i] = bn[i]; }
          }
          u32x2 w; w.x = cvt_pk_bf16(acc[0], acc[1]); w.y = cvt_pk_bf16(acc[2], acc[3]);
          *(u32x2*)(mkv + (size_t)(m0 + fr) * 1024 + n0 + 4 * fq) = w; } }
    LAS int* pend_n = (LAS int*)(lds + 18432);
    LAS int* pend_lp = (LAS int*)(lds + 18432 + 16384);
    LAS int* lcnt4 = (LAS int*)(lds + 16384);
    LAS int* gbase4 = (LAS int*)(lds + 16384 + 1024);
    for (int grp = blockIdx.x; grp < 256; grp += gridDim.x) {
        const int bh = grp >> 4, qb0 = (grp & 15) * 4, b = bh >> 3, h = bh & 7;
        { const int n = tid >> 3, c2 = tid & 7; const float* kp = ksum + (size_t)(b * 64 + n) * 1024 + h * 128 + c2 * 16;
          const f32x4 v0 = *(const f32x4*)kp, v1 = *(const f32x4*)(kp + 4), v2 = *(const f32x4*)(kp + 8), v3 = *(const f32x4*)(kp + 12);
          u32x4 w0, w1; w0.x = cvt_pk_bf16(v0[0], v0[1]); w0.y = cvt_pk_bf16(v0[2], v0[3]); w0.z = cvt_pk_bf16(v1[0], v1[1]); w0.w = cvt_pk_bf16(v1[2], v1[3]);
          w1.x = cvt_pk_bf16(v2[0], v2[1]); w1.y = cvt_pk_bf16(v2[2], v2[3]); w1.z = cvt_pk_bf16(v3[0], v3[1]); w1.w = cvt_pk_bf16(v3[2], v3[3]);
          *(LAS u32x4*)(Kl + n * 256 + (((2 * c2) ^ (n & 15)) << 4)) = w0; *(LAS u32x4*)(Kl + n * 256 + (((2 * c2 + 1) ^ (n & 15)) << 4)) = w1;
          if (tid < 256) lcnt4[tid] = 0; }
        const bf16_t* qbase = proj + (size_t)(b * SEQ + wave * 32 + fr) * DIN + h * 128 + 8 * fq;
        bf16x8 qcur[2][4];
#pragma unroll
        for (int tt = 0; tt < 2; ++tt)
#pragma unroll
            for (int k = 0; k < 4; ++k) qcur[tt][k] = *(const bf16x8*)(qbase + (size_t)(qb0 * 256 + tt * 16) * DIN + 32 * k);
        __syncthreads();
#pragma unroll 1
        for (int kk = 0; kk < 4; ++kk) {
            const int qb = qb0 + kk;
            bf16x8 qnxt[2][4];
            { const int qbn = kk < 3 ? qb + 1 : qb;
#pragma unroll
              for (int tt = 0; tt < 2; ++tt)
#pragma unroll
                  for (int k = 0; k < 4; ++k) qnxt[tt][k] = *(const bf16x8*)(qbase + (size_t)(qbn * 256 + tt * 16) * DIN + 32 * k); }
#pragma unroll
            for (int tt = 0; tt < 2; ++tt) {
                unsigned long long best0 = 0ull, best1 = 0ull, best2 = 0ull;
#pragma unroll
                for (int nt = 0; nt < 4; ++nt) {
                    if (16 * nt < qb) {
                        f32x4 g = (f32x4){0.f, 0.f, 0.f, 0.f};
#pragma unroll
                        for (int k = 0; k < 4; ++k) { const bf16x8 av = *(const LAS bf16x8*)(Kl + (16 * nt + fr) * 256 + (((4 * k + fq) ^ fr) << 4)); g = __builtin_amdgcn_mfma_f32_16x16x32_bf16(av, qcur[tt][k], g, 0, 0, 0); }
#pragma unroll
                        for (int j = 0; j < 4; ++j) { const int n = 16 * nt + 4 * fq + j;
                            const float gj = j == 0 ? g.x : j == 1 ? g.y : j == 2 ? g.z : g.w; const unsigned bits = __float_as_uint(gj); const unsigned ord = (bits & 0x80000000u) ? ~bits : (bits | 0x80000000u);
                            unsigned long long key = n < qb ? (((unsigned long long)ord << 32) | (unsigned)(63 - n)) : 0ull;
                            if (key > best0) { const unsigned long long t = best0; best0 = key; key = t; }
                            if (key > best1) { const unsigned long long t = best1; best1 = key; key = t; }
                            if (key > best2) { best2 = key; } }
                    }
                }
                int ptr = 0; int myn = -1;
#pragma unroll
                for (int r = 0; r < 3; ++r) {
                    const unsigned long long cand = ptr == 0 ? best0 : ptr == 1 ? best1 : ptr == 2 ? best2 : 0ull;
                    unsigned long long g = cand; { const unsigned long long o = shfl_xor_u64(g, 16); g = o > g ? o : g; } { const unsigned long long o = shfl_xor_u64(g, 32); g = o > g ? o : g; }
                    if (g != 0ull && cand == g) ++ptr;
                    if (fq == r && g != 0ull) myn = 63 - (int)(unsigned)(g & 0xffffffffull);
                }
                if (fq == 3) myn = qb;
                int lp = 0;
                if (myn >= 0) lp = __hip_atomic_fetch_add(lcnt4 + kk * 64 + myn, 1, __ATOMIC_RELAXED, __HIP_MEMORY_SCOPE_WORKGROUP);
                pend_n[(kk * 2 + tt) * 512 + tid] = myn; pend_lp[(kk * 2 + tt) * 512 + tid] = lp;
            }
#pragma unroll
            for (int tt = 0; tt < 2; ++tt)
#pragma unroll
                for (int k = 0; k < 4; ++k) qcur[tt][k] = qnxt[tt][k];
        }
        __syncthreads();
        if (tid < 256) { const int c = lcnt4[tid]; gbase4[tid] = c ? atomicAdd(cnt + bh * 64 + (tid & 63), c) : 0; }
        __syncthreads();
#pragma unroll 1
        for (int e = 0; e < 8; ++e) { const int kk = e >> 1, tt = e & 1; const int myn = pend_n[e * 512 + tid];
            if (myn >= 0) { const int s = (qb0 + kk) * 256 + (wave * 2 + tt) * 16 + fr;
                list[(size_t)bh * LIST_PER_BH + list_base(myn) + gbase4[kk * 64 + myn] + pend_lp[e * 512 + tid]] = (unsigned)s | ((unsigned)fq << 14); } }
        __syncthreads();
    }
}

__device__ __forceinline__ float sq8(u32x4 v) {
    const float a = bflo(v.x), b = bfhi(v.x), c = bflo(v.y), d = bfhi(v.y), e = bflo(v.z), f = bfhi(v.z), g = bflo(v.w), h = bfhi(v.w);
    return ((a * a + b * b) + (c * c + d * d)) + ((e * e + f * f) + (g * g + h * h)); }
__device__ __forceinline__ void stage_kv(LAS unsigned char* Kl, LAS unsigned char* Vl, const bf16_t* Kg, const bf16_t* Vg, int stride, int tid, LAS float* kmx) {
    float nmax = 0.f;
#pragma unroll
    for (int it = 0; it < 8; ++it) { const int q = tid + 512 * it, c = q & 15, r = q >> 4;
        const u32x4 v = *(const u32x4*)(Kg + (size_t)r * stride + 8 * c);
        *(LAS u32x4*)(Kl + r * 256 + ((c ^ (r & 15)) << 4)) = v;
        float n2 = sq8(v); n2 += __shfl_xor(n2, 1); n2 += __shfl_xor(n2, 2); n2 += __shfl_xor(n2, 4); n2 += __shfl_xor(n2, 8);
        nmax = fmaxf(nmax, n2); }
    nmax = fmaxf(nmax, __shfl_xor(nmax, 16)); nmax = fmaxf(nmax, __shfl_xor(nmax, 32));
    if ((tid & 63) == 0) kmx[tid >> 6] = nmax;
#pragma unroll
    for (int it = 0; it < 4; ++it) { const int q = tid + 512 * it, c = q & 15, kp = q >> 4, kq = 2 * kp;
        const int key = (kq & 0xE0) | (((kq >> 2) & 1) << 4) | (((kq >> 3) & 3) << 2) | (kq & 3);
        const u32x4 v0 = *(const u32x4*)(Vg + (size_t)key * stride + 8 * c), v1 = *(const u32x4*)(Vg + (size_t)(key + 1) * stride + 8 * c);
        const unsigned a0[4] = {v0.x, v0.y, v0.z, v0.w}, a1[4] = {v1.x, v1.y, v1.z, v1.w};
#pragma unroll
        for (int i = 0; i < 8; ++i) { const int d = 8 * c + i;
            const unsigned lo = (i & 1) ? (a0[i >> 1] >> 16) : (a0[i >> 1] & 0xffffu), hi = (i & 1) ? (a1[i >> 1] & 0xffff0000u) : (a1[i >> 1] << 16);
            *(LAS unsigned*)(Vl + d * 512 + ((((kq >> 3)) ^ (d & 15)) << 4) + (kq & 7) * 2) = lo | hi; } }
}
__device__ __forceinline__ float kmax_of(const LAS float* kmx) {
    float m = kmx[0];
#pragma unroll
    for (int i = 1; i < 8; ++i) m = fmaxf(m, kmx[i]);
    return sqrtf(m) * 1.002f; }

__device__ __forceinline__ float qnorm(const bf16x8 (&qf)[4]) {
    float qq = 0.f;
#pragma unroll
    for (int k = 0; k < 4; ++k) qq += sq8(__builtin_bit_cast(u32x4, qf[k]));
    qq += __shfl_xor(qq, 16); qq += __shfl_xor(qq, 32);
    return sqrtf(qq); }
#define AT_SCHED() __builtin_amdgcn_sched_barrier(0)
#define AT_LOADK(S) do { _Pragma("unroll") for (int k = 0; k < 4; ++k) { kf[2 * k] = *(const LAS bf16x8*)(Kl + kb[k] + (S) * 8192); kf[2 * k + 1] = *(const LAS bf16x8*)(Kl + kb[k] + (S) * 8192 + 4096); } } while (0)
#define AT_LOADV(S) do { const unsigned vb = (unsigned)fr * 512u + ((unsigned)((4 * (S) + fq) ^ fr) << 4); _Pragma("unroll") for (int dt = 0; dt < 8; ++dt) vf[dt] = *(const LAS bf16x8*)(Vl + vb + dt * 8192); } while (0)
__device__ __forceinline__ void attn_core(const LAS unsigned char* Kl, const LAS unsigned char* Vl, const bf16x8 (&qf)[4], int fr, int fq, bool do_mask, int qrel, int smax, float kmax,
                                          f32x4 (&oacc)[8], float& m_out, float& l_out) {
    asm volatile("" : "+v"(fr), "+v"(fq));
    unsigned kb[4];
#pragma unroll
    for (int k = 0; k < 4; ++k) kb[k] = (unsigned)fr * 256u + ((unsigned)((4 * k + fq) ^ fr) << 4);
    bf16x8 kf[8], vf[8];
    AT_LOADK(0); AT_LOADV(0);
    const float m = kmax;
    float l = 0.f;
#pragma unroll
    for (int dt = 0; dt < 8; ++dt) oacc[dt] = (f32x4){0.f, 0.f, 0.f, 0.f};
    f32x4 c0 = (f32x4){-m, -m, -m, -m}, c1 = c0;
    AT_SCHED();
#pragma unroll
    for (int k = 0; k < 4; ++k) { c0 = __builtin_amdgcn_mfma_f32_16x16x32_bf16(kf[2 * k], qf[k], c0, 0, 0, 0); c1 = __builtin_amdgcn_mfma_f32_16x16x32_bf16(kf[2 * k + 1], qf[k], c1, 0, 0, 0); }
    AT_SCHED();
    if (1 < smax) AT_LOADK(1);
#pragma unroll
    for (int s = 0; s < 8; ++s) {
        if (s < smax) {
            AT_SCHED();
            f32x4 n0 = (f32x4){-m, -m, -m, -m}, n1 = n0;
            if (s + 1 < smax) {
#pragma unroll
                for (int k = 0; k < 4; ++k) { n0 = __builtin_amdgcn_mfma_f32_16x16x32_bf16(kf[2 * k], qf[k], n0, 0, 0, 0); n1 = __builtin_amdgcn_mfma_f32_16x16x32_bf16(kf[2 * k + 1], qf[k], n1, 0, 0, 0); }
            }
            AT_SCHED();
            if (s + 2 < smax) AT_LOADK(s + 2);
            AT_SCHED();
            float p[8] = {c0.x, c0.y, c0.z, c0.w, c1.x, c1.y, c1.z, c1.w};
            if (do_mask) {
#pragma unroll
                for (int j = 0; j < 4; ++j) { if (32 * s + 4 * fq + j > qrel) p[j] = -INFINITY; if (32 * s + 16 + 4 * fq + j > qrel) p[4 + j] = -INFINITY; }
            }
#pragma unroll
            for (int j = 0; j < 8; ++j) p[j] = fast_exp2(p[j]);
            l += ((p[0] + p[1]) + (p[2] + p[3])) + ((p[4] + p[5]) + (p[6] + p[7]));
            u32x4 w; w.x = cvt_pk_bf16(p[0], p[1]); w.y = cvt_pk_bf16(p[2], p[3]); w.z = cvt_pk_bf16(p[4], p[5]); w.w = cvt_pk_bf16(p[6], p[7]);
            const bf16x8 pb = __builtin_bit_cast(bf16x8, w);
            AT_SCHED();
#pragma unroll
            for (int dt = 0; dt < 8; ++dt) oacc[dt] = __builtin_amdgcn_mfma_f32_16x16x32_bf16(vf[dt], pb, oacc[dt], 0, 0, 0);
            AT_SCHED();
            if (s + 1 < smax) AT_LOADV(s + 1);
            c0 = n0; c1 = n1;
        }
    }
    AT_SCHED();
    l += __shfl_xor(l, 16); l += __shfl_xor(l, 32);
    m_out = m; l_out = l;
}

__device__ __forceinline__ void phase3(const Args& a, LAS unsigned char* lds) {
    unsigned char* ws = a.ws;
    const int tid = threadIdx.x, lane = tid & 63, wave = __builtin_amdgcn_readfirstlane(tid >> 6), fr = lane & 15, fq = lane >> 4;
    const int fr_ = fr, fq_ = fq, lane_ = lane, tid_ = tid;
    const bf16_t* proj = (const bf16_t*)(ws + WS_PROJ);
    const int* cnt = (const int*)(ws + WS_CNT);
    const unsigned* list = (const unsigned*)(ws + WS_LIST);
    bf16_t* PO = (bf16_t*)(ws + WS_PO); f32x2* PML = (f32x2*)(ws + WS_PML);
    bf16_t* Y = (bf16_t*)(ws + WS_Y);
    LAS unsigned char* Kl = lds; LAS unsigned char* Vl = lds + 65536;
    LAS int* pre = (LAS int*)(lds + 131072);
    LAS float* kmx = (LAS float*)(lds + 131072 + 12288);
    const bf16_t* mkv = (const bf16_t*)(ws + WS_MKV);
    for (int item = blockIdx.x; item < BATCH * 4 * (SEQ / MQCH); item += gridDim.x) {
        const int c = item & 31, hm = (item >> 5) & 3, b = item >> 7;
        int tid = tid_, fr = fr_, fq = fq_; asm volatile("" : "+v"(tid), "+v"(fr), "+v"(fq));
        __syncthreads();
        const bf16_t* Kg = mkv + (size_t)(b * MEMLEN) * 1024 + hm * 128;
        stage_kv(Kl, Vl, Kg, Kg + 512, 1024, tid, kmx);
        const bf16_t* qb0 = proj + (size_t)(b * SEQ + c * MQCH + fr) * DIN + C_QME + hm * 128 + 8 * fq;
        bf16x8 qc[4];
#pragma unroll
        for (int k = 0; k < 4; ++k) qc[k] = *(const bf16x8*)(qb0 + (size_t)(wave * 16) * DIN + 32 * k);
        float qn_c = qnorm(qc);
        __syncthreads();
        const float kmax = kmax_of(kmx);
        for (int tile = wave; tile < MQCH / 16; tile += 8) {
            bf16x8 qn[4];
#pragma unroll
            for (int k = 0; k < 4; ++k) qn[k] = qc[k];
            if (tile + 8 < MQCH / 16) {
#pragma unroll
                for (int k = 0; k < 4; ++k) qn[k] = *(const bf16x8*)(qb0 + (size_t)((tile + 8) * 16) * DIN + 32 * k); }
            const int sq = c * MQCH + tile * 16 + fr; const size_t row = (size_t)(b * SEQ + sq);
            f32x4 oacc[8]; float mx, l;
            attn_core(Kl, Vl, qc, fr, fq, false, 0, 8, qn_c * kmax, oacc, mx, l);
            qn_c = qnorm(qn);
            __builtin_amdgcn_sched_barrier(0);
            const float rl = 1.f / l;
            const bf16_t* gp = proj + row * DIN + C_GME + hm * 128 + 4 * fq;
            bf16_t* yp = Y + row * DM + 1536 + hm * 128 + 4 * fq;
            u32x2 gv[8];
#pragma unroll
            for (int dt = 0; dt < 8; ++dt) gv[dt] = *(const u32x2*)(gp + 16 * dt);
            __builtin_amdgcn_sched_barrier(0);
#pragma unroll
            for (int dt = 0; dt < 8; ++dt) { const u32x2 g = gv[dt];
                u32x2 w; w.x = cvt_pk_bf16(oacc[dt][0] * rl * bflo(g.x), oacc[dt][1] * rl * bfhi(g.x)); w.y = cvt_pk_bf16(oacc[dt][2] * rl * bflo(g.y), oacc[dt][3] * rl * bfhi(g.y));
                *(u32x2*)(yp + 16 * dt) = w; }
#pragma unroll
            for (int k = 0; k < 4; ++k) qc[k] = qn[k];
        }
    }
    const bf16_t* wsb = (const bf16_t*)(ws + WS_WSB);
    for (int item = blockIdx.x; item < BATCH * (SEQ / 128); item += gridDim.x) {
        const size_t row0 = (size_t)item * 128;
        int fr = fr_, fq = fq_, lane = lane_; asm volatile("" : "+v"(fr), "+v"(fq), "+v"(lane));
        __syncthreads();
        {
            const f32x4 g0 = *(const f32x4*)(a.gln_g + 8 * lane), g1 = *(const f32x4*)(a.gln_g + 8 * lane + 4), b0 = *(const f32x4*)(a.gln_b + 8 * lane), b1 = *(const f32x4*)(a.gln_b + 8 * lane + 4);
            u32x4 raw[16];
#pragma unroll
            for (int i = 0; i < 16; ++i) raw[i] = *(const u32x4*)(proj + (row0 + wave + 8 * i) * DIN + C_VG + 8 * lane);
#pragma unroll
            for (int i = 0; i < 16; ++i) {
                const int tk = wave + 8 * i;
                float v[8] = {bflo(raw[i].x), bfhi(raw[i].x), bflo(raw[i].y), bfhi(raw[i].y), bflo(raw[i].z), bfhi(raw[i].z), bflo(raw[i].w), bfhi(raw[i].w)};
                float sm = 0.f;
#pragma unroll
                for (int e = 0; e < 8; ++e) sm += v[e];
#pragma unroll
                for (int o = 1; o < 64; o <<= 1) sm += __shfl_xor(sm, o);
                const float mu = sm * (1.f / 512.f); float q = 0.f;
#pragma unroll
                for (int e = 0; e < 8; ++e) { v[e] -= mu; q += v[e] * v[e]; }
#pragma unroll
                for (int o = 1; o < 64; o <<= 1) q += __shfl_xor(q, o);
                const float rstd = 1.f / sqrtf(q * (1.f / 512.f) + LN_EPS);
#pragma unroll
                for (int e = 0; e < 8; ++e) { const float o = v[e] * rstd * (e < 4 ? g0[e] : g1[e - 4]) + (e < 4 ? b0[e] : b1[e - 4]);
                    *(LAS bf16_t*)(lds + (8 * lane + e) * 272 + tk * 2) = (bf16_t)(cvt_pk_bf16(o, 0.f) & 0xffffu); }
            }
        }
        __syncthreads();
        const int g = wave >> 1, th = wave & 1;
        f32x4 acc[8][4];
#pragma unroll
        for (int ct = 0; ct < 8; ++ct)
#pragma unroll
            for (int tt = 0; tt < 4; ++tt) acc[ct][tt] = (f32x4){0.f, 0.f, 0.f, 0.f};
#pragma unroll
        for (int k = 0; k < 4; ++k) {
            bf16x8 wf[4];
#pragma unroll
            for (int tt = 0; tt < 4; ++tt) wf[tt] = *(const bf16x8*)(wsb + (size_t)(g * 128 + 64 * th + 16 * tt + fr) * 128 + 32 * k + 8 * fq);
#pragma unroll
            for (int ct = 0; ct < 8; ++ct) { const bf16x8 av = *(const LAS bf16x8*)(lds + (128 * g + 16 * ct + fr) * 272 + (32 * k + 8 * fq) * 2);
#pragma unroll
                for (int tt = 0; tt < 4; ++tt) acc[ct][tt] = __builtin_amdgcn_mfma_f32_16x16x32_bf16(av, wf[tt], acc[ct][tt], 0, 0, 0); }
        }
#pragma unroll
        for (int tt = 0; tt < 4; ++tt) { const int t = 64 * th + 16 * tt + fr; const float bs = a.b_s[g * 128 + t]; const size_t row = row0 + t;
            u32x2 uuv[8], ggv[8];
#pragma unroll
            for (int ct = 0; ct < 8; ++ct) { const int ch = 128 * g + 16 * ct + 4 * fq; uuv[ct] = *(const u32x2*)(proj + row * DIN + C_U + ch); ggv[ct] = *(const u32x2*)(proj + row * DIN + C_GG + ch); }
            __builtin_amdgcn_sched_barrier(0);
#pragma unroll
            for (int ct = 0; ct < 8; ++ct) { const int ch = 128 * g + 16 * ct + 4 * fq;
                const u32x2 uu = uuv[ct], gg = ggv[ct];
                const f32x4 m = acc[ct][tt] + bs;
                u32x2 w; w.x = cvt_pk_bf16(bflo(uu.x) * m[0] * bflo(gg.x), bfhi(uu.x) * m[1] * bfhi(gg.x)); w.y = cvt_pk_bf16(bflo(uu.y) * m[2] * bflo(gg.y), bfhi(uu.y) * m[3] * bfhi(gg.y));
                *(u32x2*)(Y + row * DM + 1024 + ch) = w; } }
    }
    __syncthreads();
    LAS int* prp = (LAS int*)(lds + 131072 + 4352);
    LAS int* nxt = (LAS int*)(lds + 131072 + 12288 + 64);
    if (wave == 0) {
        int locf[16], locp[16]; int sumf = 0, sump = 0;
#pragma unroll
        for (int i = 0; i < 16; ++i) { const int v_ = lane * 16 + i; const int c = cnt[(v_ & 15) * 64 + (v_ >> 4)]; locf[i] = c / QCH; locp[i] = (c % QCH) ? 1 : 0; sumf += locf[i]; sump += locp[i]; }
        int incf = sumf, incp = sump;
#pragma unroll
        for (int o = 1; o < 64; o <<= 1) { const int vf_ = __shfl_up(incf, o), vp_ = __shfl_up(incp, o); if (lane >= o) { incf += vf_; incp += vp_; } }
        int runf = incf - sumf, runp = incp - sump;
#pragma unroll
        for (int i = 0; i < 16; ++i) { pre[lane * 16 + i] = runf; prp[lane * 16 + i] = runp; runf += locf[i]; runp += locp[i]; }
        if (lane == 63) { pre[1024] = runf; prp[1024] = runp; }
    }
    __syncthreads();
    const int nfull = pre[1024], npart = prp[1024];
    int* ticket = (int*)(ws + WS_CNT) + 1024;
    int it_static = blockIdx.x; bool dyn = false;
    for (;;) {
        int idx = 0;
        if (!dyn) { if (it_static < nfull) { idx = it_static; it_static += gridDim.x; } else dyn = true; }
        if (dyn) {
            __syncthreads();
            if (tid == 0) nxt[0] = atomicAdd(ticket, 1);
            __syncthreads();
            idx = nxt[0];
            if (idx >= npart) break;
            idx += nfull;
        }
        int u, c;
        if (idx < nfull) { int lo = 0, hi = 1024; while (hi - lo > 1) { const int mid = (lo + hi) >> 1; if (pre[mid] <= idx) lo = mid; else hi = mid; } c = idx - pre[lo]; u = (lo & 15) * 64 + (lo >> 4); }
        else { const int j = idx - nfull; int lo = 0, hi = 1024; while (hi - lo > 1) { const int mid = (lo + hi) >> 1; if (prp[mid] <= j) lo = mid; else hi = mid; } u = (lo & 15) * 64 + (lo >> 4); c = cnt[u] / QCH; }
        const int bh = u >> 6, n = u & 63, b = bh >> 3, h = bh & 7;
        int tid = tid_, fr = fr_, fq = fq_; asm volatile("" : "+v"(tid), "+v"(fr), "+v"(fq));
        const int count = cnt[u], qbase = c * QCH;
        const int ntile = min(QCH / 16, (count - qbase + 15) >> 4);
        const unsigned* lp = list + (size_t)bh * LIST_PER_BH + list_base(n);
        const bf16_t* qb0 = proj + (size_t)(b * SEQ) * DIN + h * 128 + 8 * fq;
        int tile = wave;
        unsigned ent_c = 0u, ent_n = 0u;
        if (tile < ntile) ent_c = lp[min(qbase + tile * 16 + fr, count - 1)];
        if (tile + 8 < ntile) ent_n = lp[min(qbase + (tile + 8) * 16 + fr, count - 1)];
        __syncthreads();
        const bf16_t* Kg = proj + (size_t)(b * SEQ + n * 256) * DIN + C_K + h * 128;
        stage_kv(Kl, Vl, Kg, Kg + (C_V - C_K), DIN, tid, kmx);
        bf16x8 qc[4];
        { const bf16_t* qp = qb0 + (size_t)(ent_c & 0x3fffu) * DIN;
#pragma unroll
          for (int k = 0; k < 4; ++k) qc[k] = *(const bf16x8*)(qp + 32 * k); }
        float qn_c = qnorm(qc);
        __syncthreads();
        const float kmax = kmax_of(kmx);
        for (; tile < ntile; tile += 8) {
            bf16x8 qn[4]; unsigned ent_nn = 0u;
#pragma unroll
            for (int k = 0; k < 4; ++k) qn[k] = qc[k];
            if (tile + 8 < ntile) {
                const bf16_t* qp = qb0 + (size_t)(ent_n & 0x3fffu) * DIN;
#pragma unroll
                for (int k = 0; k < 4; ++k) qn[k] = *(const bf16x8*)(qp + 32 * k);
                if (tile + 16 < ntile) ent_nn = lp[min(qbase + (tile + 16) * 16 + fr, count - 1)];
            }
            const bool valid = qbase + tile * 16 + fr < count;
            const int sq = (int)(ent_c & 0x3fffu), slot = (int)(ent_c >> 14);
            const bool do_mask = __any(slot == 3);
            const int qrel = sq - n * 256;
            int smax = 8;
            if (do_mask) { int qm = qrel;
#pragma unroll
                for (int o = 1; o < 64; o <<= 1) qm = max(qm, __shfl_xor(qm, o));
                smax = min(8, (qm >> 5) + 1); }
            smax = __builtin_amdgcn_readfirstlane(smax);
            f32x4 oacc[8]; float mx, l;
            attn_core(Kl, Vl, qc, fr, fq, do_mask, qrel, smax, qn_c * kmax, oacc, mx, l);
            qn_c = qnorm(qn);
            __builtin_amdgcn_sched_barrier(0);
            if (valid) {
                const size_t pidx = ((size_t)bh * SEQ + sq) * 4 + slot;
                bf16_t* op = PO + pidx * 128 + 4 * fq;
#pragma unroll
                for (int dt = 0; dt < 8; ++dt) { u32x2 w; w.x = cvt_pk_bf16(oacc[dt][0], oacc[dt][1]); w.y = cvt_pk_bf16(oacc[dt][2], oacc[dt][3]); *(u32x2*)(op + 16 * dt) = w; }
                if (fq == 0) PML[pidx] = (f32x2){mx, l};
            }
            ent_c = ent_n; ent_n = ent_nn;
#pragma unroll
            for (int k = 0; k < 4; ++k) qc[k] = qn[k];
        }
    }
}

__device__ __forceinline__ void phase4(const Args& a) {
    unsigned char* ws = a.ws;
    const int tid = threadIdx.x, lane = tid & 63, wave = tid >> 6;
    const bf16_t* proj = (const bf16_t*)(ws + WS_PROJ);
    const bf16_t* PO = (const bf16_t*)(ws + WS_PO); const f32x2* PML = (const f32x2*)(ws + WS_PML);
    bf16_t* Y = (bf16_t*)(ws + WS_Y);
    const int rl_ = lane >> 3, d0 = (lane & 7) * 16;
    const int nw = gridDim.x * 8;
    for (int t0 = blockIdx.x * 8 + wave; t0 < 16 * (SEQ / 8); t0 += 2 * nw) {
        f32x2 ml[2][4]; u32x4 pp[2][4][2]; u32x4 gg[2][2];
#pragma unroll
        for (int r = 0; r < 2; ++r) {
            const int t = (t0 + r * nw < 16 * (SEQ / 8)) ? t0 + r * nw : t0;
            const int bh = 15 - t / (SEQ / 8), s = (t % (SEQ / 8)) * 8 + rl_, b = bh >> 3, h = bh & 7, qb = s >> 8, nv = qb < 3 ? qb : 3;
            const size_t pbase = ((size_t)bh * SEQ + s) * 4; const size_t row = (size_t)b * SEQ + s;
#pragma unroll
            for (int j = 0; j < 4; ++j) { const bool ok = (j == 3) || (j < nv);
                ml[r][j] = ok ? PML[pbase + j] : (f32x2){-INFINITY, 0.f};
                if (ok) { pp[r][j][0] = *(const u32x4*)(PO + (pbase + j) * 128 + d0); pp[r][j][1] = *(const u32x4*)(PO + (pbase + j) * 128 + d0 + 8); }
                else { pp[r][j][0] = (u32x4){0u, 0u, 0u, 0u}; pp[r][j][1] = pp[r][j][0]; } }
            gg[r][0] = *(const u32x4*)(proj + row * DIN + C_GMO + h * 128 + d0); gg[r][1] = *(const u32x4*)(proj + row * DIN + C_GMO + h * 128 + d0 + 8);
        }
        __builtin_amdgcn_sched_barrier(0);
#pragma unroll
        for (int r = 0; r < 2; ++r) {
            const int t = t0 + r * nw;
            if (t < 16 * (SEQ / 8)) {
                const int bh = 15 - t / (SEQ / 8), s = (t % (SEQ / 8)) * 8 + rl_, b = bh >> 3, h = bh & 7; const size_t row = (size_t)b * SEQ + s;
                float M = -INFINITY;
#pragma unroll
                for (int j = 0; j < 4; ++j) M = fmaxf(M, ml[r][j].x);
                float o[16]; float L = 0.f;
#pragma unroll
                for (int e = 0; e < 16; ++e) o[e] = 0.f;
#pragma unroll
                for (int j = 0; j < 4; ++j) { const float w = fast_exp2(ml[r][j].x - M); L += w * ml[r][j].y;
                    const u32x4 p0 = pp[r][j][0], p1 = pp[r][j][1];
                    o[0] += w * bflo(p0.x); o[1] += w * bfhi(p0.x); o[2] += w * bflo(p0.y); o[3] += w * bfhi(p0.y); o[4] += w * bflo(p0.z); o[5] += w * bfhi(p0.z); o[6] += w * bflo(p0.w); o[7] += w * bfhi(p0.w);
                    o[8] += w * bflo(p1.x); o[9] += w * bfhi(p1.x); o[10] += w * bflo(p1.y); o[11] += w * bfhi(p1.y); o[12] += w * bflo(p1.z); o[13] += w * bfhi(p1.z); o[14] += w * bflo(p1.w); o[15] += w * bfhi(p1.w); }
                const float rl = 1.f / L;
                const u32x4 g0 = gg[r][0], g1 = gg[r][1];
                u32x4 w0, w1;
                w0.x = cvt_pk_bf16(o[0] * rl * bflo(g0.x), o[1] * rl * bfhi(g0.x)); w0.y = cvt_pk_bf16(o[2] * rl * bflo(g0.y), o[3] * rl * bfhi(g0.y));
                w0.z = cvt_pk_bf16(o[4] * rl * bflo(g0.z), o[5] * rl * bfhi(g0.z)); w0.w = cvt_pk_bf16(o[6] * rl * bflo(g0.w), o[7] * rl * bfhi(g0.w));
                w1.x = cvt_pk_bf16(o[8] * rl * bflo(g1.x), o[9] * rl * bfhi(g1.x)); w1.y = cvt_pk_bf16(o[10] * rl * bflo(g1.y), o[11] * rl * bfhi(g1.y));
                w1.z = cvt_pk_bf16(o[12] * rl * bflo(g1.z), o[13] * rl * bfhi(g1.z)); w1.w = cvt_pk_bf16(o[14] * rl * bflo(g1.w), o[15] * rl * bfhi(g1.w));
                *(u32x4*)(Y + row * DM + h * 128 + d0) = w0; *(u32x4*)(Y + row * DM + h * 128 + d0 + 8) = w1;
            }
        }
        __builtin_amdgcn_sched_barrier(0);
    }
}

__device__ __forceinline__ void phase6(const Args& a) {
    const int tid = threadIdx.x, lane = tid & 63, wave = tid >> 6;
    const bf16_t* sub = (const bf16_t*)(a.ws + WS_SUB);
    for (int row = blockIdx.x * 8 + wave; row < MROWS; row += gridDim.x * 8) {
        const f32x4* xp = (const f32x4*)(a.x + (size_t)row * DM) + lane;
        const u32x2* sp = (const u32x2*)(sub + (size_t)row * DM) + lane;
        f32x4* rp = (f32x4*)(a.out + (size_t)row * DM) + lane;
        f32x4 v[8]; u32x2 sv[8]; float s = 0.f;
#pragma unroll
        for (int j = 0; j < 8; ++j) { v[j] = __builtin_nontemporal_load(xp + 64 * j); sv[j] = sp[64 * j]; }
#pragma unroll
        for (int j = 0; j < 8; ++j) { v[j] = v[j] * ALPHA + (f32x4){bflo(sv[j].x), bfhi(sv[j].x), bflo(sv[j].y), bfhi(sv[j].y)}; s += (v[j][0] + v[j][1]) + (v[j][2] + v[j][3]); }
#pragma unroll
        for (int o = 1; o < 64; o <<= 1) s += __shfl_xor(s, o);
        const float mu = s * (1.f / DM); float q = 0.f;
#pragma unroll
        for (int j = 0; j < 8; ++j) { v[j] = v[j] - mu; q += (v[j][0] * v[j][0] + v[j][1] * v[j][1]) + (v[j][2] * v[j][2] + v[j][3] * v[j][3]); }
#pragma unroll
        for (int o = 1; o < 64; o <<= 1) q += __shfl_xor(q, o);
        const float rstd = 1.f / sqrtf(q * (1.f / DM) + LN_EPS);
#pragma unroll
        for (int j = 0; j < 8; ++j) { const f32x4 g = ((const f32x4*)a.ln_g)[lane + 64 * j], bb = ((const f32x4*)a.ln_b)[lane + 64 * j]; __builtin_nontemporal_store(v[j] * rstd * g + bb, rp + 64 * j); }
    }
}

#define XB_TMO      128
#define XB_XCNT(j)  (256  + 64 * (j))
#define XB_XSUB(j)  (1280 + 64 * (j))
#define XB_XGEN(j)  (2304 + 64 * (j))
#define XB_TOP      3328
#define XB_TOPGEN   3392
#define XCD_BAR_WORDS 3456
#define XB_SPIN_CAP (1u << 18)
__device__ __forceinline__ unsigned xb_ld(unsigned* p)              { return __hip_atomic_load(p, __ATOMIC_RELAXED, __HIP_MEMORY_SCOPE_AGENT); }
__device__ __forceinline__ unsigned xb_add(unsigned* p, unsigned v) { return __hip_atomic_fetch_add(p, v, __ATOMIC_RELAXED, __HIP_MEMORY_SCOPE_AGENT); }
__device__ __forceinline__ unsigned xb_xcc_id() { return (unsigned)__builtin_amdgcn_s_getreg((3 << 11) | 20) & 0xFu; }
#define XB_SPIN(cond, bar) do { unsigned _sp = 0; while (cond) { __builtin_amdgcn_s_sleep(1); \
    if ((++_sp & 255u) == 0u) { if (xb_ld(&(bar)[XB_TMO])) break; if (_sp > XB_SPIN_CAP) { atomicAdd(&(bar)[XB_TMO], 1u); break; } } } } while (0)
struct XcdBarrier { unsigned* bar; unsigned x; volatile LAS unsigned* st; };
__device__ __forceinline__ XcdBarrier xcd_barrier_post(unsigned* bar, volatile LAS unsigned* st) {
    XcdBarrier b; b.bar = bar; b.x = xb_xcc_id(); b.st = st;
    if (threadIdx.x == 0) (void)xb_add(&bar[XB_XCNT(b.x)], 1u);
    return b;
}
__device__ __forceinline__ void xcd_barrier_complete(unsigned* bar, unsigned x, unsigned& nloc, unsigned& nx) {
    const unsigned G = gridDim.x * gridDim.y * gridDim.z;
    unsigned sum, cnt, mine, sp = 0u;
    for (;;) {
        sum = 0u; cnt = 0u; mine = 0u;
#pragma unroll
        for (unsigned j = 0; j < 16; ++j) { const unsigned c = xb_ld(&bar[XB_XCNT(j)]); sum += c; cnt += (c > 0u) ? 1u : 0u; mine = (j == x) ? c : mine; }
        if (sum == G) break;
        __builtin_amdgcn_s_sleep(1);
        if ((++sp & 255u) == 0u) { if (xb_ld(&bar[XB_TMO])) break; if (sp > XB_SPIN_CAP) { atomicAdd(&bar[XB_TMO], 1u); break; } }
    }
    nloc = mine > 0u ? mine : 1u; nx = cnt > 0u ? cnt : 1u;
}
__device__ __forceinline__ void xcd_barrier(const XcdBarrier& b) {
    asm volatile("s_waitcnt vmcnt(0)" ::: "memory");
    __syncthreads();
    if (threadIdx.x == 0) {
        unsigned* bar = b.bar;
        __builtin_amdgcn_s_waitcnt(0);
        unsigned nloc = b.st[0], nx = b.st[1];
        if (nloc == 0u) { xcd_barrier_complete(bar, b.x, nloc, nx); b.st[0] = nloc; b.st[1] = nx; }
        const unsigned old = xb_add(&bar[XB_XSUB(b.x)], 1u);
        const unsigned gen = old / nloc;
        if (old + 1u == (gen + 1u) * nloc) {
            __builtin_amdgcn_fence(__ATOMIC_RELEASE, "agent");
            asm volatile("s_waitcnt vmcnt(0)" ::: "memory");
            const unsigned og = xb_add(&bar[XB_TOP], 1u);
            const unsigned tg = og / nx;
            if (og + 1u == (tg + 1u) * nx) xb_add(&bar[XB_TOPGEN], 1u);
            else XB_SPIN(xb_ld(&bar[XB_TOPGEN]) == tg, bar);
            __builtin_amdgcn_fence(__ATOMIC_ACQUIRE, "agent");
            xb_add(&bar[XB_XGEN(b.x)], 1u);
            asm volatile("s_waitcnt vmcnt(0)" ::: "memory");
        } else {
            XB_SPIN(xb_ld(&bar[XB_XGEN(b.x)]) == gen, bar);
            __builtin_amdgcn_fence(__ATOMIC_ACQUIRE, "agent");
            asm volatile("s_waitcnt vmcnt(0)" ::: "memory");
        }
    }
    __syncthreads();
}

__global__ void __launch_bounds__(512, 2) hymba_fwd(Args a) {
    extern __shared__ __attribute__((aligned(16))) unsigned char lds_raw[];
    LAS unsigned char* lds = (LAS unsigned char*)lds_raw;
    unsigned char* ws = a.ws;
    const int lo = a.ph_lo, hi = a.ph_hi, G = gridDim.x;
#define IN(k) (lo <= (k) && (k) < hi)
#define SEAM(k) do { if (IN(k) && IN((k) + 1)) xcd_barrier(xbar); } while (0)
    volatile LAS unsigned* xst = (volatile LAS unsigned*)(lds + LDS_BYTES - 64);
    if (threadIdx.x < 2) xst[threadIdx.x] = 0u;
    __syncthreads();
    XcdBarrier xbar; xbar.bar = (unsigned*)(ws + WS_BAR); xbar.x = 0; xbar.st = xst;
    if (IN(0) && IN(1)) xbar = xcd_barrier_post((unsigned*)(ws + WS_BAR), xst);
    if (IN(0)) phase0(a, lds);
    SEAM(0);
    if (IN(1)) {
        { pg8::Gemm g{(const bf16_t*)(ws + WS_XB), (const bf16_t*)(ws + WS_WIN), MROWS, DIN, DM}; pg8::StaticOrder S; S.init(g.M, g.N, G, (int)blockIdx.x);
          EpiProj E{(bf16_t*)(ws + WS_PROJ), (const float*)(ws + WS_COS), (const float*)(ws + WS_SIN), (float*)(ws + WS_KSUM)};
          pg8::gemm_phase<EpiProj, pg8::StaticOrder, true, true>(lds, g, S, E); }
    }
    SEAM(1);
    if (IN(2)) phase2(a, lds);
    SEAM(2);
    if (IN(3)) phase3(a, lds);
    SEAM(3);
    if (IN(4)) phase4(a);
    SEAM(4);
    if (IN(5)) {
        pg8::Gemm g{(const bf16_t*)(ws + WS_Y), (const bf16_t*)(ws + WS_WOUT), MROWS, DM, DM}; pg8::StaticOrder S; S.init(g.M, g.N, G, (int)blockIdx.x);
        EpiPlain E{(bf16_t*)(ws + WS_SUB), DM};
        pg8::gemm_phase<EpiPlain, pg8::StaticOrder, true, true>(lds, g, S, E);
    }
    SEAM(5);
    if (IN(6)) phase6(a);
#undef IN
#undef SEAM
}

extern "C" void kernel_launch(void* const* d_in, const int* in_sizes, int n_in, void* d_out, int out_size, void* d_ws, size_t ws_size, hipStream_t stream) {
    static int grid = 0;
    if (grid == 0) {
        if (n_in != 12 || ws_size < WS_END) { fprintf(stderr, "kernel_launch: unexpected inputs (n_in %d, ws %zu)\n", n_in, ws_size); grid = -1; return; }
        int dev = 0, cus = 0, per_cu = 0;
        hipGetDevice(&dev); hipDeviceGetAttribute(&cus, hipDeviceAttributeMultiprocessorCount, dev);
        hipFuncSetAttribute((const void*)hymba_fwd, hipFuncAttributeMaxDynamicSharedMemorySize, LDS_BYTES);
        hipOccupancyMaxActiveBlocksPerMultiprocessor(&per_cu, (const void*)hymba_fwd, 512, LDS_BYTES);
        if (per_cu < 1) { fprintf(stderr, "kernel_launch: occupancy query reports %d blocks per CU\n", per_cu); per_cu = 1; }
        grid = cus * per_cu;
        (void)hipGetLastError();
    }
    if (grid < 0) return;
    Args a{};
    a.x = (const float*)d_in[0]; a.mem = (const float*)d_in[1]; a.pos = (const int*)d_in[2]; a.w_in = (const float*)d_in[3]; a.w_mkv = (const float*)d_in[4];
    a.gln_g = (const float*)d_in[5]; a.gln_b = (const float*)d_in[6]; a.w_s = (const float*)d_in[7]; a.b_s = (const float*)d_in[8]; a.w_out = (const float*)d_in[9];
    a.ln_g = (const float*)d_in[10]; a.ln_b = (const float*)d_in[11]; a.out = (float*)d_out; a.ws = (unsigned char*)d_ws;
#if MK_MULTI
    for (int p = 0; p < 7; ++p) { a.ph_lo = p; a.ph_hi = p + 1; hipLaunchKernelGGL(hymba_fwd, dim3(grid), dim3(512), LDS_BYTES, stream, a); }
#else
    a.ph_lo = 0; a.ph_hi = 7;
    (void)hipMemsetAsync((char*)d_ws + WS_BAR, 0, BAR_WORDS_N * 4, stream);
    void* args[] = {&a};
    hipError_t e = hipLaunchCooperativeKernel((const void*)hymba_fwd, dim3(grid), dim3(512), args, LDS_BYTES, stream);
    if (e != hipSuccess) fprintf(stderr, "cooperative launch failed: %s (grid %d)\n", hipGetErrorString(e), grid);
#endif
}
```
